# Optimizing an MI355X kernel written in HIP

```python
import math
import jax, jax.numpy as jnp
from jax import lax
import numpy as np

D_MODEL = 1024
BATCH = 8
SEQ = 2048
DEPTH = 2

CHUNK = 64
N_EVEN = (DEPTH + 1) // 2
N_ODD = DEPTH // 2
EPS = 1e-6
NEG_INF = -1e30
FOX_HEADS = 8
FOX_HEAD_DIM = 64
FOX_WIDTH = FOX_HEADS * FOX_HEAD_DIM
Q_BLOCK = 2 * CHUNK
POOL_WINDOWS = (2, 4, 8, 16)
POOL_GROUPS = 4
POOL_GROUP_DIM = 128
POOL_WIDTH = POOL_GROUPS * POOL_GROUP_DIM
EVEN_IN_WIDTH = 3 * FOX_WIDTH + FOX_HEADS + POOL_WIDTH
EVEN_MIX_WIDTH = FOX_WIDTH + POOL_WIDTH
SSM_WIDTH = D_MODEL
SSM_GROUP = 16
SSM_GROUPS = SSM_WIDTH // SSM_GROUP
SSM_STATE = 64
DT_MIN = 1e-3
DT_MAX = 1e-1
D_FF = 2816
N_EXPERTS = 8
TOP_K = 2

kernel_name = "hybrid_fox_pool_s5_moe_trunk"


def rms_norm(x, g):
    xf = x.astype(jnp.float32)
    xf = xf * lax.rsqrt(jnp.mean(xf * xf, axis=-1, keepdims=True) + EPS)
    return (xf * g.astype(jnp.float32)).astype(x.dtype)


def swiglu(h, w1, w3, w2):
    return (jax.nn.silu(h @ w1) * (h @ w3)) @ w2


def forgetting_attention(q, k, v, log_f):
    b, s, h, dh = q.shape
    nb = s // Q_BLOCK
    scale = dh ** -0.5
    cum = jnp.cumsum(log_f.astype(jnp.float32), axis=1)
    cum_k = cum.transpose(0, 2, 1)
    pos = jnp.arange(s, dtype=jnp.int32)
    q_blocks = q.reshape(b, nb, Q_BLOCK, h, dh).transpose(1, 0, 2, 3, 4)
    cum_q = cum.reshape(b, nb, Q_BLOCK, h).transpose(1, 0, 3, 2)
    q_pos = pos.reshape(nb, Q_BLOCK)

    def one_block(args):
        qi, ci, pi = args
        logits = jnp.einsum('bqhd,bkhd->bhqk', qi, k,
                            preferred_element_type=jnp.float32) * scale
        logits = logits + ci[..., :, None] - cum_k[..., None, :]
        mask = pos[None, :] <= pi[:, None]
        logits = jnp.where(mask, logits, NEG_INF)
        p = jax.nn.softmax(logits, axis=-1)
        return jnp.einsum('bhqk,bkhd->bqhd', p.astype(v.dtype), v)

    out = lax.map(one_block, (q_blocks, cum_q, q_pos))
    return out.transpose(1, 0, 2, 3, 4).reshape(b, s, h * dh)


def multiscale_pool(p, w_pool, pool_scale):
    b, s, _ = p.shape
    pf = p.astype(jnp.float32).reshape(b, s, POOL_GROUPS, POOL_GROUP_DIM)
    cs = jnp.cumsum(pf, axis=1)
    count = jnp.arange(1, s + 1, dtype=jnp.float32)
    outs = []
    for gi, w in enumerate(POOL_WINDOWS):
        c = cs[:, :, gi]
        lag = jnp.pad(c[:, :s - w], ((0, 0), (w, 0), (0, 0)))
        mean = (c - lag) / jnp.minimum(count, float(w))[None, :, None]
        outs.append(mean - pf[:, :, gi])
    pooled = jnp.stack(outs, axis=2).astype(p.dtype)
    mixed = jnp.einsum('bsgc,gcd->bsgd', pooled, w_pool)
    return mixed.reshape(b, s, POOL_WIDTH) * pool_scale


def s5_layer(u, a_re, a_im, log_dt, b_re, b_im, c_re, c_im, d):
    f32 = jnp.float32
    bsz, s, _ = u.shape
    ug = u.astype(f32).reshape(bsz, s, SSM_GROUPS, SSM_GROUP)
    dt = jnp.exp(log_dt.astype(f32))[:, None]
    ar = a_re.astype(f32)
    ai = a_im.astype(f32)
    mag = jnp.exp(ar * dt)
    abar_re = mag * jnp.cos(ai * dt)
    abar_im = mag * jnp.sin(ai * dt)
    den = ar * ar + ai * ai
    nr = abar_re - 1.0
    ni = abar_im
    coef_re = (nr * ar + ni * ai) / den
    coef_im = (ni * ar - nr * ai) / den
    br = b_re.astype(f32)
    bi = b_im.astype(f32)
    bbar_re = coef_re[..., None] * br - coef_im[..., None] * bi
    bbar_im = coef_re[..., None] * bi + coef_im[..., None] * br
    bu_re = jnp.einsum('bsgh,gph->bsgp', ug, bbar_re)
    bu_im = jnp.einsum('bsgh,gph->bsgp', ug, bbar_im)
    a_re_s = jnp.broadcast_to(abar_re, (1, s) + abar_re.shape)
    a_im_s = jnp.broadcast_to(abar_im, (1, s) + abar_im.shape)

    def combine(left, right):
        ar_l, ai_l, br_l, bi_l = left
        ar_r, ai_r, br_r, bi_r = right
        return (ar_r * ar_l - ai_r * ai_l,
                ar_r * ai_l + ai_r * ar_l,
                ar_r * br_l - ai_r * bi_l + br_r,
                ar_r * bi_l + ai_r * br_l + bi_r)

    _, _, x_re, x_im = lax.associative_scan(
        combine, (a_re_s, a_im_s, bu_re, bu_im), axis=1)
    y = (jnp.einsum('bsgp,ghp->bsgh', x_re, c_re.astype(f32))
         - jnp.einsum('bsgp,ghp->bsgh', x_im, c_im.astype(f32)))
    y = y.reshape(bsz, s, SSM_WIDTH) + d.astype(f32) * u.astype(f32)
    return y.astype(u.dtype)


def moe_swiglu(h, router_w, router_b, w1, w3, w2):
    b, s, d = h.shape
    xf = h.reshape(b * s, d)
    logits = (xf @ router_w).astype(jnp.float32) + router_b.astype(jnp.float32)
    top_vals, top_idx = lax.top_k(logits, TOP_K)
    gates = jax.nn.softmax(top_vals, axis=-1)
    combine = jnp.sum(jax.nn.one_hot(top_idx, N_EXPERTS, dtype=jnp.float32)
                      * gates[..., None], axis=1)
    out = jnp.zeros((b * s, d), jnp.float32)
    for e in range(N_EXPERTS):
        ye = swiglu(xf, w1[e], w3[e], w2[e])
        out = out + combine[:, e:e + 1] * ye.astype(jnp.float32)
    return out.astype(h.dtype).reshape(b, s, d)


def setup_inputs(seed: int = 0) -> dict:
    key = jax.random.key(seed)
    ks = jax.random.split(key, 32)
    f32 = jnp.float32

    def nrm(k, shape, std):
        return jax.random.normal(k, shape, f32) * std

    def gain(k, shape):
        return 1.0 + 0.02 * jax.random.normal(k, shape, f32)

    n_idx = jnp.arange(SSM_STATE, dtype=f32)
    inp = {}
    inp["x"] = jax.random.normal(ks[0], (BATCH, SEQ, D_MODEL), f32)
    inp["even_mix_norm"] = gain(ks[1], (N_EVEN, D_MODEL))
    inp["even_w_in"] = nrm(ks[2], (N_EVEN, D_MODEL, EVEN_IN_WIDTH), D_MODEL ** -0.5)
    inp["even_b_forget"] = 2.0 + 0.5 * jax.random.normal(ks[3], (N_EVEN, FOX_HEADS), f32)
    inp["even_w_pool"] = nrm(ks[4], (N_EVEN, POOL_GROUPS, POOL_GROUP_DIM, POOL_GROUP_DIM), POOL_GROUP_DIM ** -0.5)
    inp["even_pool_scale"] = gain(ks[5], (N_EVEN, POOL_WIDTH))
    inp["even_w_out"] = nrm(ks[6], (N_EVEN, EVEN_MIX_WIDTH, D_MODEL), EVEN_MIX_WIDTH ** -0.5)
    inp["even_ffn_norm"] = gain(ks[7], (N_EVEN, D_MODEL))
    inp["even_ffn_w1"] = nrm(ks[8], (N_EVEN, D_MODEL, D_FF), D_MODEL ** -0.5)
    inp["even_ffn_w3"] = nrm(ks[9], (N_EVEN, D_MODEL, D_FF), D_MODEL ** -0.5)
    inp["even_ffn_w2"] = nrm(ks[10], (N_EVEN, D_FF, D_MODEL), D_FF ** -0.5)
    inp["odd_mix_norm"] = gain(ks[11], (N_ODD, D_MODEL))
    inp["odd_w_in"] = nrm(ks[12], (N_ODD, D_MODEL, SSM_WIDTH), D_MODEL ** -0.5)
    inp["ssm_a_re"] = -0.5 + 0.01 * jax.random.normal(ks[13], (N_ODD, SSM_GROUPS, SSM_STATE), f32)
    inp["ssm_a_im"] = math.pi * n_idx + 0.01 * jax.random.normal(ks[14], (N_ODD, SSM_GROUPS, SSM_STATE), f32)
    inp["ssm_log_dt"] = jax.random.uniform(ks[15], (N_ODD, SSM_GROUPS), f32,
                                           math.log(DT_MIN), math.log(DT_MAX))
    inp["ssm_b_re"] = nrm(ks[16], (N_ODD, SSM_GROUPS, SSM_STATE, SSM_GROUP), (2.0 * SSM_GROUP) ** -0.5)
    inp["ssm_b_im"] = nrm(ks[17], (N_ODD, SSM_GROUPS, SSM_STATE, SSM_GROUP), (2.0 * SSM_GROUP) ** -0.5)
    inp["ssm_c_re"] = nrm(ks[18], (N_ODD, SSM_GROUPS, SSM_GROUP, SSM_STATE), 0.5)
    inp["ssm_c_im"] = nrm(ks[19], (N_ODD, SSM_GROUPS, SSM_GROUP, SSM_STATE), 0.5)
    inp["ssm_d"] = nrm(ks[20], (N_ODD, SSM_WIDTH), 1.0)
    inp["odd_w_glu_a"] = nrm(ks[21], (N_ODD, SSM_WIDTH, D_MODEL), SSM_WIDTH ** -0.5)
    inp["odd_w_glu_b"] = nrm(ks[22], (N_ODD, SSM_WIDTH, D_MODEL), SSM_WIDTH ** -0.5)
    inp["odd_moe_norm"] = gain(ks[23], (N_ODD, D_MODEL))
    inp["router_w"] = nrm(ks[24], (N_ODD, D_MODEL, N_EXPERTS), D_MODEL ** -0.5)
    inp["router_b"] = nrm(ks[25], (N_ODD, N_EXPERTS), 0.01)
    inp["expert_w1"] = nrm(ks[26], (N_ODD, N_EXPERTS, D_MODEL, D_FF), D_MODEL ** -0.5)
    inp["expert_w3"] = nrm(ks[27], (N_ODD, N_EXPERTS, D_MODEL, D_FF), D_MODEL ** -0.5)
    inp["expert_w2"] = nrm(ks[28], (N_ODD, N_EXPERTS, D_FF, D_MODEL), D_FF ** -0.5)
    inp["final_norm"] = gain(ks[29], (D_MODEL,))
    return inp


def reference(x, even_mix_norm, even_w_in, even_b_forget, even_w_pool, even_pool_scale,
              even_w_out, even_ffn_norm, even_ffn_w1, even_ffn_w3, even_ffn_w2,
              odd_mix_norm, odd_w_in, ssm_a_re, ssm_a_im, ssm_log_dt, ssm_b_re, ssm_b_im,
              ssm_c_re, ssm_c_im, ssm_d, odd_w_glu_a, odd_w_glu_b, odd_moe_norm,
              router_w, router_b, expert_w1, expert_w3, expert_w2, final_norm):
    b, s, _ = x.shape
    splits = [FOX_WIDTH, 2 * FOX_WIDTH, 3 * FOX_WIDTH, 3 * FOX_WIDTH + FOX_HEADS]
    for layer in range(DEPTH):
        j = layer // 2
        if layer % 2 == 0:
            h = rms_norm(x, even_mix_norm[j])
            z = h @ even_w_in[j]
            q, k, v, fg, p_in = jnp.split(z, splits, axis=-1)
            log_f = jax.nn.log_sigmoid(fg.astype(jnp.float32)
                                       + even_b_forget[j].astype(jnp.float32))
            hd = (b, s, FOX_HEADS, FOX_HEAD_DIM)
            att = forgetting_attention(q.reshape(hd), k.reshape(hd), v.reshape(hd), log_f)
            pool = multiscale_pool(p_in, even_w_pool[j], even_pool_scale[j])
            mix = jnp.concatenate([att.astype(x.dtype), pool.astype(x.dtype)], axis=-1)
            x = x + mix @ even_w_out[j]
            h = rms_norm(x, even_ffn_norm[j])
            x = x + swiglu(h, even_ffn_w1[j], even_ffn_w3[j], even_ffn_w2[j])
        else:
            h = rms_norm(x, odd_mix_norm[j])
            u = h @ odd_w_in[j]
            y = s5_layer(u, ssm_a_re[j], ssm_a_im[j], ssm_log_dt[j], ssm_b_re[j],
                         ssm_b_im[j], ssm_c_re[j], ssm_c_im[j], ssm_d[j])
            g = jax.nn.gelu(y)
            x = x + (g @ odd_w_glu_a[j]) * jax.nn.sigmoid(g @ odd_w_glu_b[j])
            h = rms_norm(x, odd_moe_norm[j])
            x = x + moe_swiglu(h, router_w[j], router_b[j], expert_w1[j],
                               expert_w3[j], expert_w2[j])
    return rms_norm(x, final_norm)
```

```cpp
#include <hip/hip_runtime.h>
#include <hip/hip_bf16.h>
#include <cstdio>
#include <cstdint>
#include <cmath>

namespace pg8 {
#define PG8_LAS __attribute__((address_space(3)))
typedef unsigned short bf16_t;
typedef short bf16x8 __attribute__((ext_vector_type(8)));
typedef float f32x4 __attribute__((ext_vector_type(4)));
typedef float f32x2 __attribute__((ext_vector_type(2)));
typedef unsigned u32x4 __attribute__((ext_vector_type(4)));
typedef unsigned u32x2 __attribute__((ext_vector_type(2)));
constexpr int BM = 256, BK = 64, HALF = 128, HTB = HALF * BK * 2  , STAGE_BYTES = 8 * HTB, NXCD = 8, WGM = 8;

__host__ __device__ __forceinline__ int lds_byte(int r, int c) { const int st = (r >> 4) * 2 + (c >> 5), rr = r & 15, cc = c & 31, ob = rr * 64 + cc * 2; return st * 1024 + (ob ^ (((ob >> 9) & 1) << 5)); }
__host__ __device__ __forceinline__ void stage_rc(int b, int& R, int& C) { const int st = b / 1024, sb = b % 1024, swz = sb ^ (((sb >> 9) & 1) << 5); R = (st >> 1) * 16 + swz / 64; C = (st & 1) * 32 + (swz % 64) / 2; }
__host__ __device__ __forceinline__ int perm32(int rho) { const int n = rho >> 4, i = rho & 15; return 8 * (i >> 2) + 4 * n + (i & 3); }

struct Unit { int pm, pn, x0, x1, x2; };

struct GridOrder {
    int nM, nN, nwg, G, c;
    __device__ __forceinline__ void init(int nM_, int nN_, int G_, int c_) { nM = nM_; nN = nN_; nwg = nM * nN; G = G_; c = c_; }
    __device__ __forceinline__ bool tile(int i, int& pm, int& pn) const {
        const long L = (long)i * G + c; if (L >= nwg) return false;
        int wgid = (int)L; { const int q = nwg / NXCD, r = nwg % NXCD, xcd = wgid % NXCD, off = wgid / NXCD; wgid = (xcd < r ? xcd * (q + 1) : r * (q + 1) + (xcd - r) * q) + off; }
        const int nig = WGM * nN, gid = wgid / nig, fm = gid * WGM, gsz = (nM - fm) < WGM ? (nM - fm) : WGM;
        pm = fm + ((wgid % nig) % gsz); pn = (wgid % nig) / gsz; return true;
    }
    __device__ __forceinline__ bool next(int i, Unit& u) const { u.x0 = 0; u.x1 = 0; u.x2 = 0; return tile(i, u.pm, u.pn); }
};

__device__ __forceinline__ unsigned cvt_pk_bf16(float lo, float hi) { unsigned r; asm volatile("v_cvt_pk_bf16_f32 %0, %1, %2" : "=v"(r) : "v"(lo), "v"(hi)); return r; }
__device__ __forceinline__ float fast_sigmoid(float v) { return __builtin_amdgcn_rcpf(1.0f + __builtin_amdgcn_exp2f(-1.4426950408889634f * v)); }
__device__ __forceinline__ float gelu_tanh(float y) { const float z2 = y * (1.5957691216057308f + 0.07135481627159282f * y * y); return y * fast_sigmoid(z2); }

template <class Epi, class Sched, class Prob, bool ALIGN_EPI>
__device__ __forceinline__ void gemm_phase(PG8_LAS unsigned char* lds, const Prob& P, const Sched& S, const Epi& E) {
    const int tid = threadIdx.x, wid = __builtin_amdgcn_readfirstlane(tid >> 6), lane = tid & 63, wr = wid >> 2, wc = wid & 3, fr = lane & 15, fq = lane >> 4;
    unsigned cV[2][2], nV[2][2], voffB[2]; int pR[2], pC[2];
#pragma unroll
    for (int i = 0; i < 2; ++i) { int R, C; stage_rc(tid * 16 + i * 8192, R, C); pR[i] = R; pC[i] = C; const int Rb = Epi::PERM ? ((R & ~31) + perm32(R & 31)) : R;
        voffB[i] = (unsigned)(Rb * P.ldb + C) * 2u;
        cV[0][i] = (unsigned)(R * P.lda + C) * 2u; cV[1][i] = (unsigned)((R + HALF) * P.lda + C) * 2u; nV[0][i] = cV[0][i]; nV[1][i] = cV[1][i]; }
    const size_t kstep = (size_t)(BK * 2);
    const size_t hstepB = (size_t)HALF * P.ldb * 2;
    const unsigned ldsw = (unsigned)wid * 1024u;
    const int aoff = lds_byte(wr * 64 + fr, fq * 8), boff = lds_byte(wc * 32 + fr, fq * 8);
#define PG8_SA(b, h) (((b) * 2 + (h)) * HTB)
#define PG8_SB(b, h) ((4 + (b) * 2 + (h)) * HTB)
#define PG8_STAGE(bufoff, gbase, voff) do { _Pragma("unroll") for (int _i = 0; _i < 2; ++_i) \
        __builtin_amdgcn_global_load_lds((const unsigned*)((const char*)(gbase) + (voff)[_i]), (PG8_LAS unsigned*)(lds + (bufoff) + ldsw + _i * 8192), 16, 0, 0); } while (0)
#define PG8_LDA(dst, b, h) do { _Pragma("unroll") for (int m = 0; m < 4; ++m) _Pragma("unroll") for (int k = 0; k < 2; ++k) dst[m][k] = *(const PG8_LAS bf16x8*)(lds + PG8_SA(b, h) + aoff + m * 2048 + k * 1024); } while (0)
#define PG8_LDB(dst, b, h) do { _Pragma("unroll") for (int n = 0; n < 2; ++n) _Pragma("unroll") for (int k = 0; k < 2; ++k) dst[n][k] = *(const PG8_LAS bf16x8*)(lds + PG8_SB(b, h) + boff + n * 2048 + k * 1024); } while (0)
#define PG8_MMA(ai, bj, At, Bt) do { __builtin_amdgcn_s_setprio(1); _Pragma("unroll") for (int m = 0; m < 4; ++m) _Pragma("unroll") for (int n = 0; n < 2; ++n) _Pragma("unroll") for (int k = 0; k < 2; ++k) \
        acc[ai][bj][m][n] = __builtin_amdgcn_mfma_f32_16x16x32_bf16(Bt[n][k], At[m][k], acc[ai][bj][m][n], 0, 0, 0); __builtin_amdgcn_s_setprio(0); } while (0)
#define PG8_WAIT_V(n) asm volatile("s_waitcnt vmcnt(" #n ")" ::: "memory")
#define PG8_WAIT_L(n) asm volatile("s_waitcnt lgkmcnt(" #n ")" ::: "memory")
#define PG8_BAR __builtin_amdgcn_s_barrier()
#define PG8_SCHED __builtin_amdgcn_sched_barrier(0)
    Unit cur, nxt; int ui = 0;
    if (!S.next(0, cur)) return;
    f32x4 acc[2][2][4][2];
#pragma unroll
    for (int a = 0; a < 2; ++a)
#pragma unroll
        for (int b = 0; b < 2; ++b)
#pragma unroll
            for (int m = 0; m < 4; ++m)
#pragma unroll
                for (int n = 0; n < 2; ++n) acc[a][b][m][n] = (f32x4){0.f, 0.f, 0.f, 0.f};
    bf16x8 At[4][2], B0[2][2], B1[2][2];
    const char* cA; const char* cB; int nt;
    P.ptrs(cur, cA, cB, nt);
    if constexpr (Prob::GATHER) P.gather(cur, pR, pC, cV);
    PG8_STAGE(PG8_SB(0, 0), cB, voffB); PG8_STAGE(PG8_SB(0, 1), cB + hstepB, voffB); PG8_STAGE(PG8_SA(0, 0), cA, cV[0]); PG8_STAGE(PG8_SA(0, 1), cA, cV[1]);
    if (wr == 1) PG8_BAR;
    PG8_WAIT_V(2); PG8_BAR;
    PG8_STAGE(PG8_SB(1, 0), cB + kstep, voffB); PG8_STAGE(PG8_SA(1, 0), cA + kstep, cV[0]); PG8_STAGE(PG8_SB(1, 1), cB + hstepB + kstep, voffB);
    PG8_WAIT_V(6); PG8_BAR;
    for (;;) {
        const bool has_next = S.next(ui + 1, nxt);
        const char* nA = cA; const char* nB = cB; int nnt = nt;
        if (has_next) { P.ptrs(nxt, nA, nB, nnt); if constexpr (Prob::GATHER) P.gather(nxt, pR, pC, nV); }
        else { if constexpr (Prob::GATHER) { nV[0][0] = cV[0][0]; nV[0][1] = cV[0][1]; nV[1][0] = cV[1][0]; nV[1][1] = cV[1][1]; } }
        for (int t = 0; t < nt; t += 2) {
            const bool last = (t == nt - 2);
            const char* a1 = cA + (size_t)(t + 1) * kstep;
            const char* a2 = last ? nA : cA + (size_t)(t + 2) * kstep; const char* b2 = last ? nB : cB + (size_t)(t + 2) * kstep;
            const char* a3 = a2 + kstep; const char* b3 = b2 + kstep;
            unsigned v2[2][2];
            if constexpr (Prob::GATHER) { v2[0][0] = last ? nV[0][0] : cV[0][0]; v2[0][1] = last ? nV[0][1] : cV[0][1]; v2[1][0] = last ? nV[1][0] : cV[1][0]; v2[1][1] = last ? nV[1][1] : cV[1][1]; }
            else { v2[0][0] = cV[0][0]; v2[0][1] = cV[0][1]; v2[1][0] = cV[1][0]; v2[1][1] = cV[1][1]; }
            PG8_LDB(B0, 0, 0); PG8_LDB(B1, 0, 1); PG8_SCHED; PG8_LDA(At, 0, 0); PG8_STAGE(PG8_SA(1, 1), a1, cV[1]);
            PG8_WAIT_V(8); PG8_WAIT_L(0); PG8_BAR; PG8_MMA(0, 0, At, B0); PG8_MMA(0, 1, At, B1); PG8_BAR; PG8_SCHED;
            PG8_LDA(At, 0, 1); PG8_STAGE(PG8_SB(0, 0), b2, voffB); PG8_STAGE(PG8_SB(0, 1), b2 + hstepB, voffB); PG8_STAGE(PG8_SA(0, 0), a2, v2[0]);
            PG8_WAIT_V(8); PG8_WAIT_L(0); PG8_BAR; PG8_MMA(1, 0, At, B0); PG8_MMA(1, 1, At, B1); PG8_BAR; PG8_SCHED;
            PG8_LDB(B0, 1, 0); PG8_LDB(B1, 1, 1); PG8_SCHED; PG8_LDA(At, 1, 0); PG8_STAGE(PG8_SA(0, 1), a2, v2[1]);
            PG8_WAIT_V(8); PG8_WAIT_L(0); PG8_BAR; PG8_MMA(0, 0, At, B0); PG8_MMA(0, 1, At, B1); PG8_BAR; PG8_SCHED;
            PG8_LDA(At, 1, 1); PG8_STAGE(PG8_SB(1, 0), b3, voffB); PG8_STAGE(PG8_SB(1, 1), b3 + hstepB, voffB); PG8_STAGE(PG8_SA(1, 0), a3, v2[0]);
            PG8_WAIT_V(8); PG8_WAIT_L(0); PG8_BAR; PG8_MMA(1, 0, At, B0); PG8_MMA(1, 1, At, B1); PG8_BAR; PG8_SCHED;
        }
        if constexpr (ALIGN_EPI) { if (wr == 0) PG8_BAR; }
        if constexpr (!Epi::AFTER_DRAIN) { E(acc, cur, wr, wc, fr, fq); }
        if (!has_next) break;
#pragma unroll
        for (int a = 0; a < 2; ++a)
#pragma unroll
            for (int b = 0; b < 2; ++b)
#pragma unroll
                for (int m = 0; m < 4; ++m)
#pragma unroll
                    for (int n = 0; n < 2; ++n) acc[a][b][m][n] = (f32x4){0.f, 0.f, 0.f, 0.f};
        cur = nxt; cA = nA; cB = nB; nt = nnt; ++ui;
        if constexpr (Prob::GATHER) { cV[0][0] = nV[0][0]; cV[0][1] = nV[0][1]; cV[1][0] = nV[1][0]; cV[1][1] = nV[1][1]; }
        if constexpr (ALIGN_EPI) { if (wr == 1) PG8_BAR; }
    }
    PG8_WAIT_V(0);
    if constexpr (!ALIGN_EPI) { if (wr == 0) PG8_BAR; }
    PG8_BAR;
    if constexpr (Epi::AFTER_DRAIN) { E.fused(acc, cur, wr, wc, fr, fq, lds, wid, lane); }
#undef PG8_SA
#undef PG8_SB
#undef PG8_STAGE
#undef PG8_LDA
#undef PG8_LDB
#undef PG8_MMA
#undef PG8_WAIT_V
#undef PG8_WAIT_L
#undef PG8_BAR
#undef PG8_SCHED
}
}
#include <hip/hip_bf16.h>
#include <cmath>
namespace attn_body {
using bf16=__hip_bfloat16;
using bf16x8=__attribute__((ext_vector_type(8)))short;
using s16x4=__attribute__((ext_vector_type(4)))short;
using f32x16=__attribute__((ext_vector_type(16)))float;
using u32x4=__attribute__((ext_vector_type(4)))unsigned;
constexpr int BATCH=8,NHEAD=8,SEQ=2048,D=64,DM=NHEAD*D,DMO=1024;
constexpr int NW=8,QBLK=32,QB=QBLK*NW,KVBLK=64,NQB=SEQ/QB;
constexpr int ATTN_PITCH=DM, ATTN_OPITCH=DMO, ATTN_UNIT_ROWS=QB;
__device__ __forceinline__ int crow(int r,int hi){return (r&3)+8*(r>>2)+4*hi;}
#define SBAR() __builtin_amdgcn_sched_barrier(0)
__device__ __forceinline__ void cmask(f32x16&p0,f32x16&p1,int jb,int qrel,int hi){
  const float NEG=-INFINITY; int kb=64*jb+4*hi;
  #pragma unroll
  for(int r=0;r<16;++r){int kv=kb+(r&3)+8*(r>>2); if(kv>qrel)p0[r]=NEG; if(kv+32>qrel)p1[r]=NEG;}
}

constexpr int NSLOT=3, SLOTB=8192;
constexpr int LDS_K=0, LDS_V=NSLOT*SLOTB, LDS_WS=2*NSLOT*SLOTB, LDS_OST=LDS_WS+NW*64*4, LDS_BIAS=LDS_OST+NW*4096, LDS_BYTES=LDS_BIAS+SEQ*4;
constexpr float C2=0.125f*1.4426950408889634f;
__device__ __forceinline__ void glds16(const void*gsrc,unsigned lds_dst){unsigned keep;
  asm volatile("s_mov_b32 %0, m0\n\ts_mov_b32 m0, %2\n\ts_nop 0\n\tglobal_load_lds_dwordx4 %1, off\n\ts_mov_b32 m0, %0":"=&s"(keep):"v"(gsrc),"s"(lds_dst):"memory");}
__device__ __forceinline__ float max3f(float a,float b,float c){float r;asm("v_max3_f32 %0, %1, %2, %3":"=v"(r):"v"(a),"v"(b),"v"(c));return r;}
__device__ __forceinline__ float max2f(float a,float b){float r;asm("v_max_f32_e32 %0, %1, %2":"=v"(r):"v"(a),"v"(b));return r;}
__device__ __forceinline__ float fadd_s(float a,float b){float r;asm("v_add_f32_e32 %0, %1, %2":"=v"(r):"v"(a),"v"(b));return r;}
__device__ __forceinline__ float fsub_s(float a,float b){float r;asm("v_sub_f32_e32 %0, %1, %2":"=v"(r):"v"(a),"v"(b));return r;}
typedef float f32x2_t __attribute__((ext_vector_type(2))); typedef float f32x4_t __attribute__((ext_vector_type(4))); typedef __bf16 bf16x2_t __attribute__((ext_vector_type(2)));
__device__ __forceinline__ unsigned cvtpk_s(float lo,float hi){f32x2_t v={lo,hi};bf16x2_t b=__builtin_convertvector(v,bf16x2_t);return __builtin_bit_cast(unsigned,b);}
#define WAIT_BAR(N) asm volatile("s_waitcnt vmcnt(" #N ") lgkmcnt(0)\n\ts_barrier":::"memory")

__device__ __forceinline__ void qkt(f32x16&p0,f32x16&p1,const char*Kslot,const bf16x8*qr,const f32x16&negm,int r32,int hi){
  const char*kb=Kslot+hi*1024+r32*16;
  #pragma unroll
  for(int d0=0;d0<4;++d0){
    const bf16x8 b0=*reinterpret_cast<const bf16x8*>(kb+d0*2048);
    const bf16x8 b1=*reinterpret_cast<const bf16x8*>(kb+d0*2048+512);
    if(d0==0){p0=__builtin_amdgcn_mfma_f32_32x32x16_bf16(b0,qr[0],negm,0,0,0);p1=__builtin_amdgcn_mfma_f32_32x32x16_bf16(b1,qr[0],negm,0,0,0);}
    else{p0=__builtin_amdgcn_mfma_f32_32x32x16_bf16(b0,qr[d0],p0,0,0,0);p1=__builtin_amdgcn_mfma_f32_32x32x16_bf16(b1,qr[d0],p1,0,0,0);}}
}
typedef __attribute__((address_space(3))) const char* lds_cptr;
typedef short v4i16_t __attribute__((ext_vector_type(4)));
__device__ __forceinline__ void kload8(bf16x8*kf,lds_cptr kp){
  kf[0]=*(const __attribute__((address_space(3))) bf16x8*)(kp);      kf[1]=*(const __attribute__((address_space(3))) bf16x8*)(kp+512);
  kf[2]=*(const __attribute__((address_space(3))) bf16x8*)(kp+2048); kf[3]=*(const __attribute__((address_space(3))) bf16x8*)(kp+2560);
  kf[4]=*(const __attribute__((address_space(3))) bf16x8*)(kp+4096); kf[5]=*(const __attribute__((address_space(3))) bf16x8*)(kp+4608);
  kf[6]=*(const __attribute__((address_space(3))) bf16x8*)(kp+6144); kf[7]=*(const __attribute__((address_space(3))) bf16x8*)(kp+6656);
}
__device__ __forceinline__ void kload2(bf16x8*kf,lds_cptr kp,int j){ kf[2*j]=*(const __attribute__((address_space(3))) bf16x8*)(kp+j*2048); kf[2*j+1]=*(const __attribute__((address_space(3))) bf16x8*)(kp+j*2048+512); }
__device__ __forceinline__ s16x4 vtr(lds_cptr p){ return __builtin_bit_cast(s16x4,__builtin_amdgcn_ds_read_tr16_b64_v4i16((__attribute__((address_space(3))) v4i16_t*)p)); }
__device__ __forceinline__ float rowmax(const f32x16&p0,const f32x16&p1){
  float a=max3f(p0[0],p0[1],p1[0]),b=max3f(p0[2],p0[3],p1[1]);a=max3f(a,p1[2],p1[3]);
  #pragma unroll
  for(int r=4;r<16;r+=4){a=max3f(a,p0[r],p0[r+1]);b=max3f(b,p0[r+2],p0[r+3]);a=max3f(a,p1[r],p1[r+1]);b=max3f(b,p1[r+2],p1[r+3]);}
  const float m=max2f(a,b);
  auto rr=__builtin_amdgcn_permlane32_swap(__float_as_uint(m),__float_as_uint(m),false,false);
  return max2f(__uint_as_float(rr[0]),__uint_as_float(rr[1]));
}
__device__ __forceinline__ void pv(f32x16*o,int vb,bf16x8 pa0,bf16x8 pa1,bf16x8 pa2,bf16x8 pa3){
  #pragma unroll
  for(int d0=0;d0<2;++d0){s16x4 lo[4],hi[4];
    #pragma unroll
    for(int ks=0;ks<4;++ks){
      asm volatile("ds_read_b64_tr_b16 %0,%1 offset:%c2":"=&v"(lo[ks]):"v"(vb),"i"(d0*4096+ks*1024):"memory");
      asm volatile("ds_read_b64_tr_b16 %0,%1 offset:%c2":"=&v"(hi[ks]):"v"(vb),"i"(d0*4096+ks*1024+512):"memory");}
    asm volatile("s_waitcnt lgkmcnt(0)":::"memory");SBAR();
    #define PK(k) (bf16x8){lo[k][0],lo[k][1],lo[k][2],lo[k][3],hi[k][0],hi[k][1],hi[k][2],hi[k][3]}
    o[d0]=__builtin_amdgcn_mfma_f32_32x32x16_bf16(pa0,PK(0),o[d0],0,0,0);
    o[d0]=__builtin_amdgcn_mfma_f32_32x32x16_bf16(pa1,PK(1),o[d0],0,0,0);
    o[d0]=__builtin_amdgcn_mfma_f32_32x32x16_bf16(pa2,PK(2),o[d0],0,0,0);
    o[d0]=__builtin_amdgcn_mfma_f32_32x32x16_bf16(pa3,PK(3),o[d0],0,0,0);
    #undef PK
  }
}

#ifndef ATTN_STORE16
#define ATTN_STORE16(p,v) (*(u32x4*)(p)=(v))
#endif
template<int THRL> __device__ __forceinline__ void attn_unit(int b,int h,int qb,const bf16*Q,const bf16*__restrict__ K,const bf16*__restrict__ V,bf16*O,const float*__restrict__ Fb,char*shm){
  asm volatile("":"+s"(Q),"+s"(K),"+s"(V),"+s"(O),"+s"(Fb));
  int tid_=threadIdx.x; asm volatile("":"+v"(tid_));
  const int tid=tid_,lane=tid&63,r32=lane&31,hi=lane>>5; const int wid=__builtin_amdgcn_readfirstlane(tid>>6);
  const long rowbase=(long)b*SEQ; const int q0=qb*QB;
  const bf16*Qw=Q+(rowbase+q0+wid*QBLK)*DM+h*D;
  const bf16*Kh=K+rowbase*DM+h*D,*Vh=V+rowbase*DM+h*D;
  const unsigned lds0=(unsigned)(uintptr_t)shm;
  float*wsf=(float*)(shm+LDS_WS)+wid*64;
  const bf16*ksrc=Kh+(long)lane*DM+wid*8;
  const bf16*vsrc=Vh+(long)(16*(wid&3)+(lane>>2))*DM+(wid>>2)*32+(lane&3)*8;
  const unsigned kdst=lds0+LDS_K+wid*1024, vdst=lds0+LDS_V+wid*1024;
  #define DMA_K(t,slot) glds16(ksrc+(long)(t)*KVBLK*DM,(unsigned)__builtin_amdgcn_readfirstlane(kdst+(slot)))
  #define DMA_V(t,slot) glds16(vsrc+(long)(t)*KVBLK*DM,(unsigned)__builtin_amdgcn_readfirstlane(vdst+(slot)))
  const int vb0=(int)(lds0+LDS_V)+((lane>>4)&1)*32+(lane&3)*8+(4*hi+((lane&15)>>2))*64;
  const char*Kbase=shm+LDS_K; bf16x8 kf[8];
  const lds_cptr shm3=(lds_cptr)shm; const lds_cptr kp0=shm3+LDS_K+hi*1024+r32*16; const lds_cptr vp0=shm3+LDS_V+((lane>>4)&1)*32+(lane&3)*8+(4*hi+((lane&15)>>2))*64;
  const int NT=(q0+QB)/KVBLK;
  glds16(Fb+wid*256+lane*4,(unsigned)__builtin_amdgcn_readfirstlane(lds0+LDS_BIAS+wid*1024));
  DMA_K(0,0);DMA_V(0,0);DMA_K(1,SLOTB);
  bf16x8 qr[4];
  #pragma unroll
  for(int d0=0;d0<4;++d0)qr[d0]=*reinterpret_cast<const bf16x8*>(&Qw[(long)r32*DM+d0*16+hi*8]);
  float mhat=0.f,l_reg=0.f;f32x16 o[2];o[0]=f32x16{};o[1]=f32x16{};f32x16 negm;
  #pragma unroll
  for(int r=0;r<16;++r)asm volatile("v_mov_b32 %0, 0":"=v"(negm[r]));
  asm volatile("":"+v"(negm));
  const int qrel=wid*QBLK+r32;
  #define CMASK(P0,P1,t) do{int jb_=(t)-(NT-4); if(jb_>=0)cmask(P0,P1,jb_,qrel,hi);}while(0)
  #define BIAS(P0,P1,t) do{ const __attribute__((address_space(3))) f32x4_t* bp_=(const __attribute__((address_space(3))) f32x4_t*)(shm3+LDS_BIAS)+(t)*16+hi; \
    _Pragma("unroll") for(int j_=0;j_<4;++j_){ const f32x4_t b0_=bp_[2*j_], b1_=bp_[8+2*j_]; \
      P0[4*j_]+=b0_[0]; P0[4*j_+1]+=b0_[1]; P0[4*j_+2]+=b0_[2]; P0[4*j_+3]+=b0_[3]; \
      P1[4*j_]+=b1_[0]; P1[4*j_+1]+=b1_[1]; P1[4*j_+2]+=b1_[2]; P1[4*j_+3]+=b1_[3]; } }while(0)
  bool resc=false;
  #define START(P0,P1) do{ const float rm=rowmax(P0,P1); resc=false; \
    { const float dl=rm; mhat=fadd_s(mhat,dl); \
      _Pragma("unroll") for(int r=0;r<16;++r){P0[r]=fsub_s(P0[r],dl);P1[r]=fsub_s(P1[r],dl);} \
      _Pragma("unroll") for(int r=0;r<16;++r)negm[r]=-mhat; asm volatile("":"+v"(negm)); } \
    _Pragma("unroll") for(int r=0;r<16;++r)P0[r]=__builtin_amdgcn_exp2f(P0[r]); }while(0)
  #define RESC() do{ if(resc){ asm volatile("s_waitcnt lgkmcnt(0)":::"memory"); \
      _Pragma("unroll") for(int d_=0;d_<2;++d_) _Pragma("unroll") for(int r=0;r<16;++r)o[d_][r]*=wsf[crow(r,hi)]; } }while(0)
  f32x16 pA0,pA1,pB0,pB1;
  int sl_prev=0,sl_cur=0,sl_next=SLOTB;
  #define ROT() do{sl_prev=sl_cur;sl_cur=sl_next;sl_next=(sl_next==(NSLOT-1)*SLOTB)?0:sl_next+SLOTB;}while(0)
  DMA_K(2,2*SLOTB);
  WAIT_BAR(3);
  qkt(pA0,pA1,Kbase,qr,negm,r32,hi);asm volatile("s_nop 15\n\ts_nop 7":"+v"(pA0),"+v"(pA1));BIAS(pA0,pA1,0);CMASK(pA0,pA1,0);
  START(pA0,pA1);
  _Pragma("unroll") for(int r=0;r<16;++r)pA1[r]=__builtin_amdgcn_exp2f(pA1[r]);
  WAIT_BAR(0);
  DMA_K(3,0);DMA_V(1,SLOTB);
  ROT();
  kload8(kf,kp0+sl_cur);
  WAIT_BAR(2);
  s16x4 vlo[8],vhi[8]; u32x4 pw0,pw1,pw2,pw3;
  #define PKW(P,B) cvtpk_s(P[B],P[B+1])
  #define PAF(k) __builtin_bit_cast(bf16x8,pw##k)
  #define VFR(i) (bf16x8){vlo[i][0],vlo[i][1],vlo[i][2],vlo[i][3],vhi[i][0],vhi[i][1],vhi[i][2],vhi[i][3]}
  #define PIN(x) asm volatile("":"+v"(x))
  #define MX3(a,b,c) __builtin_fmaxf(__builtin_fmaxf((a),(b)),(c))
  #define GAPA(MF,A0,A1,A2,A3,W0,W1,PW) do{ MF; sacc+=A0; sacc+=A1; sacc+=A2; sacc+=A3; PIN(sacc); W0; W1; PIN(PW); SBAR(); }while(0)
  #define EX(v) __builtin_amdgcn_exp2f(v)
  #define GAPB(MF,X,B) do{ MF; X[B]=EX(X[B]); X[B+1]=EX(X[B+1]); X[B+2]=EX(X[B+2]); X[B+3]=EX(X[B+3]); PIN(X); SBAR(); }while(0)
  #define VRD(i) do{ vlo[i]=vtr(vp_+(((i)>>2)*4096+((i)&3)*1024)); vhi[i]=vtr(vp_+(((i)>>2)*4096+((i)&3)*1024+512)); }while(0)
  #define KRD(G,j) do{ if(G){ kload2(kf,kp0+sl_next,j); SBAR(); } }while(0)
  #define STEP(C0,C1,P0,P1,t,GK,GV,GL) do{ SBAR(); \
    const lds_cptr vp_=vp0+sl_prev; \
    VRD(0); SBAR(); float sacc=(P0[0]+P0[1]); \
    GAPA(C0=__builtin_amdgcn_mfma_f32_32x32x16_bf16(kf[0],qr[0],negm,0,0,0), P0[2],P0[3],P0[4],P0[5],     pw0[0]=PKW(P0,0), pw0[1]=PKW(P0,2), pw0); \
    VRD(4); SBAR(); GAPA(C1=__builtin_amdgcn_mfma_f32_32x32x16_bf16(kf[1],qr[0],negm,0,0,0), P0[6],P0[7],P0[8],P0[9],     pw0[2]=PKW(P0,4), pw0[3]=PKW(P0,6), pw0); \
    VRD(1); SBAR(); GAPA(C0=__builtin_amdgcn_mfma_f32_32x32x16_bf16(kf[2],qr[1],C0,0,0,0),   P0[10],P0[11],P0[12],P0[13], pw1[0]=PKW(P0,8), pw1[1]=PKW(P0,10), pw1); \
    VRD(5); SBAR(); GAPA(C1=__builtin_amdgcn_mfma_f32_32x32x16_bf16(kf[3],qr[1],C1,0,0,0),   P0[14],P0[15],P1[0],P1[1],   pw1[2]=PKW(P0,12),pw1[3]=PKW(P0,14), pw1); \
    VRD(2); SBAR(); GAPA(C0=__builtin_amdgcn_mfma_f32_32x32x16_bf16(kf[4],qr[2],C0,0,0,0),   P1[2],P1[3],P1[4],P1[5],     pw2[0]=PKW(P1,0), pw2[1]=PKW(P1,2), pw2); \
    VRD(6); SBAR(); GAPA(C1=__builtin_amdgcn_mfma_f32_32x32x16_bf16(kf[5],qr[2],C1,0,0,0),   P1[6],P1[7],P1[8],P1[9],     pw2[2]=PKW(P1,4), pw2[3]=PKW(P1,6), pw2); \
    VRD(3); SBAR(); GAPA(C0=__builtin_amdgcn_mfma_f32_32x32x16_bf16(kf[6],qr[3],C0,0,0,0),   P1[10],P1[11],P1[12],P1[13], pw3[0]=PKW(P1,8), pw3[1]=PKW(P1,10), pw3); \
    VRD(7); SBAR(); GAPA(C1=__builtin_amdgcn_mfma_f32_32x32x16_bf16(kf[7],qr[3],C1,0,0,0),   P1[14],P1[15],0.f,0.f,       pw3[2]=PKW(P1,12),pw3[3]=PKW(P1,14), pw3); \
    l_reg+=sacc; \
    if(GK){DMA_K((t)+3,sl_cur);} if(GV){DMA_V((t)+1,sl_next);} \
    BIAS(C0,C1,t); CMASK(C0,C1,t); \
    { float a=MX3(C0[0],C0[1],C1[0]),b=MX3(C0[2],C0[3],C1[1]); a=MX3(a,C1[2],C1[3]); \
      _Pragma("unroll") for(int r=4;r<16;r+=4){a=MX3(a,C0[r],C0[r+1]);b=MX3(b,C0[r+2],C0[r+3]);a=MX3(a,C1[r],C1[r+1]);b=MX3(b,C1[r+2],C1[r+3]);} \
      float rm=__builtin_fmaxf(a,b); { auto rr=__builtin_amdgcn_permlane32_swap(__float_as_uint(rm),__float_as_uint(rm),false,false); rm=__builtin_fmaxf(__uint_as_float(rr[0]),__uint_as_float(rr[1])); } \
      resc=false; \
      if(__builtin_expect(__any(rm>(float)THRL),0)){ const float dl=__builtin_fmaxf(rm,0.f); mhat+=dl; \
        _Pragma("unroll") for(int r=0;r<16;++r){C0[r]-=dl;C1[r]-=dl;} \
        _Pragma("unroll") for(int r=0;r<16;++r)negm[r]=-mhat; asm volatile("":"+v"(negm)); \
        const float f=__builtin_amdgcn_exp2f(-dl); l_reg*=f; if(hi==0)wsf[r32]=f; resc=true; } } \
    SBAR(); \
    GAPB(o[0]=__builtin_amdgcn_mfma_f32_32x32x16_bf16(PAF(0),VFR(0),o[0],0,0,0), C0,0); \
    GAPB(o[1]=__builtin_amdgcn_mfma_f32_32x32x16_bf16(PAF(0),VFR(4),o[1],0,0,0), C0,4); \
    KRD(GL,0); GAPB(o[0]=__builtin_amdgcn_mfma_f32_32x32x16_bf16(PAF(1),VFR(1),o[0],0,0,0), C0,8); \
    KRD(GL,1); GAPB(o[1]=__builtin_amdgcn_mfma_f32_32x32x16_bf16(PAF(1),VFR(5),o[1],0,0,0), C0,12); \
    KRD(GL,2); GAPB(o[0]=__builtin_amdgcn_mfma_f32_32x32x16_bf16(PAF(2),VFR(2),o[0],0,0,0), C1,0); \
    KRD(GL,3); GAPB(o[1]=__builtin_amdgcn_mfma_f32_32x32x16_bf16(PAF(2),VFR(6),o[1],0,0,0), C1,4); \
    GAPB(o[0]=__builtin_amdgcn_mfma_f32_32x32x16_bf16(PAF(3),VFR(3),o[0],0,0,0), C1,8); \
    GAPB(o[1]=__builtin_amdgcn_mfma_f32_32x32x16_bf16(PAF(3),VFR(7),o[1],0,0,0), C1,12); \
    }while(0)
  int t=1;
  #undef CMASK
  #define CMASK(P0,P1,t) do{}while(0)
  for(;t+5<NT;t+=2){
    STEP(pB0,pB1,pA0,pA1,t,true,true,true);     WAIT_BAR(2); RESC(); ROT();
    STEP(pA0,pA1,pB0,pB1,t+1,true,true,true);   WAIT_BAR(2); RESC(); ROT();
  }
  #undef CMASK
  #define CMASK(P0,P1,t) do{int jb_=(t)-(NT-4); if(jb_>=0)cmask(P0,P1,jb_,qrel,hi);}while(0)
  #define ENDW(tt) do{ if((tt)+3<NT){WAIT_BAR(2);} else if((tt)+2<NT){WAIT_BAR(1);} else {WAIT_BAR(0);} }while(0)
  for(;t+1<NT;t+=2){
    STEP(pB0,pB1,pA0,pA1,t,(t+3<NT),(t+1<NT),(t+1<NT));       ENDW(t);   RESC(); ROT();
    STEP(pA0,pA1,pB0,pB1,t+1,(t+4<NT),(t+2<NT),(t+2<NT));     ENDW(t+1); RESC(); ROT();
  }
  STEP(pB0,pB1,pA0,pA1,NT-1,false,false,false); RESC();
  { float sacc=pB0[0]+pB0[1]; _Pragma("unroll") for(int r=2;r<16;++r)sacc+=pB0[r]; _Pragma("unroll") for(int r=0;r<16;++r)sacc+=pB1[r]; l_reg+=sacc;
    pw0=(u32x4){PKW(pB0,0),PKW(pB0,2),PKW(pB0,4),PKW(pB0,6)};pw1=(u32x4){PKW(pB0,8),PKW(pB0,10),PKW(pB0,12),PKW(pB0,14)};pw2=(u32x4){PKW(pB1,0),PKW(pB1,2),PKW(pB1,4),PKW(pB1,6)};pw3=(u32x4){PKW(pB1,8),PKW(pB1,10),PKW(pB1,12),PKW(pB1,14)};
    SBAR(); pv(o,vb0+sl_cur,PAF(0),PAF(1),PAF(2),PAF(3)); }
  #undef PKW
  #undef PAF
  #undef VFR
  #undef PIN
  #undef MX3
  #undef GAPA
  #undef GAPB
  #undef EX
  #undef VRD
  #undef KRD
  #undef STEP
  #undef ENDW
  {auto rr=__builtin_amdgcn_permlane32_swap(__float_as_uint(l_reg),__float_as_uint(l_reg),false,false);l_reg=__uint_as_float(rr[0])+__uint_as_float(rr[1]);}
  if(hi==0)wsf[32+r32]=l_reg;asm volatile("s_waitcnt lgkmcnt(0)":::"memory");
  float rli[16];
  #pragma unroll
  for(int r=0;r<16;++r)rli[r]=__builtin_amdgcn_rcpf(wsf[32+crow(r,hi)]);
  bf16*Ow=O+(rowbase+q0+wid*QBLK)*DMO+h*D;
  { bf16*stg=(bf16*)(shm+LDS_OST)+wid*2048;
    #pragma unroll
    for(int r=0;r<16;++r){const int orow=crow(r,hi);
      #pragma unroll
      for(int d0=0;d0<2;++d0)stg[orow*64+d0*32+r32]=__float2bfloat16(o[d0][r]*rli[r]);}
    asm volatile("s_waitcnt lgkmcnt(0)":::"memory");
    #pragma unroll
    for(int i=0;i<4;++i){const int row=i*8+(lane>>3),ch=lane&7; const u32x4 v=*(const u32x4*)(stg+row*64+ch*8); ATTN_STORE16(Ow+(long)row*DMO+ch*8,v);} }
  asm volatile("s_waitcnt lgkmcnt(0)\n\ts_barrier":::"memory");
  #undef DMA_K
  #undef DMA_V
  #undef CMASK
  #undef START
  #undef RESC
  #undef ROT
}
constexpr int ATTN_LDS_BYTES=LDS_BYTES;
struct AttnTensors { const bf16* Q; const bf16* K; const bf16* V; bf16* O; const float* Fneg; };
struct AttnUnit { int bh; int qb; };
struct StaticOrder {
  int vcu;
  __device__ __forceinline__ explicit StaticOrder(int grid,int block):vcu((block%8)*(grid/8)+block/8){}
  __device__ __forceinline__ bool next(int i,AttnUnit&u)const{ if(i>=2||vcu>=256)return false; const int s=vcu&3; u.bh=vcu>>2; u.qb=(i==0)?s:7-s; return true; }
  __device__ __forceinline__ void a_ready(const AttnUnit&)const{}
  __device__ __forceinline__ void done(const AttnUnit&)const{}
};
template<class Sched,int THRL=8> __device__ __forceinline__ void attn_phase(char*lds,const AttnTensors&T,const Sched&S){
  AttnUnit u;
  for(int i=0;S.next(i,u);++i){ S.a_ready(u); attn_unit<THRL>(u.bh/NHEAD,u.bh%NHEAD,u.qb,T.Q,T.K,T.V,T.O,T.Fneg+(long)u.bh*SEQ,lds); S.done(u); }
}
#undef SBAR
#undef WAIT_BAR
}
#define GAS __attribute__((address_space(1)))
#define LAS __attribute__((address_space(3)))
typedef unsigned short bf16;
typedef unsigned v4u __attribute__((ext_vector_type(4)));
typedef float f32x4 __attribute__((ext_vector_type(4)));
typedef short bf16x8 __attribute__((ext_vector_type(8)));
typedef GAS unsigned gu32;
typedef GAS unsigned long long gu64;
#define RLX_AGENT __ATOMIC_RELAXED, __HIP_MEMORY_SCOPE_AGENT
#define LDS_WAIT() asm volatile("s_waitcnt lgkmcnt(0)" ::: "memory")
#define VM_WAIT() asm volatile("s_waitcnt vmcnt(0)" ::: "memory")
__device__ __forceinline__ unsigned long long rt() { return __builtin_amdgcn_s_memrealtime(); }
__device__ __forceinline__ unsigned f2bf(float f) { unsigned u = __builtin_bit_cast(unsigned, f); return (u + 0x7fffu + ((u >> 16) & 1u)) >> 16; }
__device__ __forceinline__ unsigned pk2(float lo, float hi) { return f2bf(lo) | (f2bf(hi) << 16); }

#define XB_TMO      128
#define XB_XCNT(j)  (256  + 64 * (j))
#define XB_XSUB(j)  (1280 + 64 * (j))
#define XB_XGEN(j)  (2304 + 64 * (j))
#define XB_TOP      3328
#define XB_TOPGEN   3392
#define XCD_BAR_WORDS 3456
#define XB_SPIN_CAP (1u << 18)

__device__ __forceinline__ unsigned xb_ld(unsigned* p)              { return __hip_atomic_load(p, __ATOMIC_RELAXED, __HIP_MEMORY_SCOPE_AGENT); }
__device__ __forceinline__ unsigned xb_add(unsigned* p, unsigned v) { return __hip_atomic_fetch_add(p, v, __ATOMIC_RELAXED, __HIP_MEMORY_SCOPE_AGENT); }
__device__ __forceinline__ unsigned xb_xcc_id() { return (unsigned)__builtin_amdgcn_s_getreg((3 << 11) | 20) & 0xFu; }
#define XB_SPIN(cond, bar) do { unsigned _sp = 0; while (cond) { __builtin_amdgcn_s_sleep(1); \
    if ((++_sp & 255u) == 0u) { if (xb_ld(&(bar)[XB_TMO])) break; if (_sp > XB_SPIN_CAP) { atomicAdd(&(bar)[XB_TMO], 1u); break; } } } } while (0)

struct XcdBarrier {
    unsigned* bar; unsigned x;
    volatile LAS unsigned* st;
};

__device__ __forceinline__ XcdBarrier xcd_barrier_post(unsigned* bar, volatile LAS unsigned* st) {
    XcdBarrier b; b.bar = bar; b.x = xb_xcc_id(); b.st = st;
    if (threadIdx.x == 0) (void)xb_add(&bar[XB_XCNT(b.x)], 1u);
    return b;
}
__device__ __forceinline__ void xcd_barrier_complete(unsigned* bar, unsigned x, unsigned& nloc, unsigned& nx) {
    const unsigned G = gridDim.x * gridDim.y * gridDim.z;
    unsigned sum, cnt, mine, sp = 0u;
    for (;;) {
        sum = 0u; cnt = 0u; mine = 0u;
#pragma unroll
        for (unsigned j = 0; j < 16; ++j) { const unsigned c = xb_ld(&bar[XB_XCNT(j)]); sum += c; cnt += (c > 0u) ? 1u : 0u; mine = (j == x) ? c : mine; }
        if (sum == G) break;
        __builtin_amdgcn_s_sleep(1);
        if ((++sp & 255u) == 0u) { if (xb_ld(&bar[XB_TMO])) break; if (sp > XB_SPIN_CAP) { atomicAdd(&bar[XB_TMO], 1u); break; } }
    }
    nloc = mine > 0u ? mine : 1u; nx = cnt > 0u ? cnt : 1u;
}

__device__ __forceinline__ void xcd_barrier(const XcdBarrier& b) {
    asm volatile("s_waitcnt vmcnt(0)" ::: "memory");
    __syncthreads();
    if (threadIdx.x == 0) {
        unsigned* bar = b.bar;
        __builtin_amdgcn_s_waitcnt(0);
        unsigned nloc = b.st[0], nx = b.st[1];
        if (nloc == 0u) { xcd_barrier_complete(bar, b.x, nloc, nx); b.st[0] = nloc; b.st[1] = nx; }
        const unsigned old = xb_add(&bar[XB_XSUB(b.x)], 1u);
        const unsigned gen = old / nloc;
        if (old + 1u == (gen + 1u) * nloc) {
            __builtin_amdgcn_fence(__ATOMIC_RELEASE, "agent");
            asm volatile("s_waitcnt vmcnt(0)" ::: "memory");
            const unsigned og = xb_add(&bar[XB_TOP], 1u);
            const unsigned tg = og / nx;
            if (og + 1u == (tg + 1u) * nx) xb_add(&bar[XB_TOPGEN], 1u);
            else XB_SPIN(xb_ld(&bar[XB_TOPGEN]) == tg, bar);
            __builtin_amdgcn_fence(__ATOMIC_ACQUIRE, "agent");
            xb_add(&bar[XB_XGEN(b.x)], 1u);
            asm volatile("s_waitcnt vmcnt(0)" ::: "memory");
        } else {
            XB_SPIN(xb_ld(&bar[XB_XGEN(b.x)]) == gen, bar);
            __builtin_amdgcn_fence(__ATOMIC_ACQUIRE, "agent");
            asm volatile("s_waitcnt vmcnt(0)" ::: "memory");
        }
    }
    __syncthreads();
}

constexpr int NWAVES = 8;
constexpr int NB = 8, SEQ = 2048, M = NB * SEQ, D = 1024, NH = 8, DH = 64, FW = 512, PW = 512, INW = 2056, DFF = 2816, NE = 8;
constexpr int SG = 64, SGH = 16, SP = 64;
constexpr int CL = 32, NCH = SEQ / CL, NBC = NB * NCH, KA = 2 * SP + CL * SGH;
constexpr float EPS = 1e-6f, LOG2E = 1.4426950408889634f;
static_assert(KA == 640 && NBC == 512, "ssm chunk geometry");

constexpr size_t MiB = 1u << 20, KiB = 1024;
constexpr size_t WS_CTL = 0, CTL_ZERO_BYTES = 1 * MiB;
constexpr size_t WS_LOGF = 1 * MiB;
constexpr size_t WS_FNEG = WS_LOGF + 512 * KiB;
constexpr size_t WS_SSQ1 = 2 * MiB;
constexpr size_t WS_SSQ2 = WS_SSQ1 + 256 * KiB;
constexpr size_t WS_AL   = WS_SSQ2 + 256 * KiB;
constexpr size_t WS_TOKE = WS_AL + 64 * KiB;
constexpr size_t WS_GATE = WS_TOKE + 64 * KiB;
constexpr size_t WS_POS  = WS_GATE + 128 * KiB;
constexpr size_t WS_CNT  = WS_POS + 128 * KiB;
constexpr size_t WS_TAB  = WS_CNT + 16 * KiB;
constexpr size_t WS_TOKS = WS_TAB + 16 * KiB;
static_assert(WS_TOKS + (2 * M + 256) * 4 <= 4 * MiB, "small tables");
constexpr size_t WS_WIN0 = 4 * MiB;
constexpr size_t WS_WOT  = 8 * MiB;
constexpr size_t WS_W13  = 10 * MiB;
constexpr size_t WS_W2T  = 21 * MiB;
constexpr size_t WS_WIN1 = 27 * MiB;
constexpr size_t WS_WGLU = 29 * MiB;
constexpr size_t WS_W13E = 34 * MiB;
constexpr size_t WS_BT2  = 34 * MiB;
constexpr size_t WS_MG   = 74 * MiB;
constexpr size_t WS_YS   = 34 * MiB;
constexpr size_t WS_W2E  = 122 * MiB;
constexpr size_t WS_R    = 166 * MiB;
constexpr size_t WS_H0   = WS_R;
constexpr size_t WS_QKVP = WS_R + 32 * MiB;
constexpr size_t WS_ACT0 = WS_R + 96 * MiB;
constexpr size_t WS_ACTS = WS_R;
constexpr size_t WS_H3   = 344 * MiB;
constexpr size_t WS_END  = 376 * MiB;
static_assert(WS_ACTS + (size_t)(2 * M + 256) * DFF * 2 <= WS_H3 && WS_ACT0 + (size_t)M * DFF * 2 <= WS_END && WS_W13E + (size_t)NE * 2 * DFF * D * 2 <= WS_W2E && WS_W2E + (size_t)NE * D * DFF * 2 <= WS_R, "d_ws map");
static_assert(WS_MG + (size_t)SG * 128 * 512 * 2 <= WS_W2E && WS_BT2 + (size_t)SG * 512 * KA * 2 <= WS_MG && WS_YS + (size_t)(2 * M + 256) * D * 2 <= WS_W2E, "d_ws map 2");
constexpr int CW_BAR = 4096;

constexpr int RING_OFF = 0, RING_BYTES = 131072;
constexpr int LDSCTL_OFF = RING_BYTES, MISC_OFF = LDSCTL_OFF + 320;
constexpr int LDS_BYTES = 147456;
static_assert(MISC_OFF + 128 <= LDS_BYTES && attn_body::ATTN_LDS_BYTES <= RING_BYTES, "LDS map");

struct Args { const float* in[30]; float* out; unsigned char* ws; int ph_lo, ph_hi; };
enum { I_X = 0, I_N0, I_WIN0, I_BF, I_WPOOL, I_PSCALE, I_WOUT, I_N1, I_W1, I_W3, I_W2, I_N2, I_WIN1, I_ARE, I_AIM, I_LOGDT, I_BRE, I_BIM, I_CRE, I_CIM, I_SD, I_GA, I_GB, I_N3, I_RW, I_RB, I_EW1, I_EW3, I_EW2, I_NF };

__device__ __forceinline__ float wave_sum(float v) {
#pragma unroll
    for (int o = 1; o < 64; o <<= 1) v += __shfl_xor(v, o);
    return v;
}
__device__ __forceinline__ void transpose_item(const float* W, int ldw, int k0, int c0, const float* gain, bf16* WT, int ldt, int drow0, LAS float* scr, int lane) {
#pragma unroll 8
    for (int i = 0; i < 32; ++i) { const int kk = 2 * i + (lane >> 5); float v = W[(size_t)(k0 + kk) * ldw + c0 + (lane & 31)]; if (gain) v *= gain[k0 + kk]; scr[kk * 33 + (lane & 31)] = v; }
    LDS_WAIT(); asm volatile("" ::: "memory");
    const int c = lane & 7;
#pragma unroll
    for (int j = 0; j < 4; ++j) { const int n = (lane >> 3) + 8 * j; const LAS float* s = scr + (8 * c) * 33 + n;
        v4u o; o.x = pk2(s[0 * 33], s[1 * 33]); o.y = pk2(s[2 * 33], s[3 * 33]); o.z = pk2(s[4 * 33], s[5 * 33]); o.w = pk2(s[6 * 33], s[7 * 33]);
        *(GAS v4u*)(WT + (size_t)(drow0 + n) * ldt + k0 + 8 * c) = o; }
    LDS_WAIT(); asm volatile("" ::: "memory");
}

struct PlainProb {
    static constexpr bool GATHER = false;
    const bf16* A; const bf16* Bt; int lda, ldb, ntk;
    __device__ __forceinline__ void ptrs(const pg8::Unit& u, const char*& a, const char*& b, int& nt) const { a = (const char*)(A + (size_t)u.pm * 256 * lda); b = (const char*)(Bt + (size_t)u.pn * 256 * ldb); nt = ntk; }
    __device__ __forceinline__ void gather(const pg8::Unit&, const int (&)[2], const int (&)[2], unsigned (&)[2][2]) const {}
};
struct SsmProb {
    static constexpr bool GATHER = false;
    const bf16* AG; const bf16* BT; int lda, ldb;
    __device__ __forceinline__ void ptrs(const pg8::Unit& u, const char*& a, const char*& b, int& nt) const {
        a = (const char*)(AG + ((size_t)u.x2 * NBC + (size_t)u.pm * 256) * KA); b = (const char*)(BT + ((size_t)u.x2 * 512 + (size_t)u.pn * 256) * KA); nt = 6 + 4 * u.pn; }
    __device__ __forceinline__ void gather(const pg8::Unit&, const int (&)[2], const int (&)[2], unsigned (&)[2][2]) const {}
};
struct SsmOrder {
    int vcu, G;
    __device__ __forceinline__ bool next(int i, pg8::Unit& u) const { const int L = i * G + vcu; if (L >= 256) return false; u.x2 = L >> 2; u.pm = (L >> 1) & 1; u.pn = L & 1; u.x0 = 0; u.x1 = 0; return true; }
};
struct MoeOrder : pg8::GridOrder {
    const unsigned* tab;
    __device__ __forceinline__ bool next(int i, pg8::Unit& u) const {
        if (!tile(i, u.pm, u.pn)) return false;
        int e = 0;
#pragma unroll
        for (int k = 1; k < NE; ++k) e += ((int)tab[16 + k] <= u.pm) ? 1 : 0;
        u.x2 = e; u.x0 = (int)tab[e] + 256 * (u.pm - (int)tab[16 + e]); u.x1 = (int)tab[e + 1]; return true;
    }
};
struct MoeUpProb {
    static constexpr bool GATHER = true;
    const bf16* H3; const bf16* W; const unsigned* toks; int lda, ldb;
    __device__ __forceinline__ void ptrs(const pg8::Unit& u, const char*& a, const char*& b, int& nt) const { a = (const char*)H3; b = (const char*)(W + ((size_t)u.x2 * (2 * DFF) + (size_t)u.pn * 256) * D); nt = D / 64; }
    __device__ __forceinline__ void gather(const pg8::Unit& u, const int (&pR)[2], const int (&pC)[2], unsigned (&V)[2][2]) const {
#pragma unroll
        for (int h = 0; h < 2; ++h)
#pragma unroll
            for (int i = 0; i < 2; ++i) V[h][i] = toks[u.x0 + 128 * h + pR[i]] * (unsigned)(D * 2) + (unsigned)(pC[i] * 2);
    }
};
struct MoeDownProb {
    static constexpr bool GATHER = false;
    const bf16* ACTS; const bf16* W; int lda, ldb;
    __device__ __forceinline__ void ptrs(const pg8::Unit& u, const char*& a, const char*& b, int& nt) const { a = (const char*)(ACTS + (size_t)u.x0 * DFF); b = (const char*)(W + ((size_t)u.x2 * D + (size_t)u.pn * 256) * DFF); nt = DFF / 64; }
    __device__ __forceinline__ void gather(const pg8::Unit&, const int (&)[2], const int (&)[2], unsigned (&)[2][2]) const {}
};

using pg8::u32x4; using pg8::Unit; using pg8::cvt_pk_bf16;
#define ACC_T const pg8::f32x4 (&acc)[2][2][4][2]

struct EpiSplitBf16 {
    static constexpr bool PERM = true, AFTER_DRAIN = false;
    bf16* O; float scale0;
    __device__ __forceinline__ void operator()(ACC_T, const Unit& u, int wr, int wc, int fr, int fq) const {
        const int t = u.pn >> 1; bf16* base = O + (size_t)t * M * 512; const float sc = (t == 0) ? scale0 : 1.f;
        const int row0 = u.pm * 256 + wr * 64 + fr, col0 = (u.pn & 1) * 256 + wc * 32 + 8 * fq;
#pragma unroll
        for (int ai = 0; ai < 2; ++ai)
#pragma unroll
            for (int m = 0; m < 4; ++m) { bf16* rowp = base + (size_t)(row0 + ai * 128 + m * 16) * 512 + col0;
#pragma unroll
                for (int bj = 0; bj < 2; ++bj) { const f32x4 v0 = acc[ai][bj][m][0] * sc, v1 = acc[ai][bj][m][1] * sc;
                    u32x4 w; w.x = cvt_pk_bf16(v0[0], v0[1]); w.y = cvt_pk_bf16(v0[2], v0[3]); w.z = cvt_pk_bf16(v1[0], v1[1]); w.w = cvt_pk_bf16(v1[2], v1[3]);
                    *(u32x4*)(rowp + bj * 128) = w; } }
    }
};
struct EpiResid {
    static constexpr bool PERM = false, AFTER_DRAIN = true;
    const float* base; float* out; bf16* outb; float* ssq;
    __device__ __forceinline__ void fused(pg8::f32x4 (&acc)[2][2][4][2], const Unit& u, int wr, int wc, int fr, int fq, LAS unsigned char* lds, int wid, int lane) const {
        LAS float* Pq = (LAS float*)lds;
        const int col0 = u.pn * 256 + wc * 32 + 4 * fq;
#pragma unroll
        for (int ai = 0; ai < 2; ++ai)
#pragma unroll
            for (int m = 0; m < 4; ++m) { const int rl = ai * 128 + wr * 64 + m * 16 + fr; const size_t off = (size_t)(u.pm * 256 + rl) * D + col0; float s = 0.f;
#pragma unroll
                for (int bj = 0; bj < 2; ++bj)
#pragma unroll
                    for (int n = 0; n < 2; ++n) { const f32x4 o = *(const f32x4*)(base + off + bj * 128 + n * 16) + acc[ai][bj][m][n];
                        *(f32x4*)(out + off + bj * 128 + n * 16) = o; pg8::u32x2 w; w.x = cvt_pk_bf16(o[0], o[1]); w.y = cvt_pk_bf16(o[2], o[3]); *(pg8::u32x2*)(outb + off + bj * 128 + n * 16) = w;
                        s += (o[0] * o[0] + o[1] * o[1]) + (o[2] * o[2] + o[3] * o[3]); }
                s += __shfl_xor(s, 16); s += __shfl_xor(s, 32);
                if (fq == 0) Pq[rl * 4 + wc] = s;
                if (m & 1) asm volatile("" ::: "memory"); }
        asm volatile("s_waitcnt lgkmcnt(0)" ::: "memory"); __builtin_amdgcn_s_barrier(); asm volatile("" ::: "memory");
        const int tid = wid * 64 + lane;
        if (tid < 256) { const f32x4 p = *(const LAS f32x4*)(Pq + tid * 4); ssq[(size_t)(u.pm * 256 + tid) * 4 + u.pn] = (p[0] + p[1]) + (p[2] + p[3]); }
    }
};
template <bool MASKED> struct EpiSwiglu {
    static constexpr bool PERM = true, AFTER_DRAIN = false;
    bf16* O; const float* ssq;
    __device__ __forceinline__ void operator()(ACC_T, const Unit& u, int wr, int wc, int fr, int fq) const {
        const int rbase = MASKED ? u.x0 : u.pm * 256; const int col0 = u.pn * 128 + wc * 32 + 8 * fq;
#pragma unroll
        for (int ai = 0; ai < 2; ++ai)
#pragma unroll
            for (int m = 0; m < 4; ++m) { const int row = rbase + ai * 128 + wr * 64 + m * 16 + fr; float rs = 1.f;
                if (ssq) { const f32x4 q = *(const f32x4*)(ssq + (size_t)row * 4); rs = __builtin_amdgcn_rsqf(((q[0] + q[1]) + (q[2] + q[3])) * (1.0f / D) + EPS); }
                const f32x4 a0 = acc[ai][0][m][0] * rs, a1 = acc[ai][0][m][1] * rs, b0 = acc[ai][1][m][0] * rs, b1 = acc[ai][1][m][1] * rs;
                float v[8];
#pragma unroll
                for (int i = 0; i < 4; ++i) { v[i] = a0[i] * pg8::fast_sigmoid(a0[i]) * b0[i]; v[4 + i] = a1[i] * pg8::fast_sigmoid(a1[i]) * b1[i]; }
                u32x4 w; w.x = cvt_pk_bf16(v[0], v[1]); w.y = cvt_pk_bf16(v[2], v[3]); w.z = cvt_pk_bf16(v[4], v[5]); w.w = cvt_pk_bf16(v[6], v[7]);
                if (!MASKED || row < u.x1) *(u32x4*)(O + (size_t)row * DFF + col0) = w; }
    }
};
struct EpiSsmU {
    static constexpr bool PERM = true, AFTER_DRAIN = false;
    bf16* AG; const float* ssq;
    __device__ __forceinline__ void operator()(ACC_T, const Unit& u, int wr, int wc, int fr, int fq) const {
#pragma unroll
        for (int ai = 0; ai < 2; ++ai)
#pragma unroll
            for (int m = 0; m < 4; ++m) { const int row = u.pm * 256 + ai * 128 + wr * 64 + m * 16 + fr; const f32x4 q = *(const f32x4*)(ssq + (size_t)row * 4);
                const float rs = __builtin_amdgcn_rsqf(((q[0] + q[1]) + (q[2] + q[3])) * (1.0f / D) + EPS); const int bc = row >> 5, l = row & 31;
#pragma unroll
                for (int bj = 0; bj < 2; ++bj) { const int c0 = u.pn * 256 + bj * 128 + wc * 32 + 8 * fq, g = c0 >> 4, h0 = c0 & 15; const f32x4 v0 = acc[ai][bj][m][0] * rs, v1 = acc[ai][bj][m][1] * rs;
                    u32x4 w; w.x = cvt_pk_bf16(v0[0], v0[1]); w.y = cvt_pk_bf16(v0[2], v0[3]); w.z = cvt_pk_bf16(v1[0], v1[1]); w.w = cvt_pk_bf16(v1[2], v1[3]);
                    *(u32x4*)(AG + ((size_t)g * NBC + bc) * KA + 2 * SP + l * SGH + h0) = w; } }
    }
};
struct EpiGelu {
    static constexpr bool PERM = true, AFTER_DRAIN = false;
    bf16* GB;
    __device__ __forceinline__ void operator()(ACC_T, const Unit& u, int wr, int wc, int fr, int fq) const {
#pragma unroll
        for (int ai = 0; ai < 2; ++ai)
#pragma unroll
            for (int m = 0; m < 4; ++m) { const int bc = u.pm * 256 + ai * 128 + wr * 64 + m * 16 + fr;
#pragma unroll
                for (int bj = 0; bj < 2; ++bj) { const int n0 = u.pn * 256 + bj * 128 + wc * 32 + 8 * fq, l = n0 >> 4, h0 = n0 & 15; const f32x4 v0 = acc[ai][bj][m][0], v1 = acc[ai][bj][m][1];
                    u32x4 w; w.x = cvt_pk_bf16(pg8::gelu_tanh(v0[0]), pg8::gelu_tanh(v0[1])); w.y = cvt_pk_bf16(pg8::gelu_tanh(v0[2]), pg8::gelu_tanh(v0[3]));
                    w.z = cvt_pk_bf16(pg8::gelu_tanh(v1[0]), pg8::gelu_tanh(v1[1])); w.w = cvt_pk_bf16(pg8::gelu_tanh(v1[2]), pg8::gelu_tanh(v1[3]));
                    *(u32x4*)(GB + ((size_t)bc * CL + l) * D + u.x2 * SGH + h0) = w; } }
    }
};
struct EpiGlu {
    static constexpr bool PERM = true, AFTER_DRAIN = false;
    float* X;
    __device__ __forceinline__ void operator()(ACC_T, const Unit& u, int wr, int wc, int fr, int fq) const {
        const int col0 = u.pn * 128 + wc * 32 + 8 * fq;
#pragma unroll
        for (int ai = 0; ai < 2; ++ai)
#pragma unroll
            for (int m = 0; m < 4; ++m) { float* p = X + (size_t)(u.pm * 256 + ai * 128 + wr * 64 + m * 16 + fr) * D + col0;
#pragma unroll
                for (int n = 0; n < 2; ++n) { const f32x4 a = acc[ai][0][m][n], b = acc[ai][1][m][n]; f32x4 o = *(const f32x4*)(p + 4 * n);
#pragma unroll
                    for (int i = 0; i < 4; ++i) o[i] += a[i] * pg8::fast_sigmoid(b[i]);
                    *(f32x4*)(p + 4 * n) = o; }
                if (m & 1) asm volatile("" ::: "memory"); }
    }
};
struct EpiMaskBf16 {
    static constexpr bool PERM = true, AFTER_DRAIN = false;
    bf16* Y;
    __device__ __forceinline__ void operator()(ACC_T, const Unit& u, int wr, int wc, int fr, int fq) const {
#pragma unroll
        for (int ai = 0; ai < 2; ++ai)
#pragma unroll
            for (int m = 0; m < 4; ++m) { const int row = u.x0 + ai * 128 + wr * 64 + m * 16 + fr;
#pragma unroll
                for (int bj = 0; bj < 2; ++bj) { const f32x4 v0 = acc[ai][bj][m][0], v1 = acc[ai][bj][m][1];
                    u32x4 w; w.x = cvt_pk_bf16(v0[0], v0[1]); w.y = cvt_pk_bf16(v0[2], v0[3]); w.z = cvt_pk_bf16(v1[0], v1[1]); w.w = cvt_pk_bf16(v1[2], v1[3]);
                    if (row < u.x1) *(u32x4*)(Y + (size_t)row * D + u.pn * 256 + bj * 128 + wc * 32 + 8 * fq) = w; } }
    }
};

struct Frame {
    LAS unsigned char* lds; volatile LAS unsigned* MISC; gu32* ctl;
    int tid, lane, wave, vcu, G;
    const float* in[30]; float* out; unsigned char* ws;
};
#define WSP(T, off) ((T*)(F.ws + (off)))

__device__ __forceinline__ void tr_job(const float* W, int ldw, int ncb, int cbase, const float* gain, bf16* WT, int ldt, int mode, int rowoff, int item, LAS float* scr, int lane) {
    const int kb = item / ncb, nb = item % ncb, n0 = 32 * nb;
    const int drow0 = (mode == 0) ? rowoff + n0 : (n0 >> 7) * 256 + (n0 & 127) + rowoff;
    transpose_item(W, ldw, 64 * kb, cbase + n0, gain, WT, ldt, drow0, scr, lane);
}

__device__ __forceinline__ void ssm_prep_job(Frame& F, int g, int q) {
    LAS float* PWR = (LAS float*)(F.lds + RING_OFF);
    LAS float* PWI = PWR + 33 * 64;
    LAS float* BBR = PWI + 33 * 64;
    LAS float* BBI = BBR + 1024;
    LAS float* CR = BBI + 1024;
    LAS float* CI = CR + 1024;
    LAS float* KT = CI + 1024;
    LAS float* COEF = KT + 2048;
    const int tid = F.tid;
    const float* are = F.in[I_ARE]; const float* aim = F.in[I_AIM]; const float* logdt = F.in[I_LOGDT];
    if (tid < 64) {
        const int p = tid; const double dt = exp((double)logdt[g]); const double ar = (double)are[g * SP + p], ai = (double)aim[g * SP + p];
        const double mag = exp(ar * dt), th = ai * dt; const double abr = mag * cos(th), abi = mag * sin(th);
        const double den = ar * ar + ai * ai, nr = abr - 1.0, ni = abi;
        COEF[2 * p] = (float)((nr * ar + ni * ai) / den); COEF[2 * p + 1] = (float)((ni * ar - nr * ai) / den);
        double pr = 1.0, pi = 0.0;
        for (int t = 0; t <= CL; ++t) { PWR[t * 64 + p] = (float)pr; PWI[t * 64 + p] = (float)pi; const double nr2 = pr * abr - pi * abi, ni2 = pr * abi + pi * abr; pr = nr2; pi = ni2; }
        if (q == 0) { float* AL = WSP(float, WS_AL); AL[(g * SP + p) * 2] = PWR[CL * 64 + p]; AL[(g * SP + p) * 2 + 1] = PWI[CL * 64 + p]; }
    }
    __syncthreads();
    for (int i = tid; i < 1024; i += 512) { const int p = i >> 4; const float br = F.in[I_BRE][g * 1024 + i], bi = F.in[I_BIM][g * 1024 + i], cr = COEF[2 * p], ci = COEF[2 * p + 1];
        BBR[i] = cr * br - ci * bi; BBI[i] = cr * bi + ci * br; CR[i] = F.in[I_CRE][g * 1024 + i]; CI[i] = F.in[I_CIM][g * 1024 + i]; }
    __syncthreads();
    for (int idx = tid; idx < 2048; idx += 512) { const int tl = idx >> 8, h = (idx >> 4) & 15, h2 = idx & 15, tau = 8 * q + tl; float s = 0.f;
        for (int p = 0; p < 64; ++p) { const float cr = CR[h * 64 + p], ci = CI[h * 64 + p], pr = PWR[tau * 64 + p], pi = PWI[tau * 64 + p];
            const float zr = cr * pr - ci * pi, zi = cr * pi + ci * pr; s += zr * BBR[p * 16 + h2] - zi * BBI[p * 16 + h2]; }
        if (tau == 0 && h == h2) s += F.in[I_SD][g * SGH + h];
        KT[idx] = s; }
    __syncthreads();
    bf16* BT = WSP(bf16, WS_BT2) + (size_t)g * 512 * KA; bf16* MG = WSP(bf16, WS_MG) + (size_t)g * 128 * 512;
    for (int it = tid; it < 8192; it += 512) { const int half = it & 1, h = (it >> 1) & 15, tl = (it >> 5) & 7, l = it >> 8, l2 = l - (8 * q + tl);
        if (l2 >= 0) { const LAS float* s = KT + tl * 256 + h * 16 + 8 * half; v4u o; o.x = pk2(s[0], s[1]); o.y = pk2(s[2], s[3]); o.z = pk2(s[4], s[5]); o.w = pk2(s[6], s[7]);
            *(GAS v4u*)(BT + (size_t)(16 * l + h) * KA + 128 + 16 * l2 + 8 * half) = o; } }
    for (int it = tid; it < 16384; it += 512) { const int half = it & 1, h = (it >> 1) & 15, dl = (it >> 5) & 15, l = it >> 9, l2 = l + dl;
        if (dl >= 1 && (dl & 3) == q && l2 <= 16 * (l >> 4) + 15) *(GAS v4u*)(BT + (size_t)(16 * l + h) * KA + 128 + 16 * l2 + 8 * half) = (v4u){0u, 0u, 0u, 0u}; }
    for (int it = tid; it < 2048; it += 512) { const int pc = it & 7, part = (it >> 3) & 1, h = (it >> 4) & 15, l = 8 * q + (it >> 8); float v[8];
#pragma unroll
        for (int j = 0; j < 8; ++j) { const int p = 8 * pc + j; const float cr = CR[h * 64 + p], ci = CI[h * 64 + p], pr = PWR[(l + 1) * 64 + p], pi = PWI[(l + 1) * 64 + p];
            v[j] = part == 0 ? (cr * pr - ci * pi) : -(cr * pi + ci * pr); }
        v4u o; o.x = pk2(v[0], v[1]); o.y = pk2(v[2], v[3]); o.z = pk2(v[4], v[5]); o.w = pk2(v[6], v[7]);
        *(GAS v4u*)(BT + (size_t)(16 * l + h) * KA + 64 * part + 8 * pc) = o; }
    for (int it = tid; it < 2048; it += 512) { const int half = it & 1, ll = (it >> 1) & 7, p = (it >> 4) & 63, part = it >> 10, l2 = 8 * q + ll; float v[8];
        const float pr = PWR[(CL - 1 - l2) * 64 + p], pi = PWI[(CL - 1 - l2) * 64 + p];
#pragma unroll
        for (int j = 0; j < 8; ++j) { const float br = BBR[p * 16 + 8 * half + j], bi = BBI[p * 16 + 8 * half + j]; v[j] = part == 0 ? (pr * br - pi * bi) : (pr * bi + pi * br); }
        v4u o; o.x = pk2(v[0], v[1]); o.y = pk2(v[2], v[3]); o.z = pk2(v[4], v[5]); o.w = pk2(v[6], v[7]);
        *(GAS v4u*)(MG + (size_t)(part * 64 + p) * 512 + 16 * l2 + 8 * half) = o; }
    __syncthreads();
}

__device__ __forceinline__ void p0_prologue(Frame& F) {
    const int gw = F.vcu * NWAVES + F.wave, NGW = F.G * NWAVES;
    for (int job = F.vcu; job < 4 * SG; job += F.G) ssm_prep_job(F, job >> 2, job & 3);
    LAS float* WFG = (LAS float*)(F.lds + RING_OFF + 98304);
    for (int i = F.tid; i < D * NH; i += 512) { const int k = i >> 3, e = i & 7; WFG[i] = F.in[I_WIN0][(size_t)k * INW + 3 * FW + e] * F.in[I_N0][k]; }
    __syncthreads();
    LAS float* scr = (LAS float*)(F.lds + RING_OFF + F.wave * 8704);
    {
        constexpr int J1 = 16 * 48, J2 = 16 * 16, J3 = 8 * 32, J4 = 16 * 88, J5 = J4, J6 = 44 * 32, J7 = 16 * 32, J8 = J7, J9 = J7, NJ = J1 + J2 + J3 + J4 + J5 + J6 + J7 + J8 + J9;
        for (int it = gw; it < NJ; it += NGW) {
            int r = it;
            if (r < J1) { tr_job(F.in[I_WIN0], INW, 48, 0, nullptr, WSP(bf16, WS_WIN0), D, 0, 0, r, scr, F.lane); continue; } r -= J1;
            if (r < J2) { tr_job(F.in[I_WIN0], INW, 16, 3 * FW + NH, nullptr, WSP(bf16, WS_WIN0), D, 0, 3 * FW, r, scr, F.lane); continue; } r -= J2;
            if (r < J3) { tr_job(F.in[I_WOUT], D, 32, 0, nullptr, WSP(bf16, WS_WOT), D, 0, 0, r, scr, F.lane); continue; } r -= J3;
            if (r < J4) { tr_job(F.in[I_W1], DFF, 88, 0, F.in[I_N1], WSP(bf16, WS_W13), D, 1, 0, r, scr, F.lane); continue; } r -= J4;
            if (r < J5) { tr_job(F.in[I_W3], DFF, 88, 0, F.in[I_N1], WSP(bf16, WS_W13), D, 1, 128, r, scr, F.lane); continue; } r -= J5;
            if (r < J6) { tr_job(F.in[I_W2], D, 32, 0, nullptr, WSP(bf16, WS_W2T), DFF, 0, 0, r, scr, F.lane); continue; } r -= J6;
            if (r < J7) { tr_job(F.in[I_WIN1], D, 32, 0, F.in[I_N2], WSP(bf16, WS_WIN1), D, 0, 0, r, scr, F.lane); continue; } r -= J7;
            if (r < J8) { tr_job(F.in[I_GA], D, 32, 0, nullptr, WSP(bf16, WS_WGLU), D, 1, 0, r, scr, F.lane); continue; } r -= J8;
            tr_job(F.in[I_GB], D, 32, 0, nullptr, WSP(bf16, WS_WGLU), D, 1, 128, r, scr, F.lane);
        }
    }
    for (int it = gw; it < 16 * 64; it += NGW) {
        const int n = 64 * (it & 15) + F.lane, kk0 = 8 * (it >> 4), g = kk0 >> 7, kl0 = kk0 & 127;
        const float* wp = F.in[I_WPOOL] + ((size_t)g * 128 + kl0) * 128; const float* ps = F.in[I_PSCALE] + g * 128; const float* wo = F.in[I_WOUT] + (size_t)(FW + g * 128) * D + n;
        float a[8];
#pragma unroll
        for (int i = 0; i < 8; ++i) a[i] = 0.f;
        for (int j = 0; j < 128; ++j) { const float w = wo[(size_t)j * D] * ps[j];
#pragma unroll
            for (int i = 0; i < 8; ++i) a[i] += wp[i * 128 + j] * w; }
        v4u o; o.x = pk2(a[0], a[1]); o.y = pk2(a[2], a[3]); o.z = pk2(a[4], a[5]); o.w = pk2(a[6], a[7]);
        *(GAS v4u*)(WSP(bf16, WS_WOT) + (size_t)n * D + FW + kk0) = o;
    }
    for (int m = gw; m < M; m += NGW) {
        const GAS f32x4* xr = (const GAS f32x4*)(F.in[I_X] + (size_t)m * D) + F.lane;
        f32x4 v[4]; float s = 0.f;
#pragma unroll
        for (int j = 0; j < 4; ++j) { v[j] = xr[64 * j]; s += (v[j].x * v[j].x + v[j].y * v[j].y) + (v[j].z * v[j].z + v[j].w * v[j].w); }
        const float rs = 1.0f / sqrtf(wave_sum(s) * (1.0f / D) + EPS);
        float dot[8];
#pragma unroll
        for (int e = 0; e < 8; ++e) dot[e] = 0.f;
        GAS unsigned long long* o8 = (GAS unsigned long long*)(WSP(bf16, WS_H0) + (size_t)m * D) + F.lane;
#pragma unroll
        for (int j = 0; j < 4; ++j) { const int k0 = 4 * F.lane + 256 * j; const f32x4 g = *(const GAS f32x4*)(F.in[I_N0] + k0);
            o8[64 * j] = (unsigned long long)pk2(v[j].x * rs * g.x, v[j].y * rs * g.y) | ((unsigned long long)pk2(v[j].z * rs * g.z, v[j].w * rs * g.w) << 32);
#pragma unroll
            for (int i = 0; i < 4; ++i) { const f32x4 w0 = *(const LAS f32x4*)(WFG + (k0 + i) * 8), w1 = *(const LAS f32x4*)(WFG + (k0 + i) * 8 + 4); const float xv = v[j][i];
                dot[0] += xv * w0.x; dot[1] += xv * w0.y; dot[2] += xv * w0.z; dot[3] += xv * w0.w; dot[4] += xv * w1.x; dot[5] += xv * w1.y; dot[6] += xv * w1.z; dot[7] += xv * w1.w; } }
        float mine = 0.f;
#pragma unroll
        for (int e = 0; e < 8; ++e) { const float t = wave_sum(dot[e]); if (F.lane == e) mine = t; }
        if (F.lane < 8) { const float a = mine * rs + F.in[I_BF][F.lane]; WSP(float, WS_LOGF)[(size_t)m * 8 + F.lane] = fminf(a, 0.f) - log1pf(expf(-fabsf(a))); }
    }
}

__device__ __forceinline__ void forget_cumsum(Frame& F, int b, int h) {
    const float* lf = WSP(float, WS_LOGF) + ((size_t)b * SEQ + 32 * F.lane) * 8 + h; float v[32]; float s = 0.f;
#pragma unroll
    for (int i = 0; i < 32; ++i) { s += lf[i * 8]; v[i] = s; }
    float incl = s;
#pragma unroll
    for (int o = 1; o < 64; o <<= 1) { const float t = __shfl_up(incl, o); if (F.lane >= o) incl += t; }
    const float excl = incl - s; float* fo = WSP(float, WS_FNEG) + ((size_t)b * NH + h) * SEQ + 32 * F.lane;
#pragma unroll
    for (int i = 0; i < 32; i += 4) *(f32x4*)(fo + i) = (f32x4){-(excl + v[i]) * LOG2E, -(excl + v[i + 1]) * LOG2E, -(excl + v[i + 2]) * LOG2E, -(excl + v[i + 3]) * LOG2E};
}

__device__ __forceinline__ void pool_rows(Frame& F, int row0) {
    const unsigned* Pp = (const unsigned*)(WSP(bf16, WS_QKVP) + (size_t)3 * M * 512); unsigned* mix = (unsigned*)WSP(bf16, WS_H0);
    const int cp = F.tid & 255, half = F.tid >> 8, w = 2 << (cp >> 6), t0 = row0 + 32 * half, bs = t0 & ~(SEQ - 1);
    float s0 = 0.f, s1 = 0.f;
    for (int t = (t0 - w > bs ? t0 - w : bs); t < t0; ++t) { const unsigned u = Pp[(size_t)t * 256 + cp]; s0 += __uint_as_float(u << 16); s1 += __uint_as_float(u & 0xffff0000u); }
    for (int t = t0; t < t0 + 32; ++t) {
        const unsigned u = Pp[(size_t)t * 256 + cp]; const float p0 = __uint_as_float(u << 16), p1 = __uint_as_float(u & 0xffff0000u); s0 += p0; s1 += p1;
        const int tt = t - w; if (tt >= bs) { const unsigned uo = Pp[(size_t)tt * 256 + cp]; s0 -= __uint_as_float(uo << 16); s1 -= __uint_as_float(uo & 0xffff0000u); }
        const int cnt = (t - bs + 1) < w ? (t - bs + 1) : w; const float ic = 1.0f / (float)cnt;
        mix[(size_t)t * 512 + 256 + cp] = pk2(s0 * ic - p0, s1 * ic - p1);
    }
}

__device__ __forceinline__ void ssm_state_unit(Frame& F, int g, int bp) {
    typedef short bf16x8v __attribute__((ext_vector_type(8)));
    LAS float* SL = (LAS float*)(F.lds + RING_OFF);
    bf16* AGg = WSP(bf16, WS_QKVP) + ((size_t)g * NBC + 128 * bp) * KA; const bf16* MGg = WSP(bf16, WS_MG) + (size_t)g * 128 * 512;
    const int r16 = F.lane & 15, quad = F.lane >> 4;
    f32x4 acc[8];
#pragma unroll
    for (int nb = 0; nb < 8; ++nb) acc[nb] = (f32x4){0.f, 0.f, 0.f, 0.f};
    const bf16* ap = AGg + (size_t)(16 * F.wave + r16) * KA + 128 + 8 * quad; const bf16* bp_ = MGg + (size_t)r16 * 512 + 8 * quad;
#pragma unroll 4
    for (int ks = 0; ks < 16; ++ks) { const bf16x8v a = *(const bf16x8v*)(ap + 32 * ks);
#pragma unroll
        for (int nb = 0; nb < 8; ++nb) { const bf16x8v b = *(const bf16x8v*)(bp_ + (size_t)nb * 16 * 512 + 32 * ks); acc[nb] = __builtin_amdgcn_mfma_f32_16x16x32_bf16(a, b, acc[nb], 0, 0, 0); } }
#pragma unroll
    for (int nb = 0; nb < 8; ++nb)
#pragma unroll
        for (int r = 0; r < 4; ++r) SL[(16 * F.wave + 4 * quad + r) * 132 + 16 * nb + r16] = acc[nb][r];
    __syncthreads();
    if (F.tid < 128) { const int b2 = F.tid >> 6, p = F.tid & 63; const float alr = WSP(float, WS_AL)[(g * SP + p) * 2], ali = WSP(float, WS_AL)[(g * SP + p) * 2 + 1]; float xr = 0.f, xi = 0.f;
        for (int c = 0; c < NCH; ++c) { const int row = b2 * NCH + c; bf16* o = AGg + (size_t)row * KA + p; o[0] = (bf16)f2bf(xr); o[SP] = (bf16)f2bf(xi);
            const float sr = SL[row * 132 + p], si = SL[row * 132 + SP + p]; const float nr = alr * xr - ali * xi + sr, ni = alr * xi + ali * xr + si; xr = nr; xi = ni; } }
    __syncthreads();
}

__device__ __forceinline__ void router_rows(Frame& F) {
    LAS float* WR = (LAS float*)(F.lds + RING_OFF + 69632);
    LAS unsigned* CN = (LAS unsigned*)(F.lds + RING_OFF + 69632 + 32768);
    for (int i = F.tid; i < D * NE; i += 512) WR[i] = F.in[I_RW][i] * F.in[I_N3][i >> 3];
    if (F.tid < 8) CN[F.tid] = 0u;
    __syncthreads();
    for (int r = 0; r < 8; ++r) { const int m = 64 * F.vcu + 8 * F.wave + r;
        const GAS f32x4* xr = (const GAS f32x4*)(F.out + (size_t)m * D) + F.lane;
        f32x4 v[4]; float s = 0.f;
#pragma unroll
        for (int j = 0; j < 4; ++j) { v[j] = xr[64 * j]; s += (v[j].x * v[j].x + v[j].y * v[j].y) + (v[j].z * v[j].z + v[j].w * v[j].w); }
        const float rs = 1.0f / sqrtf(wave_sum(s) * (1.0f / D) + EPS);
        float dot[8];
#pragma unroll
        for (int e = 0; e < 8; ++e) dot[e] = 0.f;
        GAS unsigned long long* o8 = (GAS unsigned long long*)(WSP(bf16, WS_H3) + (size_t)m * D) + F.lane;
#pragma unroll
        for (int j = 0; j < 4; ++j) { const int k0 = 4 * F.lane + 256 * j; const f32x4 g = *(const GAS f32x4*)(F.in[I_N3] + k0);
            o8[64 * j] = (unsigned long long)pk2(v[j].x * rs * g.x, v[j].y * rs * g.y) | ((unsigned long long)pk2(v[j].z * rs * g.z, v[j].w * rs * g.w) << 32);
#pragma unroll
            for (int i = 0; i < 4; ++i) { const f32x4 w0 = *(const LAS f32x4*)(WR + (k0 + i) * 8), w1 = *(const LAS f32x4*)(WR + (k0 + i) * 8 + 4); const float xv = v[j][i];
                dot[0] += xv * w0.x; dot[1] += xv * w0.y; dot[2] += xv * w0.z; dot[3] += xv * w0.w; dot[4] += xv * w1.x; dot[5] += xv * w1.y; dot[6] += xv * w1.z; dot[7] += xv * w1.w; } }
        float lg[8];
#pragma unroll
        for (int e = 0; e < 8; ++e) lg[e] = wave_sum(dot[e]) * rs + F.in[I_RB][e];
        int e1 = 0; float l1 = lg[0];
#pragma unroll
        for (int e = 1; e < 8; ++e) if (lg[e] > l1) { l1 = lg[e]; e1 = e; }
        int e2 = -1; float l2 = -INFINITY;
#pragma unroll
        for (int e = 0; e < 8; ++e) if (e != e1 && lg[e] > l2) { l2 = lg[e]; e2 = e; }
        if (F.lane == 0) { const float g2 = 1.0f / (1.0f + expf(l1 - l2)); WSP(unsigned, WS_TOKE)[m] = (unsigned)e1 | ((unsigned)e2 << 8);
            WSP(float, WS_GATE)[2 * m] = 1.0f - g2; WSP(float, WS_GATE)[2 * m + 1] = g2; atomicAdd((unsigned*)&CN[e1], 1u); atomicAdd((unsigned*)&CN[e2], 1u); }
    }
    __syncthreads();
    if (F.tid < 8) WSP(unsigned, WS_CNT)[F.vcu * 8 + F.tid] = CN[F.tid];
}

__device__ __forceinline__ void moe_sort(Frame& F) {
    LAS unsigned* TOT = (LAS unsigned*)(F.lds + RING_OFF);
    LAS unsigned* BASE = TOT + 2048;
    for (int i = F.tid; i < F.G * 8; i += 512) TOT[i] = WSP(unsigned, WS_CNT)[i];
    __syncthreads();
    if (F.tid < 8) { unsigned tot = 0, pre = 0; for (int b = 0; b < F.G; ++b) { if (b == F.vcu) pre = tot; tot += TOT[b * 8 + F.tid]; } BASE[F.tid] = pre; BASE[8 + F.tid] = tot; }
    __syncthreads();
    if (F.tid == 0) { unsigned s = 0, tl = 0; for (int e = 0; e < 8; ++e) { BASE[16 + e] = s; if (F.vcu == 0) { WSP(unsigned, WS_TAB)[e] = s; WSP(unsigned, WS_TAB)[16 + e] = tl; } s += BASE[8 + e]; tl += (BASE[8 + e] + 255u) >> 8; }
        BASE[24] = s; if (F.vcu == 0) { WSP(unsigned, WS_TAB)[8] = s; WSP(unsigned, WS_TAB)[24] = tl; } }
    __syncthreads();
    if (F.vcu == 1 && F.tid < 256) WSP(unsigned, WS_TOKS)[2 * M + F.tid] = 0u;
    if (F.wave == 0) { const int t = 64 * F.vcu + F.lane; const unsigned te = WSP(unsigned, WS_TOKE)[t]; const int e1 = te & 255, e2 = (te >> 8) & 255;
        unsigned p1 = 0, p2 = 0; const unsigned long long lt = (1ull << F.lane) - 1ull;
#pragma unroll
        for (int e = 0; e < 8; ++e) { const unsigned long long b1 = __ballot(e1 == e), b2 = __ballot(e2 == e);
            if (e1 == e) p1 = BASE[16 + e] + BASE[e] + (unsigned)__popcll(b1 & lt);
            if (e2 == e) p2 = BASE[16 + e] + BASE[e] + (unsigned)__popcll(b1) + (unsigned)__popcll(b2 & lt); }
        WSP(unsigned, WS_POS)[2 * t] = p1; WSP(unsigned, WS_POS)[2 * t + 1] = p2; WSP(unsigned, WS_TOKS)[p1] = (unsigned)t; WSP(unsigned, WS_TOKS)[p2] = (unsigned)t; }
}

__device__ __forceinline__ void final_rows(Frame& F) {
    const int gw = F.vcu * NWAVES + F.wave, NGW = F.G * NWAVES;
    for (int m = gw; m < M; m += NGW) {
        GAS f32x4* xr = (GAS f32x4*)(F.out + (size_t)m * D) + F.lane;
        const unsigned p1 = WSP(unsigned, WS_POS)[2 * m], p2 = WSP(unsigned, WS_POS)[2 * m + 1]; const float g1 = WSP(float, WS_GATE)[2 * m], g2 = WSP(float, WS_GATE)[2 * m + 1];
        const GAS unsigned long long* y1 = (const GAS unsigned long long*)(WSP(bf16, WS_YS) + (size_t)p1 * D) + F.lane; const GAS unsigned long long* y2 = (const GAS unsigned long long*)(WSP(bf16, WS_YS) + (size_t)p2 * D) + F.lane;
        f32x4 v[4]; float s = 0.f;
#pragma unroll
        for (int j = 0; j < 4; ++j) { v[j] = xr[64 * j]; unsigned long long a = y1[64 * j], b = y2[64 * j];
#ifdef DBG_NOMOE
            a = 0ull; b = 0ull;
#endif
            v[j].x += g1 * __uint_as_float((unsigned)a << 16) + g2 * __uint_as_float((unsigned)b << 16);
            v[j].y += g1 * __uint_as_float((unsigned)a & 0xffff0000u) + g2 * __uint_as_float((unsigned)b & 0xffff0000u);
            v[j].z += g1 * __uint_as_float((unsigned)(a >> 32) << 16) + g2 * __uint_as_float((unsigned)(b >> 32) << 16);
            v[j].w += g1 * __uint_as_float((unsigned)(a >> 32) & 0xffff0000u) + g2 * __uint_as_float((unsigned)(b >> 32) & 0xffff0000u);
            s += (v[j].x * v[j].x + v[j].y * v[j].y) + (v[j].z * v[j].z + v[j].w * v[j].w); }
        const float rs = 1.0f / sqrtf(wave_sum(s) * (1.0f / D) + EPS);
#pragma unroll
        for (int j = 0; j < 4; ++j) { const f32x4 g = *(const GAS f32x4*)(F.in[I_NF] + 4 * F.lane + 256 * j); xr[64 * j] = (f32x4){v[j].x * rs * g.x, v[j].y * rs * g.y, v[j].z * rs * g.z, v[j].w * rs * g.w}; }
    }
}

constexpr int N_PHASES = 15;
__global__ void __launch_bounds__(NWAVES * 64, 2) trunk_fwd(Args args) {
    extern __shared__ __attribute__((aligned(16))) unsigned char lds[];
    Frame F;
    F.lds = (LAS unsigned char*)lds;
    F.MISC = (volatile LAS unsigned*)(F.lds + MISC_OFF);
    F.tid = threadIdx.x; F.lane = F.tid & 63; F.wave = __builtin_amdgcn_readfirstlane(F.tid >> 6);
    F.G = gridDim.x; { const int bx = blockIdx.x; F.vcu = (F.G % 8 == 0) ? (bx % 8) * (F.G / 8) + bx / 8 : bx; }
#pragma unroll
    for (int i = 0; i < 30; ++i) F.in[i] = args.in[i];
    F.out = args.out; F.ws = args.ws; F.ctl = (gu32*)(args.ws + WS_CTL);
    for (int u = F.tid; u < (LDS_BYTES - LDSCTL_OFF) / 4; u += NWAVES * 64) ((LAS unsigned*)(F.lds + LDSCTL_OFF))[u] = 0u;
    __syncthreads();
    const int lo = args.ph_lo, hi = args.ph_hi;
    const bool use_bar = (hi - lo) > 1;
    XcdBarrier bar; bar.bar = (unsigned*)(F.ctl + CW_BAR); bar.x = 0; bar.st = nullptr;
    if (use_bar) bar = xcd_barrier_post((unsigned*)(F.ctl + CW_BAR), F.MISC + 8);
#ifndef PHMASK
#define PHMASK 0x7fff
#endif
#define IN(k) ((((PHMASK) >> (k)) & 1) && lo <= (k) && (k) < hi)
#define SEAM(k) do { if (lo <= (k) && (k) + 1 < hi) xcd_barrier(bar); } while (0)
    LAS unsigned char* ring = F.lds + RING_OFF;

    if (IN(0)) { p0_prologue(F); } SEAM(0);

    if (IN(1)) {
        if (blockIdx.x < NB) forget_cumsum(F, blockIdx.x, F.wave);
        PlainProb P{WSP(bf16, WS_H0), WSP(bf16, WS_WIN0), D, D, D / 64}; pg8::GridOrder S; S.init(M / 256, 2048 / 256, F.G, (int)blockIdx.x);
        EpiSplitBf16 E{WSP(bf16, WS_QKVP), attn_body::C2};
        pg8::gemm_phase<EpiSplitBf16, pg8::GridOrder, PlainProb, true>(ring, P, S, E);
    } SEAM(1);

    if (IN(2)) {
        for (int r = F.vcu; r < M / 64; r += F.G) pool_rows(F, 64 * r);
        const attn_body::bf16* qkv = (const attn_body::bf16*)WSP(bf16, WS_QKVP);
        const attn_body::AttnTensors AT{qkv, qkv + (size_t)M * 512, qkv + (size_t)2 * M * 512, (attn_body::bf16*)WSP(bf16, WS_H0), WSP(float, WS_FNEG)};
        const attn_body::StaticOrder S((int)F.G, (int)blockIdx.x);
        attn_body::attn_phase<attn_body::StaticOrder>((char*)lds + RING_OFF, AT, S);
    } SEAM(2);

    if (IN(3)) {
        PlainProb P{WSP(bf16, WS_H0), WSP(bf16, WS_WOT), D, D, D / 64}; pg8::GridOrder S; S.init(M / 256, D / 256, F.G, (int)blockIdx.x);
        EpiResid E{F.in[I_X], F.out, WSP(bf16, WS_QKVP), WSP(float, WS_SSQ1)};
        pg8::gemm_phase<EpiResid, pg8::GridOrder, PlainProb, false>(ring, P, S, E);
    } SEAM(3);

    if (IN(4)) {
        PlainProb P{WSP(bf16, WS_QKVP), WSP(bf16, WS_W13), D, D, D / 64}; pg8::GridOrder S; S.init(M / 256, 2 * DFF / 256, F.G, (int)blockIdx.x);
        EpiSwiglu<false> E{WSP(bf16, WS_ACT0), WSP(float, WS_SSQ1)};
        pg8::gemm_phase<EpiSwiglu<false>, pg8::GridOrder, PlainProb, true>(ring, P, S, E);
    } SEAM(4);

    if (IN(5)) {
        PlainProb P{WSP(bf16, WS_ACT0), WSP(bf16, WS_W2T), DFF, DFF, DFF / 64}; pg8::GridOrder S; S.init(M / 256, D / 256, F.G, (int)blockIdx.x);
        EpiResid E{F.out, F.out, WSP(bf16, WS_H0), WSP(float, WS_SSQ2)};
        pg8::gemm_phase<EpiResid, pg8::GridOrder, PlainProb, false>(ring, P, S, E);
    } SEAM(5);

    if (IN(6)) {
        PlainProb P{WSP(bf16, WS_H0), WSP(bf16, WS_WIN1), D, D, D / 64}; pg8::GridOrder S; S.init(M / 256, D / 256, F.G, (int)blockIdx.x);
        EpiSsmU E{WSP(bf16, WS_QKVP), WSP(float, WS_SSQ2)};
        pg8::gemm_phase<EpiSsmU, pg8::GridOrder, PlainProb, false>(ring, P, S, E);
    } SEAM(6);

    if (IN(7)) { for (int j = F.vcu; j < 4 * SG; j += F.G) ssm_state_unit(F, j >> 2, j & 3); } SEAM(7);

    if (IN(8)) {
        SsmProb P{WSP(bf16, WS_QKVP), WSP(bf16, WS_BT2), KA, KA}; SsmOrder S{F.vcu, F.G};
        EpiGelu E{WSP(bf16, WS_H0)};
        pg8::gemm_phase<EpiGelu, SsmOrder, SsmProb, false>(ring, P, S, E);
    } SEAM(8);

    if (IN(9)) {
        PlainProb P{WSP(bf16, WS_H0), WSP(bf16, WS_WGLU), D, D, D / 64}; pg8::GridOrder S; S.init(M / 256, 2 * D / 256, F.G, (int)blockIdx.x);
        EpiGlu E{F.out};
        pg8::gemm_phase<EpiGlu, pg8::GridOrder, PlainProb, true>(ring, P, S, E);
    } SEAM(9);

    if (IN(10)) {
        router_rows(F);
        __syncthreads();
        const int gw = F.vcu * NWAVES + F.wave, NGW = F.G * NWAVES; LAS float* scr = (LAS float*)(F.lds + RING_OFF + F.wave * 8704);
        constexpr int JE = 16 * 88;
        for (int it = gw; it < NE * 3 * JE; it += NGW) { const int e = it / (3 * JE), r = it % (3 * JE);
            if (r < JE) tr_job(F.in[I_EW1] + (size_t)e * D * DFF, DFF, 88, 0, nullptr, WSP(bf16, WS_W13E) + (size_t)e * 2 * DFF * D, D, 1, 0, r, scr, F.lane);
            else if (r < 2 * JE) tr_job(F.in[I_EW3] + (size_t)e * D * DFF, DFF, 88, 0, nullptr, WSP(bf16, WS_W13E) + (size_t)e * 2 * DFF * D, D, 1, 128, r - JE, scr, F.lane);
            else tr_job(F.in[I_EW2] + (size_t)e * DFF * D, D, 32, 0, nullptr, WSP(bf16, WS_W2E) + (size_t)e * D * DFF, DFF, 0, 0, r - 2 * JE, scr, F.lane); }
    } SEAM(10);

    if (IN(11)) { moe_sort(F); } SEAM(11);

    if (IN(12)) {
        MoeOrder S; S.tab = WSP(unsigned, WS_TAB); S.init((int)S.tab[24], 2 * DFF / 256, F.G, (int)blockIdx.x);
        MoeUpProb P{WSP(bf16, WS_H3), WSP(bf16, WS_W13E), WSP(unsigned, WS_TOKS), D, D};
        EpiSwiglu<true> E{WSP(bf16, WS_ACTS), nullptr};
        pg8::gemm_phase<EpiSwiglu<true>, MoeOrder, MoeUpProb, true>(ring, P, S, E);
    } SEAM(12);

    if (IN(13)) {
        MoeOrder S; S.tab = WSP(unsigned, WS_TAB); S.init((int)S.tab[24], D / 256, F.G, (int)blockIdx.x);
        MoeDownProb P{WSP(bf16, WS_ACTS), WSP(bf16, WS_W2E), DFF, DFF};
        EpiMaskBf16 E{WSP(bf16, WS_YS)};
        pg8::gemm_phase<EpiMaskBf16, MoeOrder, MoeDownProb, true>(ring, P, S, E);
    } SEAM(13);

    if (IN(14)) { final_rows(F); }
#undef IN
#undef SEAM
}

extern "C" void kernel_launch(void* const* d_in, const int* in_sizes, int n_in, void* d_out, int out_size, void* d_ws, size_t ws_size, hipStream_t stream) {
    static int grid = 0;
    if (grid == 0) {
        if (n_in != 30 || in_sizes[0] != M * D || out_size != M * D || ws_size < WS_END) { fprintf(stderr, "kernel_launch: shape/workspace mismatch (n_in %d, ws %zu, need %zu); nothing launched\n", n_in, ws_size, (size_t)WS_END); grid = -1; return; }
        int dev = 0, cus = 0, per_cu = 0;
        if (hipGetDevice(&dev) != hipSuccess || hipDeviceGetAttribute(&cus, hipDeviceAttributeMultiprocessorCount, dev) != hipSuccess) { grid = -1; return; }
        if (hipFuncSetAttribute((const void*)trunk_fwd, hipFuncAttributeMaxDynamicSharedMemorySize, LDS_BYTES) != hipSuccess) { fprintf(stderr, "kernel_launch: hipFuncSetAttribute failed\n"); grid = -1; return; }
        if (hipOccupancyMaxActiveBlocksPerMultiprocessor(&per_cu, (const void*)trunk_fwd, NWAVES * 64, LDS_BYTES) != hipSuccess || per_cu < 1) fprintf(stderr, "kernel_launch: occupancy query reports %d\n", per_cu);
        (void)hipGetLastError();
        if (cus < 256) { fprintf(stderr, "kernel_launch: needs 256 CUs, device has %d\n", cus); grid = -1; return; }
        grid = 256;
    }
    if (grid < 0) return;
    if (hipMemsetAsync((char*)d_ws + WS_CTL, 0, CTL_ZERO_BYTES, stream) != hipSuccess) return;
    Args a{};
    for (int i = 0; i < 30; ++i) a.in[i] = (const float*)d_in[i];
    a.out = (float*)d_out; a.ws = (unsigned char*)d_ws;
#ifndef MK_SPLIT
    a.ph_lo = 0; a.ph_hi = N_PHASES;
    hipLaunchKernelGGL(trunk_fwd, dim3(grid), dim3(NWAVES * 64), LDS_BYTES, stream, a);
#else
    for (int p = 0; p < N_PHASES; ++p) { a.ph_lo = p; a.ph_hi = p + 1; hipLaunchKernelGGL(trunk_fwd, dim3(grid), dim3(NWAVES * 64), LDS_BYTES, stream, a); }
#endif
}
```

```cpp
#include <hip/hip_runtime.h>
#include <hip/hip_bf16.h>
#include <cstdio>
#include <cstdint>
#include <cmath>

namespace pg8 {
#define PG8_LAS __attribute__((address_space(3)))
typedef unsigned short bf16_t;
typedef short bf16x8 __attribute__((ext_vector_type(8)));
typedef float f32x4 __attribute__((ext_vector_type(4)));
typedef float f32x2 __attribute__((ext_vector_type(2)));
typedef unsigned u32x4 __attribute__((ext_vector_type(4)));
typedef unsigned u32x2 __attribute__((ext_vector_type(2)));
constexpr int BM = 256, BK = 64, HALF = 128, HTB = HALF * BK * 2  , STAGE_BYTES = 8 * HTB, NXCD = 8, WGM = 8;

__host__ __device__ __forceinline__ int lds_byte(int r, int c) { const int st = (r >> 4) * 2 + (c >> 5), rr = r & 15, cc = c & 31, ob = rr * 64 + cc * 2; return st * 1024 + (ob ^ (((ob >> 9) & 1) << 5)); }
__host__ __device__ __forceinline__ void stage_rc(int b, int& R, int& C) { const int st = b / 1024, sb = b % 1024, swz = sb ^ (((sb >> 9) & 1) << 5); R = (st >> 1) * 16 + swz / 64; C = (st & 1) * 32 + (swz % 64) / 2; }
__host__ __device__ __forceinline__ int perm32(int rho) { const int n = rho >> 4, i = rho & 15; return 8 * (i >> 2) + 4 * n + (i & 3); }

struct Unit { int pm, pn, x0, x1, x2, kq; };

struct GridOrder {
    int nM, nN, nwg, G, c;
    __device__ __forceinline__ void init(int nM_, int nN_, int G_, int c_) { nM = nM_; nN = nN_; nwg = nM * nN; G = G_; c = c_; }
    __device__ __forceinline__ bool tile(int i, int& pm, int& pn) const {
        const long L = (long)i * G + c; if (L >= nwg) return false;
        int wgid = (int)L; { const int q = nwg / NXCD, r = nwg % NXCD, xcd = wgid % NXCD, off = wgid / NXCD; wgid = (xcd < r ? xcd * (q + 1) : r * (q + 1) + (xcd - r) * q) + off; }
        const int nig = WGM * nN, gid = wgid / nig, fm = gid * WGM, gsz = (nM - fm) < WGM ? (nM - fm) : WGM;
        pm = fm + ((wgid % nig) % gsz); pn = (wgid % nig) / gsz; return true;
    }
    __device__ __forceinline__ bool next(int i, Unit& u) const { u.x0 = 0; u.x1 = i; u.x2 = 0; u.kq = -1; return tile(i, u.pm, u.pn); }
};

__device__ __forceinline__ unsigned cvt_pk_bf16(float lo, float hi) { unsigned r; asm volatile("v_cvt_pk_bf16_f32 %0, %1, %2" : "=v"(r) : "v"(lo), "v"(hi)); return r; }
__device__ __forceinline__ float fast_sigmoid(float v) { return __builtin_amdgcn_rcpf(1.0f + __builtin_amdgcn_exp2f(-1.4426950408889634f * v)); }
__device__ __forceinline__ float gelu_tanh(float y) { const float z2 = y * (1.5957691216057308f + 0.07135481627159282f * y * y); return y * fast_sigmoid(z2); }

typedef int i32x4 __attribute__((ext_vector_type(4)));
typedef int i32x8 __attribute__((ext_vector_type(8)));
template <class Epi, class Sched, class Prob, bool ALIGN_EPI, bool FP8 = false, int EPI_REP = 1>
__device__ __forceinline__ void gemm_phase(PG8_LAS unsigned char* lds, const Prob& P, const Sched& S, const Epi& E) {
    int tid_ = threadIdx.x; asm volatile("" : "+v"(tid_));
    const int tid = tid_, wid = __builtin_amdgcn_readfirstlane(tid >> 6), lane = tid & 63, wr = wid >> 2, wc = wid & 3, fr = lane & 15, fq = lane >> 4;
    unsigned cV[2][2], nV[2][2], voffB[2]; int pR[2], pC[2];
#pragma unroll
    for (int i = 0; i < 2; ++i) { int R, C; stage_rc(tid * 16 + i * 8192, R, C); pR[i] = R; pC[i] = C; const int Rb = Epi::PERM ? ((R & ~31) + perm32(R & 31)) : R;
        voffB[i] = (unsigned)(Rb * P.ldb + C * 2);
        cV[0][i] = (unsigned)(R * P.lda + C * 2); cV[1][i] = (unsigned)((R + HALF) * P.lda + C * 2); nV[0][i] = cV[0][i]; nV[1][i] = cV[1][i]; }
    const size_t kstep = (size_t)(BK * 2);
    const size_t hstepB = (size_t)HALF * P.ldb;
    const unsigned ldsw = (unsigned)wid * 1024u;
    int aofs[2], bofs[2];
    aofs[0] = lds_byte(wr * 64 + fr, fq * 8); aofs[1] = aofs[0] + 1024; bofs[0] = lds_byte(wc * 32 + fr, fq * 8); bofs[1] = bofs[0] + 1024;
#define PG8_SA(b, h) (((b) * 2 + (h)) * HTB)
#define PG8_SB(b, h) ((4 + (b) * 2 + (h)) * HTB)
#define PG8_STAGE(bufoff, gbase, voff) do { _Pragma("unroll") for (int _i = 0; _i < 2; ++_i) \
        __builtin_amdgcn_global_load_lds((const unsigned*)((const char*)(gbase) + (voff)[_i]), (PG8_LAS unsigned*)(lds + (bufoff) + ldsw + _i * 8192), 16, 0, 0); } while (0)
#define PG8_LDA(dst, b, h) do { _Pragma("unroll") for (int m = 0; m < 4; ++m) dst[m] = __builtin_shufflevector(*(const PG8_LAS i32x4*)(lds + PG8_SA(b, h) + aofs[0] + m * 2048), *(const PG8_LAS i32x4*)(lds + PG8_SA(b, h) + aofs[1] + m * 2048), 0, 1, 2, 3, 4, 5, 6, 7); } while (0)
#define PG8_LDB(dst, b, h) do { _Pragma("unroll") for (int n = 0; n < 2; ++n) dst[n] = __builtin_shufflevector(*(const PG8_LAS i32x4*)(lds + PG8_SB(b, h) + bofs[0] + n * 2048), *(const PG8_LAS i32x4*)(lds + PG8_SB(b, h) + bofs[1] + n * 2048), 0, 1, 2, 3, 4, 5, 6, 7); } while (0)
#define PG8_LO(x) __builtin_bit_cast(bf16x8, __builtin_shufflevector(x, x, 0, 1, 2, 3))
#define PG8_HI(x) __builtin_bit_cast(bf16x8, __builtin_shufflevector(x, x, 4, 5, 6, 7))
#define PG8_MMA(ai, bj, At, Bt) do { __builtin_amdgcn_s_setprio(1); _Pragma("unroll") for (int m = 0; m < 4; ++m) _Pragma("unroll") for (int n = 0; n < 2; ++n) { \
        if constexpr (FP8) acc[ai][bj][m][n] = __builtin_amdgcn_mfma_scale_f32_16x16x128_f8f6f4(Bt[n], At[m], acc[ai][bj][m][n], 0, 0, 0, 0x7f7f7f7f, 0, 0x7f7f7f7f); \
        else { acc[ai][bj][m][n] = __builtin_amdgcn_mfma_f32_16x16x32_bf16(PG8_LO(Bt[n]), PG8_LO(At[m]), acc[ai][bj][m][n], 0, 0, 0); acc[ai][bj][m][n] = __builtin_amdgcn_mfma_f32_16x16x32_bf16(PG8_HI(Bt[n]), PG8_HI(At[m]), acc[ai][bj][m][n], 0, 0, 0); } } \
        if constexpr (FP8) { _Pragma("unroll") for (int m = 0; m < 4; ++m) asm volatile("" : "+v"(acc[ai][bj][m][0]), "+v"(acc[ai][bj][m][1])); }     \
        __builtin_amdgcn_s_setprio(0); } while (0)
#define PG8_WAIT_V(n) asm volatile("s_waitcnt vmcnt(" #n ")" ::: "memory")
#define PG8_WAIT_L(n) asm volatile("s_waitcnt lgkmcnt(" #n ")" ::: "memory")
#define PG8_BAR __builtin_amdgcn_s_barrier()
#define PG8_SCHED __builtin_amdgcn_sched_barrier(0)
    Unit cur, nxt; int ui = 0; bool has_next = false;
    if (!S.next(0, cur)) return;
    f32x4 acc[2][2][4][2];
#pragma unroll
    for (int a = 0; a < 2; ++a)
#pragma unroll
        for (int b = 0; b < 2; ++b)
#pragma unroll
            for (int m = 0; m < 4; ++m)
#pragma unroll
                for (int n = 0; n < 2; ++n) acc[a][b][m][n] = (f32x4){0.f, 0.f, 0.f, 0.f};
    i32x8 At[4], B0[2], B1[2];
    const char* cA; const char* cB; int nt;
    P.ptrs(cur, cA, cB, nt);
    if constexpr (Prob::GATHER) { P.gather(0, pR, pC, cV); }
    PG8_STAGE(PG8_SB(0, 0), cB, voffB); PG8_STAGE(PG8_SB(0, 1), cB + hstepB, voffB); PG8_STAGE(PG8_SA(0, 0), cA, cV[0]); PG8_STAGE(PG8_SA(0, 1), cA, cV[1]);
    if (wr == 1) PG8_BAR;
    PG8_WAIT_V(2); PG8_BAR;
    PG8_STAGE(PG8_SB(1, 0), cB + kstep, voffB); PG8_STAGE(PG8_SA(1, 0), cA + kstep, cV[0]); PG8_STAGE(PG8_SB(1, 1), cB + hstepB + kstep, voffB);
    PG8_WAIT_V(6); PG8_BAR;
    for (;;) {
        has_next = S.next(ui + 1, nxt);
        const char* nA = cA; const char* nB = cB; int nnt = nt;
        if (has_next) { P.ptrs(nxt, nA, nB, nnt); if constexpr (Prob::GATHER) P.gather(ui + 1, pR, pC, nV); }
        else { if constexpr (Prob::GATHER) { nV[0][0] = cV[0][0]; nV[0][1] = cV[0][1]; nV[1][0] = cV[1][0]; nV[1][1] = cV[1][1]; } }
        for (int t = 0; t < nt; t += 2) {
            const bool last = (t == nt - 2);
            const char* a1 = cA + (size_t)(t + 1) * kstep;
            const char* a2 = last ? nA : cA + (size_t)(t + 2) * kstep; const char* b2 = last ? nB : cB + (size_t)(t + 2) * kstep;
            const char* a3 = a2 + kstep; const char* b3 = b2 + kstep;
            unsigned v2[2][2];
            if constexpr (Prob::GATHER) { v2[0][0] = last ? nV[0][0] : cV[0][0]; v2[0][1] = last ? nV[0][1] : cV[0][1]; v2[1][0] = last ? nV[1][0] : cV[1][0]; v2[1][1] = last ? nV[1][1] : cV[1][1]; }
            else { v2[0][0] = cV[0][0]; v2[0][1] = cV[0][1]; v2[1][0] = cV[1][0]; v2[1][1] = cV[1][1]; }
            PG8_LDB(B0, 0, 0); PG8_LDB(B1, 0, 1); PG8_SCHED; PG8_LDA(At, 0, 0); PG8_STAGE(PG8_SA(1, 1), a1, cV[1]);
            PG8_WAIT_V(8); PG8_WAIT_L(0); PG8_BAR; PG8_MMA(0, 0, At, B0); PG8_MMA(0, 1, At, B1); PG8_BAR; PG8_SCHED;
            PG8_LDA(At, 0, 1); PG8_STAGE(PG8_SB(0, 0), b2, voffB); PG8_STAGE(PG8_SB(0, 1), b2 + hstepB, voffB); PG8_STAGE(PG8_SA(0, 0), a2, v2[0]);
            PG8_WAIT_V(8); PG8_WAIT_L(0); PG8_BAR; PG8_MMA(1, 0, At, B0); PG8_MMA(1, 1, At, B1); PG8_BAR; PG8_SCHED;
            PG8_LDB(B0, 1, 0); PG8_LDB(B1, 1, 1); PG8_SCHED; PG8_LDA(At, 1, 0); PG8_STAGE(PG8_SA(0, 1), a2, v2[1]);
            PG8_WAIT_V(8); PG8_WAIT_L(0); PG8_BAR; PG8_MMA(0, 0, At, B0); PG8_MMA(0, 1, At, B1); PG8_BAR; PG8_SCHED;
            PG8_LDA(At, 1, 1); PG8_STAGE(PG8_SB(1, 0), b3, voffB); PG8_STAGE(PG8_SB(1, 1), b3 + hstepB, voffB); PG8_STAGE(PG8_SA(1, 0), a3, v2[0]);
            PG8_WAIT_V(8); PG8_WAIT_L(0); PG8_BAR; PG8_MMA(1, 0, At, B0); PG8_MMA(1, 1, At, B1); PG8_BAR; PG8_SCHED;
        }
        if constexpr (ALIGN_EPI) { if (wr == 0) PG8_BAR; }
        if constexpr (!Epi::AFTER_DRAIN) { _Pragma("unroll") for (int rep_ = 0; rep_ < EPI_REP; ++rep_) E(acc, cur, wr, wc, fr, fq); }
        if (!has_next) break;
#pragma unroll
        for (int a = 0; a < 2; ++a)
#pragma unroll
            for (int b = 0; b < 2; ++b)
#pragma unroll
                for (int m = 0; m < 4; ++m)
#pragma unroll
                    for (int n = 0; n < 2; ++n) acc[a][b][m][n] = (f32x4){0.f, 0.f, 0.f, 0.f};
        cur = nxt; cA = nA; cB = nB; nt = nnt; ++ui;
        if constexpr (Prob::GATHER) { cV[0][0] = nV[0][0]; cV[0][1] = nV[0][1]; cV[1][0] = nV[1][0]; cV[1][1] = nV[1][1]; }
        if constexpr (ALIGN_EPI) { if (wr == 1) PG8_BAR; }
    }
    PG8_WAIT_V(0);
    if constexpr (!ALIGN_EPI) { if (wr == 0) PG8_BAR; }
    PG8_BAR;
    if constexpr (Epi::AFTER_DRAIN) { E.fused(acc, cur, wr, wc, fr, fq, lds, wid, lane); }
#undef PG8_SA
#undef PG8_SB
#undef PG8_STAGE
#undef PG8_LDA
#undef PG8_LDB
#undef PG8_MMA
#undef PG8_LO
#undef PG8_HI
#undef PG8_WAIT_V
#undef PG8_WAIT_L
#undef PG8_BAR
#undef PG8_SCHED
}
}
#include <hip/hip_bf16.h>
#include <cmath>
namespace attn_body {
using bf16=__hip_bfloat16;
using bf16x8=__attribute__((ext_vector_type(8)))short;
using s16x4=__attribute__((ext_vector_type(4)))short;
using f32x16=__attribute__((ext_vector_type(16)))float;
using u32x4=__attribute__((ext_vector_type(4)))unsigned;
constexpr int BATCH=8,NHEAD=8,SEQ=2048,D=64,DM=NHEAD*D,DMO=1024;
constexpr int NW=8,QBLK=32,QB=QBLK*NW,KVBLK=64,NQB=SEQ/QB;
constexpr int ATTN_PITCH=DM, ATTN_OPITCH=DMO, ATTN_UNIT_ROWS=QB;
__device__ __forceinline__ int crow(int r,int hi){return (r&3)+8*(r>>2)+4*hi;}
#define SBAR() __builtin_amdgcn_sched_barrier(0)
__device__ __forceinline__ void cmask(f32x16&p0,f32x16&p1,int jb,int qrel,int hi){
  const float NEG=-INFINITY; int kb=64*jb+4*hi;
  #pragma unroll
  for(int r=0;r<16;++r){int kv=kb+(r&3)+8*(r>>2); if(kv>qrel)p0[r]=NEG; if(kv+32>qrel)p1[r]=NEG;}
}

constexpr int NSLOT=3, SLOTB=8192;
constexpr int LDS_K=0, LDS_V=NSLOT*SLOTB, LDS_WS=2*NSLOT*SLOTB, LDS_OST=LDS_WS+NW*64*4, LDS_BIAS=LDS_OST+NW*4096, LDS_BYTES=LDS_BIAS+SEQ*4;
constexpr float C2=0.125f*1.4426950408889634f;
__device__ __forceinline__ void glds16(const void*gsrc,unsigned lds_dst){unsigned keep;
  asm volatile("s_mov_b32 %0, m0\n\ts_mov_b32 m0, %2\n\ts_nop 0\n\tglobal_load_lds_dwordx4 %1, off\n\ts_mov_b32 m0, %0":"=&s"(keep):"v"(gsrc),"s"(lds_dst):"memory");}
__device__ __forceinline__ float max3f(float a,float b,float c){float r;asm("v_max3_f32 %0, %1, %2, %3":"=v"(r):"v"(a),"v"(b),"v"(c));return r;}
__device__ __forceinline__ float max2f(float a,float b){float r;asm("v_max_f32_e32 %0, %1, %2":"=v"(r):"v"(a),"v"(b));return r;}
__device__ __forceinline__ float fadd_s(float a,float b){float r;asm("v_add_f32_e32 %0, %1, %2":"=v"(r):"v"(a),"v"(b));return r;}
__device__ __forceinline__ float fsub_s(float a,float b){float r;asm("v_sub_f32_e32 %0, %1, %2":"=v"(r):"v"(a),"v"(b));return r;}
typedef float f32x2_t __attribute__((ext_vector_type(2))); typedef float f32x4_t __attribute__((ext_vector_type(4))); typedef __bf16 bf16x2_t __attribute__((ext_vector_type(2)));
__device__ __forceinline__ unsigned cvtpk_s(float lo,float hi){f32x2_t v={lo,hi};bf16x2_t b=__builtin_convertvector(v,bf16x2_t);return __builtin_bit_cast(unsigned,b);}
#define WAIT_BAR(N) asm volatile("s_waitcnt vmcnt(" #N ") lgkmcnt(0)\n\ts_barrier":::"memory")

__device__ __forceinline__ void qkt(f32x16&p0,f32x16&p1,const char*Kslot,const bf16x8*qr,const f32x16&negm,int r32,int hi){
  const char*kb=Kslot+hi*1024+r32*16;
  #pragma unroll
  for(int d0=0;d0<4;++d0){
    const bf16x8 b0=*reinterpret_cast<const bf16x8*>(kb+d0*2048);
    const bf16x8 b1=*reinterpret_cast<const bf16x8*>(kb+d0*2048+512);
    if(d0==0){p0=__builtin_amdgcn_mfma_f32_32x32x16_bf16(b0,qr[0],negm,0,0,0);p1=__builtin_amdgcn_mfma_f32_32x32x16_bf16(b1,qr[0],negm,0,0,0);}
    else{p0=__builtin_amdgcn_mfma_f32_32x32x16_bf16(b0,qr[d0],p0,0,0,0);p1=__builtin_amdgcn_mfma_f32_32x32x16_bf16(b1,qr[d0],p1,0,0,0);}}
}
typedef __attribute__((address_space(3))) const char* lds_cptr;
typedef short v4i16_t __attribute__((ext_vector_type(4)));
__device__ __forceinline__ void kload8(bf16x8*kf,lds_cptr kp){
  kf[0]=*(const __attribute__((address_space(3))) bf16x8*)(kp);      kf[1]=*(const __attribute__((address_space(3))) bf16x8*)(kp+512);
  kf[2]=*(const __attribute__((address_space(3))) bf16x8*)(kp+2048); kf[3]=*(const __attribute__((address_space(3))) bf16x8*)(kp+2560);
  kf[4]=*(const __attribute__((address_space(3))) bf16x8*)(kp+4096); kf[5]=*(const __attribute__((address_space(3))) bf16x8*)(kp+4608);
  kf[6]=*(const __attribute__((address_space(3))) bf16x8*)(kp+6144); kf[7]=*(const __attribute__((address_space(3))) bf16x8*)(kp+6656);
}
__device__ __forceinline__ void kload2(bf16x8*kf,lds_cptr kp,int j){ kf[2*j]=*(const __attribute__((address_space(3))) bf16x8*)(kp+j*2048); kf[2*j+1]=*(const __attribute__((address_space(3))) bf16x8*)(kp+j*2048+512); }
__device__ __forceinline__ s16x4 vtr(lds_cptr p){ return __builtin_bit_cast(s16x4,__builtin_amdgcn_ds_read_tr16_b64_v4i16((__attribute__((address_space(3))) v4i16_t*)p)); }
__device__ __forceinline__ float rowmax(const f32x16&p0,const f32x16&p1){
  float a=max3f(p0[0],p0[1],p1[0]),b=max3f(p0[2],p0[3],p1[1]);a=max3f(a,p1[2],p1[3]);
  #pragma unroll
  for(int r=4;r<16;r+=4){a=max3f(a,p0[r],p0[r+1]);b=max3f(b,p0[r+2],p0[r+3]);a=max3f(a,p1[r],p1[r+1]);b=max3f(b,p1[r+2],p1[r+3]);}
  const float m=max2f(a,b);
  auto rr=__builtin_amdgcn_permlane32_swap(__float_as_uint(m),__float_as_uint(m),false,false);
  return max2f(__uint_as_float(rr[0]),__uint_as_float(rr[1]));
}
__device__ __forceinline__ void pv(f32x16*o,int vb,bf16x8 pa0,bf16x8 pa1,bf16x8 pa2,bf16x8 pa3){
  #pragma unroll
  for(int d0=0;d0<2;++d0){s16x4 lo[4],hi[4];
    #pragma unroll
    for(int ks=0;ks<4;++ks){
      asm volatile("ds_read_b64_tr_b16 %0,%1 offset:%c2":"=&v"(lo[ks]):"v"(vb),"i"(d0*4096+ks*1024):"memory");
      asm volatile("ds_read_b64_tr_b16 %0,%1 offset:%c2":"=&v"(hi[ks]):"v"(vb),"i"(d0*4096+ks*1024+512):"memory");}
    asm volatile("s_waitcnt lgkmcnt(0)":::"memory");SBAR();
    #define PK(k) (bf16x8){lo[k][0],lo[k][1],lo[k][2],lo[k][3],hi[k][0],hi[k][1],hi[k][2],hi[k][3]}
    o[d0]=__builtin_amdgcn_mfma_f32_32x32x16_bf16(pa0,PK(0),o[d0],0,0,0);
    o[d0]=__builtin_amdgcn_mfma_f32_32x32x16_bf16(pa1,PK(1),o[d0],0,0,0);
    o[d0]=__builtin_amdgcn_mfma_f32_32x32x16_bf16(pa2,PK(2),o[d0],0,0,0);
    o[d0]=__builtin_amdgcn_mfma_f32_32x32x16_bf16(pa3,PK(3),o[d0],0,0,0);
    #undef PK
  }
}

#ifndef ATTN_STORE16
#define ATTN_STORE16(p,v) (*(u32x4*)(p)=(v))
#endif
template<int THRL> __device__ __forceinline__ void attn_unit(int b,int h,int qb,const bf16*Q,const bf16*__restrict__ K,const bf16*__restrict__ V,bf16*O,const float*__restrict__ Fb,char*shm){
  asm volatile("":"+s"(Q),"+s"(K),"+s"(V),"+s"(O),"+s"(Fb));
  int tid_=threadIdx.x; asm volatile("":"+v"(tid_));
  const int tid=tid_,lane=tid&63,r32=lane&31,hi=lane>>5; const int wid=__builtin_amdgcn_readfirstlane(tid>>6);
  const long rowbase=(long)b*SEQ; const int q0=qb*QB;
  const bf16*Qw=Q+(rowbase+q0+wid*QBLK)*DM+h*D;
  const bf16*Kh=K+rowbase*DM+h*D,*Vh=V+rowbase*DM+h*D;
  const unsigned lds0=(unsigned)(uintptr_t)shm;
  float*wsf=(float*)(shm+LDS_WS)+wid*64;
  const bf16*ksrc=Kh+(long)lane*DM+wid*8;
  const bf16*vsrc=Vh+(long)(16*(wid&3)+(lane>>2))*DM+(wid>>2)*32+(lane&3)*8;
  const unsigned kdst=lds0+LDS_K+wid*1024, vdst=lds0+LDS_V+wid*1024;
  #define DMA_K(t,slot) glds16(ksrc+(long)(t)*KVBLK*DM,(unsigned)__builtin_amdgcn_readfirstlane(kdst+(slot)))
  #define DMA_V(t,slot) glds16(vsrc+(long)(t)*KVBLK*DM,(unsigned)__builtin_amdgcn_readfirstlane(vdst+(slot)))
  const int vb0=(int)(lds0+LDS_V)+((lane>>4)&1)*32+(lane&3)*8+(4*hi+((lane&15)>>2))*64;
  const char*Kbase=shm+LDS_K; bf16x8 kf[8];
  const lds_cptr shm3=(lds_cptr)shm; const lds_cptr kp0=shm3+LDS_K+hi*1024+r32*16; const lds_cptr vp0=shm3+LDS_V+((lane>>4)&1)*32+(lane&3)*8+(4*hi+((lane&15)>>2))*64;
  const int NT=(q0+QB)/KVBLK;
  glds16(Fb+wid*256+lane*4,(unsigned)__builtin_amdgcn_readfirstlane(lds0+LDS_BIAS+wid*1024));
  DMA_K(0,0);DMA_V(0,0);DMA_K(1,SLOTB);
  bf16x8 qr[4];
  #pragma unroll
  for(int d0=0;d0<4;++d0)qr[d0]=*reinterpret_cast<const bf16x8*>(&Qw[(long)r32*DM+d0*16+hi*8]);
  float mhat=0.f,l_reg=0.f;f32x16 o[2];o[0]=f32x16{};o[1]=f32x16{};f32x16 negm;
  #pragma unroll
  for(int r=0;r<16;++r)asm volatile("v_mov_b32 %0, 0":"=v"(negm[r]));
  asm volatile("":"+v"(negm));
  const int qrel=wid*QBLK+r32;
  #define CMASK(P0,P1,t) do{int jb_=(t)-(NT-4); if(jb_>=0)cmask(P0,P1,jb_,qrel,hi);}while(0)
  #define BIAS(P0,P1,t) do{ const __attribute__((address_space(3))) f32x4_t* bp_=(const __attribute__((address_space(3))) f32x4_t*)(shm3+LDS_BIAS)+(t)*16+hi; \
    _Pragma("unroll") for(int j_=0;j_<4;++j_){ const f32x4_t b0_=bp_[2*j_], b1_=bp_[8+2*j_]; \
      P0[4*j_]+=b0_[0]; P0[4*j_+1]+=b0_[1]; P0[4*j_+2]+=b0_[2]; P0[4*j_+3]+=b0_[3]; \
      P1[4*j_]+=b1_[0]; P1[4*j_+1]+=b1_[1]; P1[4*j_+2]+=b1_[2]; P1[4*j_+3]+=b1_[3]; } }while(0)
  bool resc=false;
  #define START(P0,P1) do{ _Pragma("unroll") for(int r=0;r<16;++r)P0[r]=__builtin_amdgcn_exp2f(P0[r]); }while(0)
  #define RESC() do{}while(0)
  f32x16 pA0,pA1,pB0,pB1;
  int sl_prev=0,sl_cur=0,sl_next=SLOTB;
  #define ROT() do{sl_prev=sl_cur;sl_cur=sl_next;sl_next=(sl_next==(NSLOT-1)*SLOTB)?0:sl_next+SLOTB;}while(0)
  DMA_K(2,2*SLOTB);
  WAIT_BAR(3);
  { mhat=*(const __attribute__((address_space(3))) float*)(shm3+LDS_BIAS+(q0+qrel)*4);
    _Pragma("unroll") for(int r=0;r<16;++r)negm[r]=-mhat; asm volatile("":"+v"(negm)); }
  qkt(pA0,pA1,Kbase,qr,negm,r32,hi);asm volatile("s_nop 15\n\ts_nop 7":"+v"(pA0),"+v"(pA1));BIAS(pA0,pA1,0);CMASK(pA0,pA1,0);
  START(pA0,pA1);
  _Pragma("unroll") for(int r=0;r<16;++r)pA1[r]=__builtin_amdgcn_exp2f(pA1[r]);
  WAIT_BAR(0);
  DMA_K(3,0);DMA_V(1,SLOTB);
  ROT();
  kload8(kf,kp0+sl_cur);
  WAIT_BAR(2);
  s16x4 vlo[8],vhi[8]; u32x4 pw0,pw1,pw2,pw3;
  #define PKW(P,B) cvtpk_s(P[B],P[B+1])
  #define PAF(k) __builtin_bit_cast(bf16x8,pw##k)
  #define VFR(i) (bf16x8){vlo[i][0],vlo[i][1],vlo[i][2],vlo[i][3],vhi[i][0],vhi[i][1],vhi[i][2],vhi[i][3]}
  #define PIN(x) asm volatile("":"+v"(x))
  #define MX3(a,b,c) __builtin_fmaxf(__builtin_fmaxf((a),(b)),(c))
  #define GAPA(MF,A0,A1,A2,A3,W0,W1,PW) do{ MF; sacc+=A0; sacc+=A1; sacc+=A2; sacc+=A3; PIN(sacc); W0; W1; PIN(PW); SBAR(); }while(0)
  #define EX(v) __builtin_amdgcn_exp2f(v)
  #define GAPB(MF,X,B) do{ MF; X[B]=EX(X[B]); X[B+1]=EX(X[B+1]); X[B+2]=EX(X[B+2]); X[B+3]=EX(X[B+3]); PIN(X); SBAR(); }while(0)
  #define VRD(i) do{ vlo[i]=vtr(vp_+(((i)>>2)*4096+((i)&3)*1024)); vhi[i]=vtr(vp_+(((i)>>2)*4096+((i)&3)*1024+512)); }while(0)
  #define KRD(G,j) do{ if(G){ kload2(kf,kp0+sl_next,j); SBAR(); } }while(0)
  #define STEP(C0,C1,P0,P1,t,GK,GV,GL) do{ SBAR(); \
    const lds_cptr vp_=vp0+sl_prev; \
    VRD(0); SBAR(); float sacc=(P0[0]+P0[1]); \
    GAPA(C0=__builtin_amdgcn_mfma_f32_32x32x16_bf16(kf[0],qr[0],negm,0,0,0), P0[2],P0[3],P0[4],P0[5],     pw0[0]=PKW(P0,0), pw0[1]=PKW(P0,2), pw0); \
    VRD(4); SBAR(); GAPA(C1=__builtin_amdgcn_mfma_f32_32x32x16_bf16(kf[1],qr[0],negm,0,0,0), P0[6],P0[7],P0[8],P0[9],     pw0[2]=PKW(P0,4), pw0[3]=PKW(P0,6), pw0); \
    VRD(1); SBAR(); GAPA(C0=__builtin_amdgcn_mfma_f32_32x32x16_bf16(kf[2],qr[1],C0,0,0,0),   P0[10],P0[11],P0[12],P0[13], pw1[0]=PKW(P0,8), pw1[1]=PKW(P0,10), pw1); \
    VRD(5); SBAR(); GAPA(C1=__builtin_amdgcn_mfma_f32_32x32x16_bf16(kf[3],qr[1],C1,0,0,0),   P0[14],P0[15],P1[0],P1[1],   pw1[2]=PKW(P0,12),pw1[3]=PKW(P0,14), pw1); \
    VRD(2); SBAR(); GAPA(C0=__builtin_amdgcn_mfma_f32_32x32x16_bf16(kf[4],qr[2],C0,0,0,0),   P1[2],P1[3],P1[4],P1[5],     pw2[0]=PKW(P1,0), pw2[1]=PKW(P1,2), pw2); \
    VRD(6); SBAR(); GAPA(C1=__builtin_amdgcn_mfma_f32_32x32x16_bf16(kf[5],qr[2],C1,0,0,0),   P1[6],P1[7],P1[8],P1[9],     pw2[2]=PKW(P1,4), pw2[3]=PKW(P1,6), pw2); \
    VRD(3); SBAR(); GAPA(C0=__builtin_amdgcn_mfma_f32_32x32x16_bf16(kf[6],qr[3],C0,0,0,0),   P1[10],P1[11],P1[12],P1[13], pw3[0]=PKW(P1,8), pw3[1]=PKW(P1,10), pw3); \
    VRD(7); SBAR(); GAPA(C1=__builtin_amdgcn_mfma_f32_32x32x16_bf16(kf[7],qr[3],C1,0,0,0),   P1[14],P1[15],0.f,0.f,       pw3[2]=PKW(P1,12),pw3[3]=PKW(P1,14), pw3); \
    l_reg+=sacc; \
    if(GK){DMA_K((t)+3,sl_cur);} if(GV){DMA_V((t)+1,sl_next);} \
    BIAS(C0,C1,t); CMASK(C0,C1,t); \
    SBAR(); \
    GAPB(o[0]=__builtin_amdgcn_mfma_f32_32x32x16_bf16(PAF(0),VFR(0),o[0],0,0,0), C0,0); \
    GAPB(o[1]=__builtin_amdgcn_mfma_f32_32x32x16_bf16(PAF(0),VFR(4),o[1],0,0,0), C0,4); \
    KRD(GL,0); GAPB(o[0]=__builtin_amdgcn_mfma_f32_32x32x16_bf16(PAF(1),VFR(1),o[0],0,0,0), C0,8); \
    KRD(GL,1); GAPB(o[1]=__builtin_amdgcn_mfma_f32_32x32x16_bf16(PAF(1),VFR(5),o[1],0,0,0), C0,12); \
    KRD(GL,2); GAPB(o[0]=__builtin_amdgcn_mfma_f32_32x32x16_bf16(PAF(2),VFR(2),o[0],0,0,0), C1,0); \
    KRD(GL,3); GAPB(o[1]=__builtin_amdgcn_mfma_f32_32x32x16_bf16(PAF(2),VFR(6),o[1],0,0,0), C1,4); \
    GAPB(o[0]=__builtin_amdgcn_mfma_f32_32x32x16_bf16(PAF(3),VFR(3),o[0],0,0,0), C1,8); \
    GAPB(o[1]=__builtin_amdgcn_mfma_f32_32x32x16_bf16(PAF(3),VFR(7),o[1],0,0,0), C1,12); \
    }while(0)
  int t=1;
  #undef CMASK
  #define CMASK(P0,P1,t) do{}while(0)
  for(;t+5<NT;t+=2){
    STEP(pB0,pB1,pA0,pA1,t,true,true,true);     WAIT_BAR(2); RESC(); ROT();
    STEP(pA0,pA1,pB0,pB1,t+1,true,true,true);   WAIT_BAR(2); RESC(); ROT();
  }
  #undef CMASK
  #define CMASK(P0,P1,t) do{int jb_=(t)-(NT-4); if(jb_>=0)cmask(P0,P1,jb_,qrel,hi);}while(0)
  #define ENDW(tt) do{ if((tt)+3<NT){WAIT_BAR(2);} else if((tt)+2<NT){WAIT_BAR(1);} else {WAIT_BAR(0);} }while(0)
  for(;t+1<NT;t+=2){
    STEP(pB0,pB1,pA0,pA1,t,(t+3<NT),(t+1<NT),(t+1<NT));       ENDW(t);   RESC(); ROT();
    STEP(pA0,pA1,pB0,pB1,t+1,(t+4<NT),(t+2<NT),(t+2<NT));     ENDW(t+1); RESC(); ROT();
  }
  STEP(pB0,pB1,pA0,pA1,NT-1,false,false,false); RESC();
  { float sacc=pB0[0]+pB0[1]; _Pragma("unroll") for(int r=2;r<16;++r)sacc+=pB0[r]; _Pragma("unroll") for(int r=0;r<16;++r)sacc+=pB1[r]; l_reg+=sacc;
    pw0=(u32x4){PKW(pB0,0),PKW(pB0,2),PKW(pB0,4),PKW(pB0,6)};pw1=(u32x4){PKW(pB0,8),PKW(pB0,10),PKW(pB0,12),PKW(pB0,14)};pw2=(u32x4){PKW(pB1,0),PKW(pB1,2),PKW(pB1,4),PKW(pB1,6)};pw3=(u32x4){PKW(pB1,8),PKW(pB1,10),PKW(pB1,12),PKW(pB1,14)};
    SBAR(); pv(o,vb0+sl_cur,PAF(0),PAF(1),PAF(2),PAF(3)); }
  #undef PKW
  #undef PAF
  #undef VFR
  #undef PIN
  #undef MX3
  #undef GAPA
  #undef GAPB
  #undef EX
  #undef VRD
  #undef KRD
  #undef STEP
  #undef ENDW
  {auto rr=__builtin_amdgcn_permlane32_swap(__float_as_uint(l_reg),__float_as_uint(l_reg),false,false);l_reg=__uint_as_float(rr[0])+__uint_as_float(rr[1]);}
  {
    int tid2=threadIdx.x; asm volatile("":"+v"(tid2)); const int lane2=tid2&63,r32b=lane2&31,hib=lane2>>5; const int wid2=__builtin_amdgcn_readfirstlane(tid2>>6);
    float*wsf2=(float*)(shm+LDS_WS)+wid2*64;
    if(hib==0)wsf2[32+r32b]=l_reg;asm volatile("s_waitcnt lgkmcnt(0)":::"memory");
    float rli[16];
    #pragma unroll
    for(int r=0;r<16;++r)rli[r]=__builtin_amdgcn_rcpf(wsf2[32+crow(r,hib)]);
    bf16*Ow=O+((long)b*SEQ+qb*QB+wid2*QBLK)*DMO+h*D;
    bf16*stg=(bf16*)(shm+LDS_OST)+wid2*2048;
    #pragma unroll
    for(int r=0;r<16;++r){const int orow=crow(r,hib);
      #pragma unroll
      for(int d0=0;d0<2;++d0)stg[orow*64+d0*32+r32b]=__float2bfloat16(o[d0][r]*rli[r]);}
    asm volatile("s_waitcnt lgkmcnt(0)":::"memory");
    #pragma unroll
    for(int i=0;i<4;++i){const int row=i*8+(lane2>>3),ch=lane2&7; const u32x4 v=*(const u32x4*)(stg+row*64+ch*8); ATTN_STORE16(Ow+(long)row*DMO+ch*8,v);} }
  asm volatile("s_waitcnt lgkmcnt(0)\n\ts_barrier":::"memory");
  #undef DMA_K
  #undef DMA_V
  #undef CMASK
  #undef START
  #undef RESC
  #undef ROT
}
constexpr int ATTN_LDS_BYTES=LDS_BYTES;
struct AttnTensors { const bf16* Q; const bf16* K; const bf16* V; bf16* O; const float* Fneg; };
struct AttnUnit { int bh; int qb; };
struct StaticOrder {
  int vcu;
  __device__ __forceinline__ explicit StaticOrder(int grid,int block):vcu((block%8)*(grid/8)+block/8){}
  __device__ __forceinline__ bool next(int i,AttnUnit&u)const{ if(i>=2||vcu>=256)return false; const int s=vcu&3; u.bh=vcu>>2; u.qb=(i==0)?s:7-s; return true; }
  __device__ __forceinline__ void a_ready(const AttnUnit&)const{}
  __device__ __forceinline__ void done(const AttnUnit&)const{}
};
template<class Sched,int THRL=8> __device__ __forceinline__ void attn_phase(char*lds,const AttnTensors&T,const Sched&S){
  AttnUnit u;
  for(int i=0;S.next(i,u);++i){ S.a_ready(u); attn_unit<THRL>(u.bh/NHEAD,u.bh%NHEAD,u.qb,T.Q,T.K,T.V,T.O,T.Fneg+(long)u.bh*SEQ,lds); S.done(u); }
}
#undef SBAR
#undef WAIT_BAR
}
#define GAS __attribute__((address_space(1)))
#define LAS __attribute__((address_space(3)))
typedef unsigned short bf16;
typedef unsigned v4u __attribute__((ext_vector_type(4)));
typedef float f32x4 __attribute__((ext_vector_type(4)));
typedef short bf16x8 __attribute__((ext_vector_type(8)));
typedef GAS unsigned gu32;
typedef GAS unsigned long long gu64;
#define RLX_AGENT __ATOMIC_RELAXED, __HIP_MEMORY_SCOPE_AGENT
#define LDS_WAIT() asm volatile("s_waitcnt lgkmcnt(0)" ::: "memory")
#define VM_WAIT() asm volatile("s_waitcnt vmcnt(0)" ::: "memory")
__device__ __forceinline__ unsigned long long rt() { return __builtin_amdgcn_s_memrealtime(); }
__device__ __forceinline__ unsigned f2bf(float f) { unsigned u = __builtin_bit_cast(unsigned, f); return (u + 0x7fffu + ((u >> 16) & 1u)) >> 16; }
__device__ __forceinline__ unsigned pk2(float lo, float hi) { return f2bf(lo) | (f2bf(hi) << 16); }

#define XB_TMO      128
#define XB_XCNT(j)  (256  + 64 * (j))
#define XB_XSUB(j)  (1280 + 64 * (j))
#define XB_XGEN(j)  (2304 + 64 * (j))
#define XB_TOP      3328
#define XB_TOPGEN   3392
#define XCD_BAR_WORDS 3456
#define XB_SPIN_CAP (1u << 18)

__device__ __forceinline__ unsigned xb_ld(unsigned* p)              { return __hip_atomic_load(p, __ATOMIC_RELAXED, __HIP_MEMORY_SCOPE_AGENT); }
__device__ __forceinline__ unsigned xb_add(unsigned* p, unsigned v) { return __hip_atomic_fetch_add(p, v, __ATOMIC_RELAXED, __HIP_MEMORY_SCOPE_AGENT); }
__device__ __forceinline__ unsigned xb_xcc_id() { return (unsigned)__builtin_amdgcn_s_getreg((3 << 11) | 20) & 0xFu; }
#define XB_SPIN(cond, bar) do { unsigned _sp = 0; while (cond) { __builtin_amdgcn_s_sleep(1); \
    if ((++_sp & 255u) == 0u) { if (xb_ld(&(bar)[XB_TMO])) break; if (_sp > XB_SPIN_CAP) { atomicAdd(&(bar)[XB_TMO], 1u); break; } } } } while (0)

struct XcdBarrier {
    unsigned* bar; unsigned x;
    volatile LAS unsigned* st;
};

__device__ __forceinline__ XcdBarrier xcd_barrier_post(unsigned* bar, volatile LAS unsigned* st) {
    XcdBarrier b; b.bar = bar; b.x = xb_xcc_id(); b.st = st;
    if (threadIdx.x == 0) (void)xb_add(&bar[XB_XCNT(b.x)], 1u);
    return b;
}
__device__ __forceinline__ void xcd_barrier_complete(unsigned* bar, unsigned x, unsigned& nloc, unsigned& nx) {
    const unsigned G = gridDim.x * gridDim.y * gridDim.z;
    unsigned sum, cnt, mine, sp = 0u;
    for (;;) {
        sum = 0u; cnt = 0u; mine = 0u;
#pragma unroll
        for (unsigned j = 0; j < 16; ++j) { const unsigned c = xb_ld(&bar[XB_XCNT(j)]); sum += c; cnt += (c > 0u) ? 1u : 0u; mine = (j == x) ? c : mine; }
        if (sum == G) break;
        __builtin_amdgcn_s_sleep(1);
        if ((++sp & 255u) == 0u) { if (xb_ld(&bar[XB_TMO])) break; if (sp > XB_SPIN_CAP) { atomicAdd(&bar[XB_TMO], 1u); break; } }
    }
    nloc = mine > 0u ? mine : 1u; nx = cnt > 0u ? cnt : 1u;
}

__device__ __forceinline__ void xcd_barrier(const XcdBarrier& b) {
    asm volatile("s_waitcnt vmcnt(0)" ::: "memory");
    __syncthreads();
    if (threadIdx.x == 0) {
        unsigned* bar = b.bar;
        __builtin_amdgcn_s_waitcnt(0);
        unsigned nloc = b.st[0], nx = b.st[1];
        if (nloc == 0u) { xcd_barrier_complete(bar, b.x, nloc, nx); b.st[0] = nloc; b.st[1] = nx; }
        const unsigned old = xb_add(&bar[XB_XSUB(b.x)], 1u);
        const unsigned gen = old / nloc;
        if (old + 1u == (gen + 1u) * nloc) {
            __builtin_amdgcn_fence(__ATOMIC_RELEASE, "agent");
            asm volatile("s_waitcnt vmcnt(0)" ::: "memory");
            const unsigned og = xb_add(&bar[XB_TOP], 1u);
            const unsigned tg = og / nx;
            if (og + 1u == (tg + 1u) * nx) xb_add(&bar[XB_TOPGEN], 1u);
            else XB_SPIN(xb_ld(&bar[XB_TOPGEN]) == tg, bar);
            __builtin_amdgcn_fence(__ATOMIC_ACQUIRE, "agent");
            xb_add(&bar[XB_XGEN(b.x)], 1u);
            asm volatile("s_waitcnt vmcnt(0)" ::: "memory");
        } else {
            XB_SPIN(xb_ld(&bar[XB_XGEN(b.x)]) == gen, bar);
            __builtin_amdgcn_fence(__ATOMIC_ACQUIRE, "agent");
            asm volatile("s_waitcnt vmcnt(0)" ::: "memory");
        }
    }
    __syncthreads();
}

constexpr int NWAVES = 8;
constexpr int NB = 8, SEQ = 2048, M = NB * SEQ, D = 1024, NH = 8, DH = 64, FW = 512, PW = 512, INW = 2056, DFF = 2816, NE = 8;
constexpr int SG = 64, SGH = 16, SP = 64;
constexpr int CL = 32, NCH = SEQ / CL, NBC = NB * NCH, KA = 2 * SP + CL * SGH;
constexpr float EPS = 1e-6f, LOG2E = 1.4426950408889634f;
static_assert(KA == 640 && NBC == 512, "ssm chunk geometry");

constexpr size_t MiB = 1u << 20, KiB = 1024;
constexpr size_t WS_CTL = 0, CTL_ZERO_BYTES = 1 * MiB;
constexpr size_t WS_LOGF = 1 * MiB;
constexpr size_t WS_FNEG = WS_LOGF + 512 * KiB;
constexpr size_t WS_SSQ1 = 2 * MiB;
constexpr size_t WS_SSQ2 = WS_SSQ1 + 256 * KiB;
constexpr size_t WS_AL   = WS_SSQ2 + 256 * KiB;
constexpr size_t WS_TOKE = WS_AL + 64 * KiB;
constexpr size_t WS_GATE = WS_TOKE + 64 * KiB;
constexpr size_t WS_POS  = WS_GATE + 128 * KiB;
constexpr size_t WS_CNT  = WS_POS + 128 * KiB;
constexpr size_t WS_TAB  = WS_CNT + 16 * KiB;
constexpr size_t WS_TOKS = WS_TAB + 16 * KiB;
static_assert(WS_TOKS + (2 * M + 256) * 4 <= 4 * MiB, "small tables");
constexpr size_t WS_WIN0 = 4 * MiB;
constexpr size_t WS_WOT  = 8 * MiB;
constexpr size_t WS_W13  = 10 * MiB;
constexpr size_t WS_W2T  = 21 * MiB;
constexpr size_t WS_WIN1 = 27 * MiB;
constexpr size_t WS_WGLU = 29 * MiB;
constexpr size_t WS_W13E = 34 * MiB;
constexpr size_t WS_BT2  = 34 * MiB;
constexpr size_t WS_MG   = 74 * MiB;
constexpr size_t WS_YS   = 34 * MiB;
constexpr size_t WS_YP   = 70 * MiB;
constexpr size_t WS_W2E  = 122 * MiB;
constexpr size_t WS_R    = 166 * MiB;
constexpr size_t WS_H0   = WS_R;
constexpr size_t WS_QKVP = WS_R + 32 * MiB;
constexpr size_t WS_ACT0 = WS_R + 96 * MiB;
constexpr size_t WS_ACTS = WS_R + 32 * MiB;
constexpr size_t WS_H3   = 344 * MiB;
constexpr size_t WS_END  = 376 * MiB;
static_assert(WS_ACTS + (size_t)(2 * M + 256) * DFF <= WS_H3 && WS_ACT0 + (size_t)M * DFF * 2 <= WS_END && WS_W13E + (size_t)NE * 2 * DFF * D * 2 <= WS_W2E && WS_W2E + (size_t)NE * D * DFF * 2 <= WS_R, "d_ws map");
static_assert(WS_MG + (size_t)SG * 128 * 512 * 2 <= WS_W2E && WS_BT2 + (size_t)SG * 512 * KA * 2 <= WS_MG && WS_YS + (size_t)(2 * M + 256) * D * 2 <= WS_W2E, "d_ws map 2");
constexpr int CW_BAR = 4096;
constexpr int CW_W2E = 192;
constexpr int CW_RDY = 64;

constexpr int RING_OFF = 0, RING_BYTES = 131072;
constexpr int LDSCTL_OFF = RING_BYTES, MISC_OFF = LDSCTL_OFF + 320;
constexpr int LDS_BYTES = 147456;
static_assert(MISC_OFF + 128 <= LDS_BYTES && attn_body::ATTN_LDS_BYTES <= RING_BYTES, "LDS map");

struct Args { const float* in[30]; float* out; unsigned char* ws; int ph_lo, ph_hi; };
enum { I_X = 0, I_N0, I_WIN0, I_BF, I_WPOOL, I_PSCALE, I_WOUT, I_N1, I_W1, I_W3, I_W2, I_N2, I_WIN1, I_ARE, I_AIM, I_LOGDT, I_BRE, I_BIM, I_CRE, I_CIM, I_SD, I_GA, I_GB, I_N3, I_RW, I_RB, I_EW1, I_EW3, I_EW2, I_NF };

__device__ __forceinline__ float wave_sum(float v) {
#pragma unroll
    for (int o = 1; o < 64; o <<= 1) v += __shfl_xor(v, o);
    return v;
}
__device__ __forceinline__ void transpose_item(const float* W, int ldw, int k0, int c0, const float* gain, bf16* WT, int ldt, int drow0, LAS unsigned char* scr, int lane) {
    const int lr = lane >> 4, lc = lane & 15; f32x4 v[16];
    const GAS f32x4* src = (const GAS f32x4*)(W + (size_t)(k0 + lr) * ldw + c0) + lc;
#pragma unroll
    for (int i = 0; i < 16; ++i) v[i] = __builtin_nontemporal_load(src + (size_t)i * ldw);
    if (gain) {
#pragma unroll
        for (int i = 0; i < 16; ++i) v[i] = v[i] * gain[k0 + 4 * i + lr];
    }
#pragma unroll
    for (int i = 0; i < 16; ++i) { typedef unsigned u32x2v __attribute__((ext_vector_type(2))); u32x2v w; w.x = pk2(v[i].x, v[i].y); w.y = pk2(v[i].z, v[i].w);
        *(LAS u32x2v*)(scr + (4 * i + lr) * 136 + 8 * lc) = w; }
    LDS_WAIT(); asm volatile("" ::: "memory");
    const int c = lane & 7;
#pragma unroll
    for (int it = 0; it < 4; ++it) { const int np = (lane >> 3) + 8 * it; unsigned w[8];
#pragma unroll
        for (int j = 0; j < 8; ++j) w[j] = *(const LAS unsigned*)(scr + (8 * c + j) * 136 + 4 * np);
        v4u lo, hi;
        lo.x = (w[0] & 0xffffu) | (w[1] << 16); lo.y = (w[2] & 0xffffu) | (w[3] << 16); lo.z = (w[4] & 0xffffu) | (w[5] << 16); lo.w = (w[6] & 0xffffu) | (w[7] << 16);
        hi.x = (w[0] >> 16) | (w[1] & 0xffff0000u); hi.y = (w[2] >> 16) | (w[3] & 0xffff0000u); hi.z = (w[4] >> 16) | (w[5] & 0xffff0000u); hi.w = (w[6] >> 16) | (w[7] & 0xffff0000u);
        bf16* o = WT + (size_t)(drow0 + 2 * np) * ldt + k0 + 8 * c;
        *(GAS v4u*)o = lo; *(GAS v4u*)(o + ldt) = hi; }
    LDS_WAIT(); asm volatile("" ::: "memory");
}

__device__ __forceinline__ unsigned pk4_fp8(float a, float b, float c, float d) { int w = 0; w = __builtin_amdgcn_cvt_pk_fp8_f32(a, b, w, false); w = __builtin_amdgcn_cvt_pk_fp8_f32(c, d, w, true); return (unsigned)w; }
constexpr float W8_SCALE = 64.0f, W8_INV = 1.0f / 64.0f;
__device__ __forceinline__ void transpose_item_f8(const float* W, int ldw, int k0, int c0, float scale, unsigned char* WT, int ldt, int drow0, LAS unsigned char* scr, int lane) {
    const int lr = lane >> 4, lc = lane & 15; f32x4 v[32];
    const GAS f32x4* src = (const GAS f32x4*)(W + (size_t)(k0 + lr) * ldw + c0) + lc;
#pragma unroll
    for (int i = 0; i < 32; ++i) v[i] = __builtin_nontemporal_load(src + (size_t)i * ldw);
#pragma unroll
    for (int i = 0; i < 32; ++i) *(LAS unsigned*)(scr + (4 * i + lr) * 68 + 4 * lc) = pk4_fp8(v[i].x * scale, v[i].y * scale, v[i].z * scale, v[i].w * scale);
    LDS_WAIT(); asm volatile("" ::: "memory");
#pragma unroll
    for (int it = 0; it < 2; ++it) { const int nq = lane & 15, c = (lane >> 4) + 4 * it; unsigned d[16];
#pragma unroll
        for (int j = 0; j < 16; ++j) d[j] = *(const LAS unsigned*)(scr + (16 * c + j) * 68 + 4 * nq);
        v4u y[4];
#pragma unroll
        for (int q = 0; q < 4; ++q) { const unsigned x0 = d[4 * q], x1 = d[4 * q + 1], x2 = d[4 * q + 2], x3 = d[4 * q + 3];
            const unsigned t01l = __builtin_amdgcn_perm(x1, x0, 0x05010400u), t01h = __builtin_amdgcn_perm(x1, x0, 0x07030602u), t23l = __builtin_amdgcn_perm(x3, x2, 0x05010400u), t23h = __builtin_amdgcn_perm(x3, x2, 0x07030602u);
            y[0][q] = __builtin_amdgcn_perm(t23l, t01l, 0x05040100u); y[1][q] = __builtin_amdgcn_perm(t23l, t01l, 0x07060302u); y[2][q] = __builtin_amdgcn_perm(t23h, t01h, 0x05040100u); y[3][q] = __builtin_amdgcn_perm(t23h, t01h, 0x07060302u); }
        unsigned char* o = WT + (size_t)(drow0 + 4 * nq) * ldt + k0 + 16 * c;
#pragma unroll
        for (int b = 0; b < 4; ++b) *(GAS v4u*)(o + (size_t)b * ldt) = y[b]; }
    LDS_WAIT(); asm volatile("" ::: "memory");
}

struct PlainProb {
    static constexpr bool GATHER = false;
    const bf16* A; const bf16* Bt; int lda, ldb, ntk;
    __device__ __forceinline__ void ptrs(const pg8::Unit& u, const char*& a, const char*& b, int& nt) const { a = (const char*)A + (size_t)u.pm * 256 * lda; b = (const char*)Bt + (size_t)u.pn * 256 * ldb; nt = ntk; }
    __device__ __forceinline__ void gather(int, const int (&)[2], const int (&)[2], unsigned (&)[2][2]) const {}
};
struct SsmProb {
    static constexpr bool GATHER = false;
    const bf16* AG; const bf16* BT; int lda, ldb;
    __device__ __forceinline__ void ptrs(const pg8::Unit& u, const char*& a, const char*& b, int& nt) const {
        a = (const char*)(AG + ((size_t)u.x2 * NBC + (size_t)u.pm * 256) * KA); b = (const char*)(BT + ((size_t)u.x2 * 512 + (size_t)u.pn * 256) * KA); nt = 6 + 4 * u.pn; }
    __device__ __forceinline__ void gather(int, const int (&)[2], const int (&)[2], unsigned (&)[2][2]) const {}
};
struct SsmOrder {
    int vcu, G;
    __device__ __forceinline__ bool next(int i, pg8::Unit& u) const { const int L = i * G + vcu; if (L >= 256) return false; u.x2 = L >> 2; u.pm = (L >> 1) & 1; u.pn = L & 1; u.x0 = 0; u.x1 = 0; u.kq = -1; return true; }
};
struct MoeOrder : pg8::GridOrder {
    const unsigned* tab;
    __device__ __forceinline__ bool next(int i, pg8::Unit& u) const {
        if (!tile(i, u.pm, u.pn)) return false;
        u.kq = -1; int e = 0;
#pragma unroll
        for (int k = 1; k < NE; ++k) e += ((int)tab[16 + k] <= u.pm) ? 1 : 0;
        u.x2 = e; u.x0 = (int)tab[e] + 256 * (u.pm - (int)tab[16 + e]); u.x1 = (int)tab[e + 1]; return true;
    }
};
constexpr int YP_ROWS = 8 * 256 + 256, MAIN_TILES = 128;
struct MoeDownOrder {
    pg8::GridOrder G4; const unsigned* tab; int nM, G, c, nmain_c;
    __device__ __forceinline__ void init(const unsigned* tab_, int G_, int c_) { tab = tab_; nM = (int)tab[24]; G = G_; c = c_; const int nmt = nM < MAIN_TILES ? nM : MAIN_TILES; G4.init(nmt, D / 256, G_, c_); nmain_c = (G4.nwg - c_ + G_ - 1) / G_; if (nmain_c < 0) nmain_c = 0; }
    __device__ __forceinline__ bool next(int i, pg8::Unit& u) const {
        if (i < nmain_c) { if (!G4.tile(i, u.pm, u.pn)) return false; u.kq = -1; }
        else if (i == nmain_c) { const int nl = nM - MAIN_TILES; if (nl <= 0 || c >= 16 * nl) return false; u.pm = MAIN_TILES + c / 16; u.pn = (c >> 2) & 3; u.kq = c & 3; }
        else return false;
        int e = 0;
#pragma unroll
        for (int k = 1; k < NE; ++k) e += ((int)tab[16 + k] <= u.pm) ? 1 : 0;
        u.x2 = e; u.x0 = (int)tab[e] + 256 * (u.pm - (int)tab[16 + e]); u.x1 = (int)tab[e + 1]; return true;
    }
};
struct MoeUpProb {
    static constexpr bool GATHER = true;
    const unsigned char* H3; const unsigned char* W; const LAS unsigned short* TOKL; int lda, ldb;
    __device__ __forceinline__ void ptrs(const pg8::Unit& u, const char*& a, const char*& b, int& nt) const { a = (const char*)H3; b = (const char*)(W + ((size_t)u.x2 * (2 * DFF) + (size_t)u.pn * 256) * D); nt = D / 128; }
    __device__ __forceinline__ void gather(int ord, const int (&pR)[2], const int (&pC)[2], unsigned (&V)[2][2]) const {
#pragma unroll
        for (int h = 0; h < 2; ++h)
#pragma unroll
            for (int i = 0; i < 2; ++i) V[h][i] = (unsigned)TOKL[ord * 256 + 128 * h + pR[i]] * (unsigned)D + (unsigned)(pC[i] * 2);
    }
};
struct MoeDownProb {
    static constexpr bool GATHER = false;
    const unsigned char* ACTS; const unsigned char* W; int lda, ldb;
    __device__ __forceinline__ void ptrs(const pg8::Unit& u, const char*& a, const char*& b, int& nt) const { const int k0 = u.kq < 0 ? 0 : 6 * u.kq;
        a = (const char*)(ACTS + (size_t)u.x0 * DFF) + 128 * k0; b = (const char*)(W + ((size_t)u.x2 * D + (size_t)u.pn * 256) * DFF) + 128 * k0; nt = u.kq < 0 ? DFF / 128 : (u.kq == 3 ? 4 : 6); }
    __device__ __forceinline__ void gather(int, const int (&)[2], const int (&)[2], unsigned (&)[2][2]) const {}
};

using pg8::u32x4; using pg8::Unit; using pg8::cvt_pk_bf16;
#define ACC_T const pg8::f32x4 (&acc)[2][2][4][2]

struct EpiSplitBf16 {
    static constexpr bool PERM = true, AFTER_DRAIN = false;
    bf16* O; float scale0;
    __device__ __forceinline__ void operator()(ACC_T, const Unit& u, int wr, int wc, int fr, int fq) const {
        const int t = u.pn >> 1; bf16* base = O + (size_t)t * M * 512; const float sc = (t == 0) ? scale0 : 1.f;
        const int row0 = u.pm * 256 + wr * 64 + fr, col0 = (u.pn & 1) * 256 + wc * 32 + 8 * fq;
#pragma unroll
        for (int ai = 0; ai < 2; ++ai)
#pragma unroll
            for (int m = 0; m < 4; ++m) { bf16* rowp = base + (size_t)(row0 + ai * 128 + m * 16) * 512 + col0;
#pragma unroll
                for (int bj = 0; bj < 2; ++bj) { const f32x4 v0 = acc[ai][bj][m][0] * sc, v1 = acc[ai][bj][m][1] * sc;
                    u32x4 w; w.x = cvt_pk_bf16(v0[0], v0[1]); w.y = cvt_pk_bf16(v0[2], v0[3]); w.z = cvt_pk_bf16(v1[0], v1[1]); w.w = cvt_pk_bf16(v1[2], v1[3]);
                    *(u32x4*)(rowp + bj * 128) = w; } }
    }
};
__device__ __forceinline__ f32x4 bf16x4_lo(u32x4 w) { return (f32x4){__uint_as_float(w.x << 16), __uint_as_float(w.x & 0xffff0000u), __uint_as_float(w.y << 16), __uint_as_float(w.y & 0xffff0000u)}; }
__device__ __forceinline__ f32x4 bf16x4_hi(u32x4 w) { return (f32x4){__uint_as_float(w.z << 16), __uint_as_float(w.z & 0xffff0000u), __uint_as_float(w.w << 16), __uint_as_float(w.w & 0xffff0000u)}; }
template <bool BASE_F32> struct EpiResid {
    static constexpr bool PERM = true, AFTER_DRAIN = true;
    const void* base; bf16* outb; float* ssq;
    __device__ __forceinline__ void fused(pg8::f32x4 (&acc)[2][2][4][2], const Unit& u, int wr, int wc, int fr, int fq, LAS unsigned char* lds, int wid, int lane) const {
        LAS float* Pq = (LAS float*)lds;
        const int col0 = u.pn * 256 + wc * 32 + 8 * fq;
#pragma unroll
        for (int ai = 0; ai < 2; ++ai)
#pragma unroll
            for (int m = 0; m < 4; ++m) { const int rl = ai * 128 + wr * 64 + m * 16 + fr; const size_t off = (size_t)(u.pm * 256 + rl) * D + col0; float s = 0.f;
#pragma unroll
                for (int bj = 0; bj < 2; ++bj) { f32x4 b0, b1;
                    if constexpr (BASE_F32) { const float* bp = (const float*)base + off + bj * 128; b0 = __builtin_nontemporal_load((const f32x4*)bp); b1 = __builtin_nontemporal_load((const f32x4*)(bp + 4)); }
                    else { const u32x4 bw = *(const u32x4*)((const bf16*)base + off + bj * 128); b0 = bf16x4_lo(bw); b1 = bf16x4_hi(bw); }
                    const f32x4 o0 = b0 + acc[ai][bj][m][0], o1 = b1 + acc[ai][bj][m][1];
                    u32x4 w; w.x = cvt_pk_bf16(o0[0], o0[1]); w.y = cvt_pk_bf16(o0[2], o0[3]); w.z = cvt_pk_bf16(o1[0], o1[1]); w.w = cvt_pk_bf16(o1[2], o1[3]);
                    *(u32x4*)(outb + off + bj * 128) = w;
                    s += ((o0[0] * o0[0] + o0[1] * o0[1]) + (o0[2] * o0[2] + o0[3] * o0[3])) + ((o1[0] * o1[0] + o1[1] * o1[1]) + (o1[2] * o1[2] + o1[3] * o1[3])); }
                s += __shfl_xor(s, 16); s += __shfl_xor(s, 32);
                if (fq == 0) Pq[rl * 4 + wc] = s;
                if (BASE_F32 && m == 3) asm volatile("" ::: "memory"); }
        asm volatile("s_waitcnt lgkmcnt(0)" ::: "memory"); __builtin_amdgcn_s_barrier(); asm volatile("" ::: "memory");
        const int tid = wid * 64 + lane;
        if (tid < 256) { const f32x4 p = *(const LAS f32x4*)(Pq + tid * 4); ssq[(size_t)(u.pm * 256 + tid) * 4 + u.pn] = (p[0] + p[1]) + (p[2] + p[3]); }
    }
};
constexpr int RS_OFF = RING_BYTES + 512, RS_SLOTS = 6;
static_assert(RS_OFF + RS_SLOTS * 256 * 4 <= LDS_BYTES, "rs table");
template <class Sched> __device__ __forceinline__ void fill_rs(LAS float* RSL, const float* ssq, const Sched& S, int tid) {
    for (int i0 = 0; i0 < RS_SLOTS; i0 += 2) { const int i = i0 + (tid >> 8); int pm, pn;
        if (S.tile(i, pm, pn)) { const f32x4 q = *(const f32x4*)(ssq + (size_t)(pm * 256 + (tid & 255)) * 4); RSL[i * 256 + (tid & 255)] = __builtin_amdgcn_rsqf(((q[0] + q[1]) + (q[2] + q[3])) * (1.0f / D) + EPS); } }
    __syncthreads();
}
constexpr int UT_OFF = RS_OFF + RS_SLOTS * 256 * 4, UT_MAX = 16;
static_assert(UT_OFF + UT_MAX * 32 <= LDS_BYTES, "unit table");
struct TableOrder {
    const LAS int* T;
    __device__ __forceinline__ bool next(int i, pg8::Unit& u) const {
        if (i >= UT_MAX) return false; const LAS int* t = T + i * 8;
        if (__builtin_amdgcn_readfirstlane(t[5]) == 0) return false;
        u.pm = __builtin_amdgcn_readfirstlane(t[0]); u.pn = __builtin_amdgcn_readfirstlane(t[1]); u.x0 = __builtin_amdgcn_readfirstlane(t[2]); u.x1 = __builtin_amdgcn_readfirstlane(t[3]); u.x2 = __builtin_amdgcn_readfirstlane(t[4]); u.kq = __builtin_amdgcn_readfirstlane(t[6]); return true;
    }
};
constexpr int TOKL_OFF = UT_OFF + UT_MAX * 32;
static_assert(TOKL_OFF + UT_MAX * 256 * 2 <= LDS_BYTES, "token table");
__device__ __forceinline__ void fill_tokl(LAS unsigned char* lds, const unsigned* toks, int tid) {
    const LAS int* T = (const LAS int*)(lds + UT_OFF); LAS unsigned short* TL = (LAS unsigned short*)(lds + TOKL_OFF);
    const int i = tid >> 5, r0 = tid & 31;
    if (T[i * 8 + 5]) { const int x0 = T[i * 8 + 2]; unsigned v[8];
#pragma unroll
        for (int k = 0; k < 8; ++k) v[k] = toks[x0 + r0 + 32 * k];
#pragma unroll
        for (int k = 0; k < 8; ++k) TL[i * 256 + r0 + 32 * k] = (unsigned short)v[k]; }
    __syncthreads();
}
template <class Sched> __device__ __forceinline__ TableOrder build_units(LAS unsigned char* lds, const Sched& S, int tid) {
    LAS int* T = (LAS int*)(lds + UT_OFF);
    if (tid < UT_MAX) { pg8::Unit u; const bool ok = S.next(tid, u); T[tid * 8 + 0] = u.pm; T[tid * 8 + 1] = u.pn; T[tid * 8 + 2] = u.x0; T[tid * 8 + 3] = u.x1; T[tid * 8 + 4] = u.x2; T[tid * 8 + 5] = ok ? 1 : 0; T[tid * 8 + 6] = u.kq; }
    __syncthreads();
    return TableOrder{T};
}
__device__ __forceinline__ pg8::f32x2 swiglu_pk(pg8::f32x2 a, pg8::f32x2 b, float c1, float c2) {
    pg8::f32x2 t = a * c1; t.x = __builtin_amdgcn_exp2f(t.x); t.y = __builtin_amdgcn_exp2f(t.y);
    const pg8::f32x2 d = t + 1.0f; pg8::f32x2 r; r.x = __builtin_amdgcn_rcpf(d.x); r.y = __builtin_amdgcn_rcpf(d.y);
    return (a * b) * (r * c2);
}
struct EpiSwiglu {
    static constexpr bool PERM = true, AFTER_DRAIN = false;
    bf16* O; const LAS float* RSL;
    __device__ __forceinline__ void operator()(ACC_T, const Unit& u, int wr, int wc, int fr, int fq) const {
        const int col0 = u.pn * 128 + wc * 32 + 8 * fq;
#pragma unroll
        for (int ai = 0; ai < 2; ++ai)
#pragma unroll
            for (int m = 0; m < 4; ++m) { const int rl = ai * 128 + wr * 64 + m * 16 + fr, row = u.pm * 256 + rl; const float rs = RSL[u.x1 * 256 + rl];
                const f32x4 a0 = acc[ai][0][m][0], a1 = acc[ai][0][m][1], b0 = acc[ai][1][m][0], b1 = acc[ai][1][m][1]; const float c1 = -LOG2E * rs, c2 = rs * rs;
                const pg8::f32x2 v0 = swiglu_pk((pg8::f32x2){a0[0], a0[1]}, (pg8::f32x2){b0[0], b0[1]}, c1, c2), v1 = swiglu_pk((pg8::f32x2){a0[2], a0[3]}, (pg8::f32x2){b0[2], b0[3]}, c1, c2);
                const pg8::f32x2 v2 = swiglu_pk((pg8::f32x2){a1[0], a1[1]}, (pg8::f32x2){b1[0], b1[1]}, c1, c2), v3 = swiglu_pk((pg8::f32x2){a1[2], a1[3]}, (pg8::f32x2){b1[2], b1[3]}, c1, c2);
                u32x4 w; w.x = cvt_pk_bf16(v0.x, v0.y); w.y = cvt_pk_bf16(v1.x, v1.y); w.z = cvt_pk_bf16(v2.x, v2.y); w.w = cvt_pk_bf16(v3.x, v3.y);
                *(u32x4*)(O + (size_t)row * DFF + col0) = w; }
    }
};
struct EpiSsmU {
    static constexpr bool PERM = true, AFTER_DRAIN = false;
    bf16* AG; const LAS float* RSL;
    __device__ __forceinline__ void operator()(ACC_T, const Unit& u, int wr, int wc, int fr, int fq) const {
#pragma unroll
        for (int ai = 0; ai < 2; ++ai)
#pragma unroll
            for (int m = 0; m < 4; ++m) { const int rl = ai * 128 + wr * 64 + m * 16 + fr, row = u.pm * 256 + rl; const float rs = RSL[u.x1 * 256 + rl]; const int bc = row >> 5, l = row & 31;
#pragma unroll
                for (int bj = 0; bj < 2; ++bj) { const int c0 = u.pn * 256 + bj * 128 + wc * 32 + 8 * fq, g = c0 >> 4, h0 = c0 & 15; const f32x4 v0 = acc[ai][bj][m][0] * rs, v1 = acc[ai][bj][m][1] * rs;
                    u32x4 w; w.x = cvt_pk_bf16(v0[0], v0[1]); w.y = cvt_pk_bf16(v0[2], v0[3]); w.z = cvt_pk_bf16(v1[0], v1[1]); w.w = cvt_pk_bf16(v1[2], v1[3]);
                    *(u32x4*)(AG + ((size_t)g * NBC + bc) * KA + 2 * SP + l * SGH + h0) = w; } }
    }
};
struct EpiGelu {
    static constexpr bool PERM = true, AFTER_DRAIN = false;
    bf16* GB;
    __device__ __forceinline__ void operator()(ACC_T, const Unit& u, int wr, int wc, int fr, int fq) const {
#pragma unroll
        for (int ai = 0; ai < 2; ++ai)
#pragma unroll
            for (int m = 0; m < 4; ++m) { const int bc = u.pm * 256 + ai * 128 + wr * 64 + m * 16 + fr;
#pragma unroll
                for (int bj = 0; bj < 2; ++bj) { const int n0 = u.pn * 256 + bj * 128 + wc * 32 + 8 * fq, l = n0 >> 4, h0 = n0 & 15; const f32x4 v0 = acc[ai][bj][m][0], v1 = acc[ai][bj][m][1];
                    u32x4 w; w.x = cvt_pk_bf16(pg8::gelu_tanh(v0[0]), pg8::gelu_tanh(v0[1])); w.y = cvt_pk_bf16(pg8::gelu_tanh(v0[2]), pg8::gelu_tanh(v0[3]));
                    w.z = cvt_pk_bf16(pg8::gelu_tanh(v1[0]), pg8::gelu_tanh(v1[1])); w.w = cvt_pk_bf16(pg8::gelu_tanh(v1[2]), pg8::gelu_tanh(v1[3]));
                    *(u32x4*)(GB + ((size_t)bc * CL + l) * D + u.x2 * SGH + h0) = w; } }
    }
};
struct EpiGlu {
    static constexpr bool PERM = true, AFTER_DRAIN = false;
    bf16* X;
    __device__ __forceinline__ void operator()(ACC_T, const Unit& u, int wr, int wc, int fr, int fq) const {
        const int col0 = u.pn * 128 + wc * 32 + 8 * fq;
#pragma unroll
        for (int ai = 0; ai < 2; ++ai)
#pragma unroll
            for (int m = 0; m < 4; ++m) { bf16* pp = X + (size_t)(u.pm * 256 + ai * 128 + wr * 64 + m * 16 + fr) * D + col0; const u32x4 xw = *(const u32x4*)pp;
                f32x4 o0 = bf16x4_lo(xw), o1 = bf16x4_hi(xw); const f32x4 a0 = acc[ai][0][m][0], a1 = acc[ai][0][m][1], b0 = acc[ai][1][m][0], b1 = acc[ai][1][m][1];
#pragma unroll
                for (int i = 0; i < 4; ++i) { o0[i] += a0[i] * pg8::fast_sigmoid(b0[i]); o1[i] += a1[i] * pg8::fast_sigmoid(b1[i]); }
                u32x4 w; w.x = cvt_pk_bf16(o0[0], o0[1]); w.y = cvt_pk_bf16(o0[2], o0[3]); w.z = cvt_pk_bf16(o1[0], o1[1]); w.w = cvt_pk_bf16(o1[2], o1[3]);
                *(u32x4*)pp = w; }
    }
};
struct EpiSwigluF8 {
    static constexpr bool PERM = true, AFTER_DRAIN = false;
    unsigned char* O;
    __device__ __forceinline__ void operator()(ACC_T, const Unit& u, int wr, int wc, int fr, int fq) const {
        const int col0 = u.pn * 128 + wc * 32 + 8 * fq;
#pragma unroll
        for (int ai = 0; ai < 2; ++ai)
#pragma unroll
            for (int m = 0; m < 4; ++m) { const int row = u.x0 + ai * 128 + wr * 64 + m * 16 + fr;
                const f32x4 a0 = acc[ai][0][m][0], a1 = acc[ai][0][m][1], b0 = acc[ai][1][m][0], b1 = acc[ai][1][m][1]; constexpr float c1 = -LOG2E * W8_INV, c2 = W8_INV * W8_INV;
                const pg8::f32x2 v0 = swiglu_pk((pg8::f32x2){a0[0], a0[1]}, (pg8::f32x2){b0[0], b0[1]}, c1, c2), v1 = swiglu_pk((pg8::f32x2){a0[2], a0[3]}, (pg8::f32x2){b0[2], b0[3]}, c1, c2);
                const pg8::f32x2 v2 = swiglu_pk((pg8::f32x2){a1[0], a1[1]}, (pg8::f32x2){b1[0], b1[1]}, c1, c2), v3 = swiglu_pk((pg8::f32x2){a1[2], a1[3]}, (pg8::f32x2){b1[2], b1[3]}, c1, c2);
                pg8::u32x2 w; w.x = pk4_fp8(v0.x, v0.y, v1.x, v1.y); w.y = pk4_fp8(v2.x, v2.y, v3.x, v3.y);
                if (row < u.x1) *(pg8::u32x2*)(O + (size_t)row * DFF + col0) = w; }
    }
};
struct EpiMaskF8 {
    static constexpr bool PERM = true, AFTER_DRAIN = false;
    unsigned char* Y; unsigned char* YP; int rowL;
    __device__ __forceinline__ void operator()(ACC_T, const Unit& u, int wr, int wc, int fr, int fq) const {
#pragma unroll
        for (int ai = 0; ai < 2; ++ai)
#pragma unroll
            for (int m = 0; m < 4; ++m) { const int row = u.x0 + ai * 128 + wr * 64 + m * 16 + fr;
                unsigned char* dst = (u.kq <= 0) ? Y + (size_t)row * D : YP + ((size_t)(u.kq - 1) * YP_ROWS + (size_t)(row - rowL)) * D;
#pragma unroll
                for (int bj = 0; bj < 2; ++bj) { const f32x4 v0 = acc[ai][bj][m][0] * W8_INV, v1 = acc[ai][bj][m][1] * W8_INV;
                    pg8::u32x2 w; w.x = pk4_fp8(v0[0], v0[1], v0[2], v0[3]); w.y = pk4_fp8(v1[0], v1[1], v1[2], v1[3]);
                    if (row < u.x1) *(pg8::u32x2*)(dst + u.pn * 256 + bj * 128 + wc * 32 + 8 * fq) = w; } }
    }
};

struct Frame {
    LAS unsigned char* lds; volatile LAS unsigned* MISC; gu32* ctl;
    int tid, lane, wave, vcu, G;
    const float* const __attribute__((address_space(4)))* in;
    float* out; unsigned char* ws;
};
#define WSP(T, off) ((T*)(F.ws + (off)))

__device__ __forceinline__ void tr_job(const float* W, int ldw, int ncb, int cbase, const float* gain, bf16* WT, int ldt, int mode, int rowoff, int item, LAS unsigned char* scr, int lane) {
    const int kb = item / ncb, nb = item % ncb, n0 = 64 * nb;
    const int drow0 = (mode == 0) ? rowoff + n0 : (n0 >> 7) * 256 + (n0 & 127) + rowoff;
    transpose_item(W, ldw, 64 * kb, cbase + n0, gain, WT, ldt, drow0, scr, lane);
}

__device__ __forceinline__ void tr_job_f8(const float* W, int ldw, int ncb, unsigned char* WT, int ldt, int mode, int rowoff, int item, LAS unsigned char* scr, int lane) {
    const int kb = item / ncb, nb = item % ncb, n0 = 64 * nb;
    const int drow0 = (mode == 0) ? rowoff + n0 : (n0 >> 7) * 256 + (n0 & 127) + rowoff;
    transpose_item_f8(W, ldw, 128 * kb, n0, W8_SCALE, WT, ldt, drow0, scr, lane);
}

__device__ __forceinline__ void ssm_prep_job(Frame& F, int g, int q, bool fresh = true) {
    LAS float* PWR = (LAS float*)(F.lds + RING_OFF);
    LAS float* PWI = PWR + 33 * 64;
    LAS float* BBR = PWI + 33 * 64;
    LAS float* BBI = BBR + 1024;
    LAS float* CR = BBI + 1024;
    LAS float* CI = CR + 1024;
    LAS float* KT = CI + 1024;
    LAS float* COEF = KT + 2048;
    const int tid = F.tid;
    const float* are = F.in[I_ARE]; const float* aim = F.in[I_AIM]; const float* logdt = F.in[I_LOGDT];
    if (fresh) {
    float pbr[2], pbi[2], pcr[2], pci[2];
#pragma unroll
    for (int it = 0; it < 2; ++it) { const int i = tid + 512 * it; pbr[it] = F.in[I_BRE][g * 1024 + i]; pbi[it] = F.in[I_BIM][g * 1024 + i]; pcr[it] = F.in[I_CRE][g * 1024 + i]; pci[it] = F.in[I_CIM][g * 1024 + i]; }
    if (tid < 64) {
        const int p = tid; const float dt = expf(logdt[g]); const float ar = are[g * SP + p], ai = aim[g * SP + p];
        const float mag = expf(ar * dt), th = ai * dt; const float abr = mag * cosf(th), abi = mag * sinf(th);
        const float sh = sinf(0.5f * th); const float nr = expm1f(ar * dt) - 2.0f * mag * sh * sh, ni = abi;
        const float den = ar * ar + ai * ai;
        COEF[2 * p] = (nr * ar + ni * ai) / den; COEF[2 * p + 1] = (ni * ar - nr * ai) / den;
        float pr = 1.0f, pi = 0.0f;
        for (int t = 0; t <= CL; ++t) { PWR[t * 64 + p] = pr; PWI[t * 64 + p] = pi; const float nr2 = pr * abr - pi * abi, ni2 = pr * abi + pi * abr; pr = nr2; pi = ni2; }
        if (q == 0) { float* AL = WSP(float, WS_AL); AL[(g * SP + p) * 2] = PWR[CL * 64 + p]; AL[(g * SP + p) * 2 + 1] = PWI[CL * 64 + p]; }
    }
    __syncthreads();
#pragma unroll
    for (int it = 0; it < 2; ++it) { const int i = tid + 512 * it, p = i >> 4; const float cr = COEF[2 * p], ci = COEF[2 * p + 1];
        BBR[i] = cr * pbr[it] - ci * pbi[it]; BBI[i] = cr * pbi[it] + ci * pbr[it]; CR[i] = pcr[it]; CI[i] = pci[it]; }
    __syncthreads();
    }
    { const int tl = tid >> 6, h = (tid >> 2) & 15, pq = tid & 3, tau = 8 * q + tl; float a[16];
#pragma unroll
        for (int i = 0; i < 16; ++i) a[i] = 0.f;
#pragma unroll 4
        for (int pp = 0; pp < 16; ++pp) { const int p = 16 * pq + pp; const float cr = CR[h * 64 + p], ci = CI[h * 64 + p], pr = PWR[tau * 64 + p], pi = PWI[tau * 64 + p];
            const float zr = cr * pr - ci * pi, zi = cr * pi + ci * pr;
#pragma unroll
            for (int i4 = 0; i4 < 4; ++i4) { const f32x4 br = *(const LAS f32x4*)(BBR + p * 16 + 4 * i4), bi = *(const LAS f32x4*)(BBI + p * 16 + 4 * i4);
                a[4 * i4] += zr * br.x - zi * bi.x; a[4 * i4 + 1] += zr * br.y - zi * bi.y; a[4 * i4 + 2] += zr * br.z - zi * bi.z; a[4 * i4 + 3] += zr * br.w - zi * bi.w; } }
#pragma unroll
        for (int i = 0; i < 16; ++i) { a[i] += __shfl_xor(a[i], 1); a[i] += __shfl_xor(a[i], 2); }
        f32x4 o;
        o.x = pq == 0 ? a[0] : pq == 1 ? a[4] : pq == 2 ? a[8] : a[12]; o.y = pq == 0 ? a[1] : pq == 1 ? a[5] : pq == 2 ? a[9] : a[13];
        o.z = pq == 0 ? a[2] : pq == 1 ? a[6] : pq == 2 ? a[10] : a[14]; o.w = pq == 0 ? a[3] : pq == 1 ? a[7] : pq == 2 ? a[11] : a[15];
        if (tau == 0 && (h >> 2) == pq) { const float dv = F.in[I_SD][g * SGH + h]; if ((h & 3) == 0) o.x += dv; else if ((h & 3) == 1) o.y += dv; else if ((h & 3) == 2) o.z += dv; else o.w += dv; }
        *(LAS f32x4*)(KT + tl * 256 + h * 16 + 4 * pq) = o; }
    __syncthreads();
    bf16* BT = WSP(bf16, WS_BT2) + (size_t)g * 512 * KA; bf16* MG = WSP(bf16, WS_MG) + (size_t)g * 128 * 512;
    for (int it = tid; it < 8192; it += 512) { const int half = it & 1, h = (it >> 1) & 15, tl = (it >> 5) & 7, l = it >> 8, l2 = l - (8 * q + tl);
        if (l2 >= 0) { const LAS float* s = KT + tl * 256 + h * 16 + 8 * half; v4u o; o.x = pk2(s[0], s[1]); o.y = pk2(s[2], s[3]); o.z = pk2(s[4], s[5]); o.w = pk2(s[6], s[7]);
            *(GAS v4u*)(BT + (size_t)(16 * l + h) * KA + 128 + 16 * l2 + 8 * half) = o; } }
    for (int it = tid; it < 16384; it += 512) { const int half = it & 1, h = (it >> 1) & 15, dl = (it >> 5) & 15, l = it >> 9, l2 = l + dl;
        if (dl >= 1 && (dl & 3) == q && l2 <= 16 * (l >> 4) + 15) *(GAS v4u*)(BT + (size_t)(16 * l + h) * KA + 128 + 16 * l2 + 8 * half) = (v4u){0u, 0u, 0u, 0u}; }
    for (int it = tid; it < 2048; it += 512) { const int pc = it & 7, part = (it >> 3) & 1, h = (it >> 4) & 15, l = 8 * q + (it >> 8); float v[8];
#pragma unroll
        for (int j = 0; j < 8; ++j) { const int p = 8 * pc + j; const float cr = CR[h * 64 + p], ci = CI[h * 64 + p], pr = PWR[(l + 1) * 64 + p], pi = PWI[(l + 1) * 64 + p];
            v[j] = part == 0 ? (cr * pr - ci * pi) : -(cr * pi + ci * pr); }
        v4u o; o.x = pk2(v[0], v[1]); o.y = pk2(v[2], v[3]); o.z = pk2(v[4], v[5]); o.w = pk2(v[6], v[7]);
        *(GAS v4u*)(BT + (size_t)(16 * l + h) * KA + 64 * part + 8 * pc) = o; }
    for (int it = tid; it < 2048; it += 512) { const int half = it & 1, ll = (it >> 1) & 7, p = (it >> 4) & 63, part = it >> 10, l2 = 8 * q + ll; float v[8];
        const float pr = PWR[(CL - 1 - l2) * 64 + p], pi = PWI[(CL - 1 - l2) * 64 + p];
#pragma unroll
        for (int j = 0; j < 8; ++j) { const float br = BBR[p * 16 + 8 * half + j], bi = BBI[p * 16 + 8 * half + j]; v[j] = part == 0 ? (pr * br - pi * bi) : (pr * bi + pi * br); }
        v4u o; o.x = pk2(v[0], v[1]); o.y = pk2(v[2], v[3]); o.z = pk2(v[4], v[5]); o.w = pk2(v[6], v[7]);
        *(GAS v4u*)(MG + (size_t)(part * 64 + p) * 512 + 16 * l2 + 8 * half) = o; }
    __syncthreads();
}


__device__ __forceinline__ float reduce8(const float (&d)[8], int lane) {
    const bool b5 = lane & 32, b4 = lane & 16, b3 = lane & 8; float a[4], b[2];
#pragma unroll
    for (int i = 0; i < 4; ++i) { const float keep = b5 ? d[4 + i] : d[i], send = b5 ? d[i] : d[4 + i]; a[i] = keep + __shfl_xor(send, 32); }
#pragma unroll
    for (int i = 0; i < 2; ++i) { const float keep = b4 ? a[2 + i] : a[i], send = b4 ? a[i] : a[2 + i]; b[i] = keep + __shfl_xor(send, 16); }
    float c = (b3 ? b[1] : b[0]) + __shfl_xor(b3 ? b[0] : b[1], 8);
    c += __shfl_xor(c, 4); c += __shfl_xor(c, 2); c += __shfl_xor(c, 1);
    return c;
}
__device__ __forceinline__ void fill_w8(LAS float* WL, const float* W, int ldw, const float* gain, int tid) {
#pragma unroll
    for (int it = 0; it < 16; ++it) { const int idx = tid + 512 * it, k = idx >> 3, e = idx & 7; const float v = W[(size_t)k * ldw + e] * gain[k];
        WL[((((k >> 8) * 4 + (k & 3)) * 64 + ((k >> 2) & 63)) << 3) + e] = v; }
}
__device__ __forceinline__ void row_dots(const f32x4 (&v)[4], const LAS float* WL, int lane, float& rs, float& red) {
    float s = 0.f, dot[8];
#pragma unroll
    for (int e = 0; e < 8; ++e) dot[e] = 0.f;
#pragma unroll
    for (int j = 0; j < 4; ++j) { s += (v[j].x * v[j].x + v[j].y * v[j].y) + (v[j].z * v[j].z + v[j].w * v[j].w);
#pragma unroll
        for (int i = 0; i < 4; ++i) { const LAS f32x4* wp = (const LAS f32x4*)(WL + (((j * 4 + i) * 64 + lane) << 3)); const f32x4 w0 = wp[0], w1 = wp[1]; const float xv = v[j][i];
            dot[0] += xv * w0.x; dot[1] += xv * w0.y; dot[2] += xv * w0.z; dot[3] += xv * w0.w; dot[4] += xv * w1.x; dot[5] += xv * w1.y; dot[6] += xv * w1.z; dot[7] += xv * w1.w; } }
    rs = 1.0f / sqrtf(wave_sum(s) * (1.0f / D) + EPS);
    red = reduce8(dot, lane) * rs;
}

__device__ __forceinline__ void p0_prologue(Frame& F) {
    const int gw = F.vcu * NWAVES + F.wave, NGW = F.G * NWAVES;
#ifndef P0_REP_SSM
#define P0_REP_SSM 1
#define P0_REP_TR 1
#define P0_REP_FOLD 1
#define P0_REP_ROWS 1
#endif
#ifndef SSM_IN_P4
#define SSM_IN_P4 1
#endif
    if (!SSM_IN_P4 && (F.vcu & 1) == 0) {
    for (int rep = 0; rep < P0_REP_SSM; ++rep)
    for (int job = F.vcu; job < 4 * SG; job += F.G) ssm_prep_job(F, job >> 2, job & 3);
    }
    {
    LAS float* WFG = (LAS float*)(F.lds + RING_OFF + 98304);
    fill_w8(WFG, F.in[I_WIN0] + 3 * FW, INW, F.in[I_N0], F.tid);
    __syncthreads();
    LAS unsigned char* scr = F.lds + RING_OFF + F.wave * 8704;
    {
        constexpr int J1 = 16 * 24, J2 = 16 * 8, J3 = 8 * 16, J4 = 16 * 44, J5 = J4, J6 = 44 * 16, J7 = 16 * 16, J8 = J7, J9 = J7, NJ = J1 + J2 + J3 + J4 + J5 + J6 + J7 + J8 + J9;
        for (int rep = 0; rep < P0_REP_TR; ++rep)
        for (int it = gw; it < NJ; it += NGW) {
            int r = it;
            if (r < J1) { tr_job(F.in[I_WIN0], INW, 24, 0, nullptr, WSP(bf16, WS_WIN0), D, 0, 0, r, scr, F.lane); continue; } r -= J1;
            if (r < J2) { tr_job(F.in[I_WIN0], INW, 8, 3 * FW + NH, nullptr, WSP(bf16, WS_WIN0), D, 0, 3 * FW, r, scr, F.lane); continue; } r -= J2;
            if (r < J3) { tr_job(F.in[I_WOUT], D, 16, 0, nullptr, WSP(bf16, WS_WOT), D, 0, 0, r, scr, F.lane); continue; } r -= J3;
            if (r < J4) { tr_job(F.in[I_W1], DFF, 44, 0, F.in[I_N1], WSP(bf16, WS_W13), D, 1, 0, r, scr, F.lane); continue; } r -= J4;
            if (r < J5) { tr_job(F.in[I_W3], DFF, 44, 0, F.in[I_N1], WSP(bf16, WS_W13), D, 1, 128, r, scr, F.lane); continue; } r -= J5;
            if (r < J6) { tr_job(F.in[I_W2], D, 16, 0, nullptr, WSP(bf16, WS_W2T), DFF, 0, 0, r, scr, F.lane); continue; } r -= J6;
            if (r < J7) { tr_job(F.in[I_WIN1], D, 16, 0, F.in[I_N2], WSP(bf16, WS_WIN1), D, 0, 0, r, scr, F.lane); continue; } r -= J7;
            if (r < J8) { tr_job(F.in[I_GA], D, 16, 0, nullptr, WSP(bf16, WS_WGLU), D, 1, 0, r, scr, F.lane); continue; } r -= J8;
            tr_job(F.in[I_GB], D, 16, 0, nullptr, WSP(bf16, WS_WGLU), D, 1, 128, r, scr, F.lane);
        }
    }
    for (int rep = 0; rep < P0_REP_FOLD; ++rep)
    for (int it = gw; it < 16 * 64; it += NGW) {
        const int n = 64 * (it & 15) + F.lane, kk0 = 8 * (it >> 4), g = kk0 >> 7, kl0 = kk0 & 127;
        const float* wp = F.in[I_WPOOL] + ((size_t)g * 128 + kl0) * 128; const float* ps = F.in[I_PSCALE] + g * 128; const float* wo = F.in[I_WOUT] + (size_t)(FW + g * 128) * D + n;
        float a[8];
#pragma unroll
        for (int i = 0; i < 8; ++i) a[i] = 0.f;
#pragma unroll 16
        for (int j = 0; j < 128; ++j) { const float w = wo[(size_t)j * D] * ps[j];
#pragma unroll
            for (int i = 0; i < 8; ++i) a[i] += wp[i * 128 + j] * w; }
        v4u o; o.x = pk2(a[0], a[1]); o.y = pk2(a[2], a[3]); o.z = pk2(a[4], a[5]); o.w = pk2(a[6], a[7]);
        *(GAS v4u*)(WSP(bf16, WS_WOT) + (size_t)n * D + FW + kk0) = o;
    }
    for (int rep = 0; rep < P0_REP_ROWS; ++rep)
    {
        f32x4 nx[4];
        if (gw < M) { const GAS f32x4* xr = (const GAS f32x4*)(F.in[I_X] + (size_t)gw * D) + F.lane;
#pragma unroll
            for (int j = 0; j < 4; ++j) nx[j] = __builtin_nontemporal_load(xr + 64 * j); }
        for (int m = gw; m < M; m += NGW) {
            f32x4 v[4];
#pragma unroll
            for (int j = 0; j < 4; ++j) v[j] = nx[j];
            if (m + NGW < M) { const GAS f32x4* xr = (const GAS f32x4*)(F.in[I_X] + (size_t)(m + NGW) * D) + F.lane;
#pragma unroll
                for (int j = 0; j < 4; ++j) nx[j] = __builtin_nontemporal_load(xr + 64 * j); }
            float rs, red; row_dots(v, WFG, F.lane, rs, red);
            GAS unsigned long long* o8 = (GAS unsigned long long*)(WSP(bf16, WS_H0) + (size_t)m * D) + F.lane;
#pragma unroll
            for (int j = 0; j < 4; ++j) { const f32x4 g = *(const GAS f32x4*)(F.in[I_N0] + 4 * F.lane + 256 * j);
                o8[64 * j] = (unsigned long long)pk2(v[j].x * rs * g.x, v[j].y * rs * g.y) | ((unsigned long long)pk2(v[j].z * rs * g.z, v[j].w * rs * g.w) << 32); }
            if ((F.lane & 7) == 0) { const int e = F.lane >> 3; const float a = red + F.in[I_BF][e]; WSP(float, WS_LOGF)[(size_t)m * 8 + e] = fminf(a, 0.f) - log1pf(expf(-fabsf(a))); }
        }
    }
    __syncthreads();
    }
    if (!SSM_IN_P4 && (F.vcu & 1) != 0) { for (int job = F.vcu; job < 4 * SG; job += F.G) ssm_prep_job(F, job >> 2, job & 3); }
}

__device__ __forceinline__ void forget_cumsum(Frame& F, int b, int h) {
    const float* lf = WSP(float, WS_LOGF) + ((size_t)b * SEQ + 32 * F.lane) * 8 + h; float v[32]; float s = 0.f;
#pragma unroll
    for (int i = 0; i < 32; ++i) { s += lf[i * 8]; v[i] = s; }
    float incl = s;
#pragma unroll
    for (int o = 1; o < 64; o <<= 1) { const float t = __shfl_up(incl, o); if (F.lane >= o) incl += t; }
    const float excl = incl - s; float* fo = WSP(float, WS_FNEG) + ((size_t)b * NH + h) * SEQ + 32 * F.lane;
#pragma unroll
    for (int i = 0; i < 32; i += 4) *(f32x4*)(fo + i) = (f32x4){-(excl + v[i]) * LOG2E, -(excl + v[i + 1]) * LOG2E, -(excl + v[i + 2]) * LOG2E, -(excl + v[i + 3]) * LOG2E};
}

__device__ __forceinline__ void pool_rows(Frame& F, int row0) {
    const unsigned* Pp = (const unsigned*)(WSP(bf16, WS_QKVP) + (size_t)3 * M * 512); unsigned* mix = (unsigned*)WSP(bf16, WS_H0);
    const int cp = F.tid & 255, half = F.tid >> 8, w = 2 << (cp >> 6), t0 = row0 + 32 * half, bs = t0 & ~(SEQ - 1);
    unsigned u[48];
#pragma unroll
    for (int i = 0; i < 48; ++i) { const int t = t0 - 16 + i; u[i] = (t >= bs) ? Pp[(size_t)t * 256 + cp] : 0u; }
    float s0 = 0.f, s1 = 0.f;
#pragma unroll
    for (int i = 0; i < 16; ++i) { if (16 - i <= w) { s0 += __uint_as_float(u[i] << 16); s1 += __uint_as_float(u[i] & 0xffff0000u); } }
#pragma unroll
    for (int i = 0; i < 32; ++i) { const int t = t0 + i; const float p0 = __uint_as_float(u[16 + i] << 16), p1 = __uint_as_float(u[16 + i] & 0xffff0000u);
        const unsigned uo = (w == 2) ? u[14 + i] : (w == 4) ? u[12 + i] : (w == 8) ? u[8 + i] : u[i];
        s0 += p0 - __uint_as_float(uo << 16); s1 += p1 - __uint_as_float(uo & 0xffff0000u);
        const int cnt = (t - bs + 1) < w ? (t - bs + 1) : w; const float ic = 1.0f / (float)cnt;
        mix[(size_t)t * 512 + 256 + cp] = pk2(s0 * ic - p0, s1 * ic - p1); }
}

__device__ __forceinline__ void ssm_state_unit(Frame& F, int g, int bp) {
    typedef short bf16x8v __attribute__((ext_vector_type(8)));
    LAS unsigned char* BL = F.lds + RING_OFF;
    LAS float* SL = (LAS float*)(F.lds + RING_OFF);
    LAS float* TL = SL + 128 * 132;
    bf16* AGg = WSP(bf16, WS_QKVP) + ((size_t)g * NBC + 128 * bp) * KA; const bf16* MGg = WSP(bf16, WS_MG) + (size_t)g * 128 * 512;
    const int r16 = F.lane & 15, quad = F.lane >> 4;
#pragma unroll
    for (int i = 0; i < 16; ++i) { const int n = 16 * F.wave + i, cs = (F.lane & ~7) | ((F.lane ^ n) & 7);
        __builtin_amdgcn_global_load_lds((const unsigned*)(MGg + (size_t)n * 512 + 8 * cs), (LAS unsigned*)(BL + n * 1024), 16, 0, 0); }
    f32x4 acc[8];
#pragma unroll
    for (int nb = 0; nb < 8; ++nb) acc[nb] = (f32x4){0.f, 0.f, 0.f, 0.f};
    const bf16* ap = AGg + (size_t)(16 * F.wave + r16) * KA + 128 + 8 * quad;
    bf16x8v a[8];
#pragma unroll
    for (int ks = 0; ks < 8; ++ks) a[ks] = *(const bf16x8v*)(ap + 32 * ks);
    asm volatile("s_waitcnt vmcnt(0)" ::: "memory"); __syncthreads();
    const int n7 = r16 & 7; const LAS unsigned char* be = BL + r16 * 1024 + 16 * (quad ^ n7); const LAS unsigned char* bo = BL + r16 * 1024 + 16 * ((4 + quad) ^ n7);
#pragma unroll 1
    for (int kh = 0; kh < 2; ++kh) {
#pragma unroll
        for (int ks = 0; ks < 8; ++ks) { const LAS unsigned char* bb = ((ks & 1) ? bo : be) + kh * 512 + (ks >> 1) * 128;
#pragma unroll
            for (int nb = 0; nb < 8; ++nb) { const bf16x8v b = *(const LAS bf16x8v*)(bb + nb * 16384); acc[nb] = __builtin_amdgcn_mfma_f32_16x16x32_bf16(a[ks], b, acc[nb], 0, 0, 0); } }
        if (kh == 0) {
#pragma unroll
            for (int ks = 0; ks < 8; ++ks) a[ks] = *(const bf16x8v*)(ap + 256 + 32 * ks); }
    }
    __syncthreads();
#pragma unroll
    for (int nb = 0; nb < 8; ++nb)
#pragma unroll
        for (int r = 0; r < 4; ++r) SL[(16 * F.wave + 4 * quad + r) * 132 + 16 * nb + r16] = acc[nb][r];
    __syncthreads();
    { const int seg = F.tid >> 7, b2 = (F.tid >> 6) & 1, p = F.tid & 63; const float alr = WSP(float, WS_AL)[(g * SP + p) * 2], ali = WSP(float, WS_AL)[(g * SP + p) * 2 + 1];
      float lr[16], li[16], xr = 0.f, xi = 0.f, pr = 1.f, pi = 0.f;
#pragma unroll
      for (int j = 0; j < 16; ++j) { const int row = b2 * NCH + 16 * seg + j; lr[j] = xr; li[j] = xi;
          const float sr = SL[row * 132 + p], si = SL[row * 132 + SP + p]; const float nr = alr * xr - ali * xi + sr, ni = alr * xi + ali * xr + si; xr = nr; xi = ni;
          const float qr = pr * alr - pi * ali, qi = pr * ali + pi * alr; pr = qr; pi = qi; }
      TL[(seg * 128 + b2 * 64 + p) * 2] = xr; TL[(seg * 128 + b2 * 64 + p) * 2 + 1] = xi;
      __syncthreads();
      float cr = 0.f, ci = 0.f;
      for (int s2 = 0; s2 < seg; ++s2) { const float tr = TL[(s2 * 128 + b2 * 64 + p) * 2], ti = TL[(s2 * 128 + b2 * 64 + p) * 2 + 1]; const float nr = pr * cr - pi * ci + tr, ni = pr * ci + pi * cr + ti; cr = nr; ci = ni; }
      float wr_ = 1.f, wi_ = 0.f;
#pragma unroll
      for (int j = 0; j < 16; ++j) { const int row = b2 * NCH + 16 * seg + j; bf16* o = AGg + (size_t)row * KA + p;
          o[0] = (bf16)f2bf(lr[j] + wr_ * cr - wi_ * ci); o[SP] = (bf16)f2bf(li[j] + wr_ * ci + wi_ * cr);
          const float qr = wr_ * alr - wi_ * ali, qi = wr_ * ali + wi_ * alr; wr_ = qr; wi_ = qi; } }
    __syncthreads();
}

__device__ __forceinline__ void router_rows(Frame& F, const LAS float* WR, LAS unsigned* CN) {
    const int m0 = 64 * F.vcu + 16 * F.wave;
    unsigned long long nxb[4];
    { const GAS unsigned long long* xr = (const GAS unsigned long long*)(WSP(bf16, WS_H0) + (size_t)m0 * D) + F.lane;
#pragma unroll
        for (int j = 0; j < 4; ++j) nxb[j] = xr[64 * j]; }
    for (int r = 0; r < 16; ++r) { const int m = m0 + r;
        f32x4 v[4];
#pragma unroll
        for (int j = 0; j < 4; ++j) { const unsigned lo = (unsigned)nxb[j], hi = (unsigned)(nxb[j] >> 32); v[j] = (f32x4){__uint_as_float(lo << 16), __uint_as_float(lo & 0xffff0000u), __uint_as_float(hi << 16), __uint_as_float(hi & 0xffff0000u)}; }
        if (r + 1 < 16) { const GAS unsigned long long* xr = (const GAS unsigned long long*)(WSP(bf16, WS_H0) + (size_t)(m + 1) * D) + F.lane;
#pragma unroll
            for (int j = 0; j < 4; ++j) nxb[j] = xr[64 * j]; }
        float rs, red; row_dots(v, WR, F.lane, rs, red);
        GAS unsigned* o4 = (GAS unsigned*)(WSP(unsigned char, WS_H3) + (size_t)m * D) + F.lane;
#pragma unroll
        for (int j = 0; j < 4; ++j) { const f32x4 g = *(const GAS f32x4*)(F.in[I_N3] + 4 * F.lane + 256 * j);
            o4[64 * j] = pk4_fp8(v[j].x * rs * g.x, v[j].y * rs * g.y, v[j].z * rs * g.z, v[j].w * rs * g.w); }
        float lg[8];
#pragma unroll
        for (int e = 0; e < 8; ++e) lg[e] = __builtin_bit_cast(float, __builtin_amdgcn_readlane(__builtin_bit_cast(int, red), 8 * e)) + F.in[I_RB][e];
        int e1 = 0; float l1 = lg[0];
#pragma unroll
        for (int e = 1; e < 8; ++e) if (lg[e] > l1) { l1 = lg[e]; e1 = e; }
        int e2 = -1; float l2 = -INFINITY;
#pragma unroll
        for (int e = 0; e < 8; ++e) if (e != e1 && lg[e] > l2) { l2 = lg[e]; e2 = e; }
        if (F.lane == 0) { const float g2 = 1.0f / (1.0f + expf(l1 - l2)); WSP(unsigned, WS_TOKE)[m] = (unsigned)e1 | ((unsigned)e2 << 8);
            WSP(float, WS_GATE)[2 * m] = 1.0f - g2; WSP(float, WS_GATE)[2 * m + 1] = g2; atomicAdd((unsigned*)&CN[e1], 1u); atomicAdd((unsigned*)&CN[e2], 1u); }
    }
}

__device__ __forceinline__ void moe_sort(Frame& F) {
    LAS unsigned* TOT = (LAS unsigned*)(F.lds + RING_OFF);
    LAS unsigned* BASE = TOT + 2048;
    for (int i = F.tid; i < F.G * 8; i += 512) TOT[i] = WSP(unsigned, WS_CNT)[i];
    __syncthreads();
    if (F.tid < 8) { unsigned tot = 0, pre = 0; for (int b = 0; b < F.G; ++b) { if (b == F.vcu) pre = tot; tot += TOT[b * 8 + F.tid]; } BASE[F.tid] = pre; BASE[8 + F.tid] = tot; }
    __syncthreads();
    if (F.tid == 0) { unsigned s = 0, tl = 0; for (int e = 0; e < 8; ++e) { BASE[16 + e] = s; if (F.vcu == 0) { WSP(unsigned, WS_TAB)[e] = s; WSP(unsigned, WS_TAB)[16 + e] = tl; } s += BASE[8 + e]; tl += (BASE[8 + e] + 255u) >> 8; }
        BASE[24] = s; if (F.vcu == 0) { WSP(unsigned, WS_TAB)[8] = s; WSP(unsigned, WS_TAB)[24] = tl;
            unsigned rowL = 2u * M, t0 = 0, r0 = 0; for (int e = 0; e < 8; ++e) { const unsigned nt_ = (BASE[8 + e] + 255u) >> 8; if (t0 <= (unsigned)MAIN_TILES && (unsigned)MAIN_TILES < t0 + nt_) rowL = r0 + 256u * ((unsigned)MAIN_TILES - t0); t0 += nt_; r0 += BASE[8 + e]; }
            WSP(unsigned, WS_TAB)[25] = rowL; } }
    __syncthreads();
    if (F.vcu == 1 && F.tid < 256) WSP(unsigned, WS_TOKS)[2 * M + F.tid] = 0u;
    if (F.wave == 0) { const int t = 64 * F.vcu + F.lane; const unsigned te = WSP(unsigned, WS_TOKE)[t]; const int e1 = te & 255, e2 = (te >> 8) & 255;
        unsigned p1 = 0, p2 = 0; const unsigned long long lt = (1ull << F.lane) - 1ull;
#pragma unroll
        for (int e = 0; e < 8; ++e) { const unsigned long long b1 = __ballot(e1 == e), b2 = __ballot(e2 == e);
            if (e1 == e) p1 = BASE[16 + e] + BASE[e] + (unsigned)__popcll(b1 & lt);
            if (e2 == e) p2 = BASE[16 + e] + BASE[e] + (unsigned)__popcll(b1) + (unsigned)__popcll(b2 & lt); }
        WSP(unsigned, WS_POS)[2 * t] = p1; WSP(unsigned, WS_POS)[2 * t + 1] = p2; WSP(unsigned, WS_TOKS)[p1] = (unsigned)t; WSP(unsigned, WS_TOKS)[p2] = (unsigned)t; }
}

__device__ __forceinline__ void final_rows(Frame& F) {
    const int gw = F.vcu * NWAVES + F.wave, NGW = F.G * NWAVES; int lane_ = F.lane; asm volatile("" : "+v"(lane_));
    unsigned pp1 = 0, pp2 = 0; float gg1 = 0.f, gg2 = 0.f; const unsigned rowL = WSP(unsigned, WS_TAB)[25];
    { const int mi = gw + (lane_ & 7) * NGW; if (mi < M) { pp1 = WSP(unsigned, WS_POS)[2 * mi]; pp2 = WSP(unsigned, WS_POS)[2 * mi + 1]; gg1 = WSP(float, WS_GATE)[2 * mi]; gg2 = WSP(float, WS_GATE)[2 * mi + 1]; } }
#define FR_LOAD(i, X, A, B) do { const int m_ = gw + (i) * NGW; const unsigned q1_ = (unsigned)__builtin_amdgcn_readlane((int)pp1, (i) & 7), q2_ = (unsigned)__builtin_amdgcn_readlane((int)pp2, (i) & 7); \
        const GAS unsigned long long* xr_ = (const GAS unsigned long long*)(WSP(bf16, WS_H0) + (size_t)m_ * D) + lane_; const GAS unsigned* y1_ = (const GAS unsigned*)(WSP(unsigned char, WS_YS) + (size_t)q1_ * D) + lane_; \
        const GAS unsigned* y2_ = (const GAS unsigned*)(WSP(unsigned char, WS_YS) + (size_t)q2_ * D) + lane_; \
        _Pragma("unroll") for (int j = 0; j < 4; ++j) { X[j] = __builtin_nontemporal_load(xr_ + 64 * j); A[j] = __builtin_nontemporal_load(y1_ + 64 * j); B[j] = __builtin_nontemporal_load(y2_ + 64 * j); } } while (0)
    unsigned long long nx[4]; unsigned na[4], nb[4];
    if (gw < M) FR_LOAD(0, nx, na, nb);
    for (int i = 0; gw + i * NGW < M; ++i) { const int m = gw + i * NGW;
        f32x4 v[4]; unsigned ya[4], yb[4];
#pragma unroll
        for (int j = 0; j < 4; ++j) { const unsigned lo = (unsigned)nx[j], hi = (unsigned)(nx[j] >> 32); v[j] = (f32x4){__uint_as_float(lo << 16), __uint_as_float(lo & 0xffff0000u), __uint_as_float(hi << 16), __uint_as_float(hi & 0xffff0000u)}; ya[j] = na[j]; yb[j] = nb[j]; }
        const float g1 = __builtin_bit_cast(float, __builtin_amdgcn_readlane(__builtin_bit_cast(int, gg1), i & 7)), g2 = __builtin_bit_cast(float, __builtin_amdgcn_readlane(__builtin_bit_cast(int, gg2), i & 7));
        if (gw + (i + 1) * NGW < M) FR_LOAD(i + 1, nx, na, nb);
        float s = 0.f;
        typedef float f32x2v __attribute__((ext_vector_type(2)));
#pragma unroll
        for (int j = 0; j < 4; ++j) {
            const f32x2v a0 = __builtin_amdgcn_cvt_pk_f32_fp8((int)ya[j], false), a1 = __builtin_amdgcn_cvt_pk_f32_fp8((int)ya[j], true), b0 = __builtin_amdgcn_cvt_pk_f32_fp8((int)yb[j], false), b1 = __builtin_amdgcn_cvt_pk_f32_fp8((int)yb[j], true);
            v[j].x += g1 * a0.x + g2 * b0.x; v[j].y += g1 * a0.y + g2 * b0.y; v[j].z += g1 * a1.x + g2 * b1.x; v[j].w += g1 * a1.y + g2 * b1.y; }
        { const unsigned q1 = (unsigned)__builtin_amdgcn_readlane((int)pp1, i & 7), q2 = (unsigned)__builtin_amdgcn_readlane((int)pp2, i & 7);
#pragma unroll
          for (int sl = 0; sl < 2; ++sl) { const unsigned q = sl ? q2 : q1; const float gg = sl ? g2 : g1;
            if (q >= rowL) { const GAS unsigned* yp = (const GAS unsigned*)(WSP(unsigned char, WS_YP) + (size_t)(q - rowL) * D) + lane_;
#pragma unroll
                for (int part = 0; part < 3; ++part)
#pragma unroll
                    for (int j = 0; j < 4; ++j) { const unsigned w = yp[(size_t)part * (YP_ROWS * D / 4) + 64 * j]; const f32x2v c0 = __builtin_amdgcn_cvt_pk_f32_fp8((int)w, false), c1 = __builtin_amdgcn_cvt_pk_f32_fp8((int)w, true);
                        v[j].x += gg * c0.x; v[j].y += gg * c0.y; v[j].z += gg * c1.x; v[j].w += gg * c1.y; } } } }
#pragma unroll
        for (int j = 0; j < 4; ++j) {
            s += (v[j].x * v[j].x + v[j].y * v[j].y) + (v[j].z * v[j].z + v[j].w * v[j].w); }
        const float rs = 1.0f / sqrtf(wave_sum(s) * (1.0f / D) + EPS);
        GAS f32x4* xw = (GAS f32x4*)(F.out + (size_t)m * D) + lane_;
#pragma unroll
        for (int j = 0; j < 4; ++j) { const f32x4 g = *(const GAS f32x4*)(F.in[I_NF] + 4 * lane_ + 256 * j); __builtin_nontemporal_store((f32x4){v[j].x * rs * g.x, v[j].y * rs * g.y, v[j].z * rs * g.z, v[j].w * rs * g.w}, xw + 64 * j); }
    }
#undef FR_LOAD
}

constexpr int N_PHASES = 15;
#ifndef REP_P4
#define REP_P4 1
#endif
#ifndef REP_P12
#define REP_P12 1
#endif
#ifndef REP_P13
#define REP_P13 1
#endif
__global__ void __launch_bounds__(NWAVES * 64, 2) trunk_fwd(Args args) {
    extern __shared__ __attribute__((aligned(16))) unsigned char lds[];
    Frame F;
    F.lds = (LAS unsigned char*)lds;
    F.MISC = (volatile LAS unsigned*)(F.lds + MISC_OFF);
    F.tid = threadIdx.x; F.lane = F.tid & 63; F.wave = __builtin_amdgcn_readfirstlane(F.tid >> 6);
    F.G = gridDim.x; { const int bx = blockIdx.x; F.vcu = (F.G % 8 == 0) ? (bx % 8) * (F.G / 8) + bx / 8 : bx; }
    F.in = (const float* const __attribute__((address_space(4)))*)__builtin_amdgcn_kernarg_segment_ptr();
    F.out = args.out; F.ws = args.ws; F.ctl = (gu32*)(args.ws + WS_CTL);
    for (int u = F.tid; u < (LDS_BYTES - LDSCTL_OFF) / 4; u += NWAVES * 64) ((LAS unsigned*)(F.lds + LDSCTL_OFF))[u] = 0u;
    __syncthreads();
    const int lo = args.ph_lo, hi = args.ph_hi;
    const bool use_bar = (hi - lo) > 1;
    XcdBarrier bar; bar.bar = (unsigned*)(F.ctl + CW_BAR); bar.x = 0; bar.st = nullptr;
    if (use_bar) bar = xcd_barrier_post((unsigned*)(F.ctl + CW_BAR), F.MISC + 8);
#ifndef PHMASK
#define PHMASK 0x7fff
#endif
#define IN(k) ((((PHMASK) >> (k)) & 1) && lo <= (k) && (k) < hi)
#define SEAM(k) do { if (lo <= (k) && (k) + 1 < hi) xcd_barrier(bar); } while (0)
#ifndef DBLMASK
#define DBLMASK 0
#endif
#define RETID() do { int t_ = threadIdx.x; asm volatile("" : "+v"(t_)); F.tid = t_; F.lane = t_ & 63; } while (0)
#define PH(k, ...) if (IN(k)) { RETID(); { __VA_ARGS__ } if (((DBLMASK) >> (k)) & 1) { xcd_barrier(bar); { __VA_ARGS__ } } } SEAM(k);
    LAS unsigned char* ring = F.lds + RING_OFF;

    PH(0, p0_prologue(F); )

    PH(1,
        if (blockIdx.x < NB * NH && F.wave == 0) forget_cumsum(F, blockIdx.x >> 3, blockIdx.x & 7);
        PlainProb P{WSP(bf16, WS_H0), WSP(bf16, WS_WIN0), 2 * D, 2 * D, D / 64}; pg8::GridOrder S; S.init(M / 256, 2048 / 256, F.G, (int)blockIdx.x);
        EpiSplitBf16 E{WSP(bf16, WS_QKVP), attn_body::C2};
        const TableOrder TS = build_units(F.lds, S, F.tid);
        pg8::gemm_phase<EpiSplitBf16, TableOrder, PlainProb, true>(ring, P, TS, E);
    )

    PH(2,
        for (int r = F.vcu; r < M / 64; r += F.G) pool_rows(F, 64 * r);
        const attn_body::bf16* qkv = (const attn_body::bf16*)WSP(bf16, WS_QKVP);
        const attn_body::AttnTensors AT{qkv, qkv + (size_t)M * 512, qkv + (size_t)2 * M * 512, (attn_body::bf16*)WSP(bf16, WS_H0), WSP(float, WS_FNEG)};
        const attn_body::StaticOrder S((int)F.G, (int)blockIdx.x);
        attn_body::attn_phase<attn_body::StaticOrder>((char*)lds + RING_OFF, AT, S);
    )

    PH(3,
        PlainProb P{WSP(bf16, WS_H0), WSP(bf16, WS_WOT), 2 * D, 2 * D, D / 64}; pg8::GridOrder S; S.init(M / 256, D / 256, F.G, (int)blockIdx.x);
        EpiResid<true> E{F.in[I_X], WSP(bf16, WS_QKVP), WSP(float, WS_SSQ1)};
        pg8::gemm_phase<EpiResid<true>, pg8::GridOrder, PlainProb, false>(ring, P, S, E);
    )

    PH(4,
        PlainProb P{WSP(bf16, WS_QKVP), WSP(bf16, WS_W13), 2 * D, 2 * D, D / 64}; pg8::GridOrder S; S.init(M / 256, 2 * DFF / 256, F.G, (int)blockIdx.x);
        LAS float* RSL = (LAS float*)(F.lds + RS_OFF); fill_rs(RSL, WSP(float, WS_SSQ1), S, F.tid);
        EpiSwiglu E{WSP(bf16, WS_ACT0), RSL};
        const TableOrder TS = build_units(F.lds, S, F.tid);
        pg8::gemm_phase<EpiSwiglu, TableOrder, PlainProb, true, false, REP_P4>(ring, P, TS, E);
        if (SSM_IN_P4) { int pm_, pn_; if (!S.tile(5, pm_, pn_)) { const int k_ = (int)blockIdx.x - 128; if (k_ >= 0) { ssm_prep_job(F, k_ >> 1, k_ & 1, true); ssm_prep_job(F, k_ >> 1, (k_ & 1) + 2, false); } } }
    )

    PH(5,
        PlainProb P{WSP(bf16, WS_ACT0), WSP(bf16, WS_W2T), 2 * DFF, 2 * DFF, DFF / 64}; pg8::GridOrder S; S.init(M / 256, D / 256, F.G, (int)blockIdx.x);
        EpiResid<false> E{WSP(bf16, WS_QKVP), WSP(bf16, WS_H0), WSP(float, WS_SSQ2)};
        pg8::gemm_phase<EpiResid<false>, pg8::GridOrder, PlainProb, false>(ring, P, S, E);
    )

    PH(6,
        PlainProb P{WSP(bf16, WS_H0), WSP(bf16, WS_WIN1), 2 * D, 2 * D, D / 64}; pg8::GridOrder S; S.init(M / 256, D / 256, F.G, (int)blockIdx.x);
        LAS float* RSL = (LAS float*)(F.lds + RS_OFF); fill_rs(RSL, WSP(float, WS_SSQ2), S, F.tid);
        EpiSsmU E{WSP(bf16, WS_QKVP), RSL};
        pg8::gemm_phase<EpiSsmU, pg8::GridOrder, PlainProb, false>(ring, P, S, E);
    )

    PH(7, for (int j = F.vcu; j < 4 * SG; j += F.G) ssm_state_unit(F, j >> 2, j & 3); )

    PH(8,
        SsmProb P{WSP(bf16, WS_QKVP), WSP(bf16, WS_BT2), 2 * KA, 2 * KA}; SsmOrder S{F.vcu, F.G};
        EpiGelu E{WSP(bf16, WS_ACT0)};
        pg8::gemm_phase<EpiGelu, SsmOrder, SsmProb, false>(ring, P, S, E);
    )

    PH(9,
        PlainProb P{WSP(bf16, WS_ACT0), WSP(bf16, WS_WGLU), 2 * D, 2 * D, D / 64}; pg8::GridOrder S; S.init(M / 256, 2 * D / 256, F.G, (int)blockIdx.x);
        EpiGlu E{WSP(bf16, WS_H0)};
        const TableOrder TS = build_units(F.lds, S, F.tid);
        pg8::gemm_phase<EpiGlu, TableOrder, PlainProb, true>(ring, P, TS, E);
    )

    PH(10,
        LAS float* WR = (LAS float*)(F.lds + RING_OFF + 69632);
        LAS unsigned* CN = (LAS unsigned*)(F.lds + RING_OFF + 69632 + 32768);
        fill_w8(WR, F.in[I_RW], NE, F.in[I_N3], F.tid);
        if (F.tid < 16) CN[F.tid] = 0u;
        __syncthreads();
        if (F.wave < 4) router_rows(F, WR, CN);
        { LAS unsigned char* scr = F.lds + RING_OFF + F.wave * 8704;
          constexpr int JE = 8 * 44; constexpr int NIT = NE * 2 * JE;
          for (;;) { unsigned k = 0; if (F.lane == 0) k = atomicAdd((unsigned*)&CN[8], 1u); k = (unsigned)__builtin_amdgcn_readfirstlane((int)k);
              const int it = F.vcu + (int)k * F.G; if (it >= NIT) break; const int e = it / (2 * JE), r = it % (2 * JE);
              if (r < JE) tr_job_f8(F.in[I_EW1] + (size_t)e * D * DFF, DFF, 44, WSP(unsigned char, WS_W13E) + (size_t)e * 2 * DFF * D, D, 1, 0, r, scr, F.lane);
              else tr_job_f8(F.in[I_EW3] + (size_t)e * D * DFF, DFF, 44, WSP(unsigned char, WS_W13E) + (size_t)e * 2 * DFF * D, D, 1, 128, r - JE, scr, F.lane); } }
        __syncthreads();
        if (F.tid < 8) WSP(unsigned, WS_CNT)[F.vcu * 8 + F.tid] = CN[F.tid];
    )

    PH(11, moe_sort(F); )

    PH(12,
        const int nM_ = (int)WSP(unsigned, WS_TAB)[24], nwg_ = nM_ * (2 * DFF / 256), rounds_ = (nwg_ + F.G - 1) / F.G; int Gp_ = rounds_ > 0 ? (nwg_ + rounds_ - 1) / rounds_ : F.G; if (Gp_ > F.G) Gp_ = F.G;
        if ((int)blockIdx.x < Gp_) {
            MoeOrder S; S.tab = WSP(unsigned, WS_TAB); S.init(nM_, 2 * DFF / 256, Gp_, (int)blockIdx.x);
            MoeUpProb P{WSP(unsigned char, WS_H3), WSP(unsigned char, WS_W13E), (const LAS unsigned short*)(F.lds + TOKL_OFF), D, D};
            EpiSwigluF8 E{WSP(unsigned char, WS_ACTS)};
            const TableOrder TS = build_units(F.lds, S, F.tid); fill_tokl(F.lds, WSP(unsigned, WS_TOKS), F.tid);
            pg8::gemm_phase<EpiSwigluF8, TableOrder, MoeUpProb, true, true, REP_P12>(ring, P, TS, E);
        }
        { LAS unsigned char* scr = F.lds + RING_OFF + F.wave * 8704; constexpr int JE = 8 * 44; constexpr int NIT2 = NE * JE;
          for (;;) { __syncthreads(); if (F.tid == 0) F.MISC[16] = __hip_atomic_fetch_add((unsigned*)(F.ctl + CW_W2E), 8u, RLX_AGENT); __syncthreads();
              const int base = (int)F.MISC[16]; if (base >= NIT2) break; const int it = base + F.wave;
              if (it < NIT2) { const int e = it / JE, r = it % JE; tr_job_f8(F.in[I_EW2] + (size_t)e * DFF * D, D, 16, WSP(unsigned char, WS_W2E) + (size_t)e * D * DFF, DFF, 0, 0, r, scr, F.lane); } } }
    )

    PH(13,
        MoeDownOrder S; S.init(WSP(unsigned, WS_TAB), F.G, (int)blockIdx.x);
        MoeDownProb P{WSP(unsigned char, WS_ACTS), WSP(unsigned char, WS_W2E), DFF, DFF};
        EpiMaskF8 E{WSP(unsigned char, WS_YS), WSP(unsigned char, WS_YP), (int)WSP(unsigned, WS_TAB)[25]};
        const TableOrder TS = build_units(F.lds, S, F.tid);
        pg8::gemm_phase<EpiMaskF8, TableOrder, MoeDownProb, true, true, REP_P13>(ring, P, TS, E);
    )

    PH(14, final_rows(F); )
#undef IN
#undef SEAM
}

extern "C" void kernel_launch(void* const* d_in, const int* in_sizes, int n_in, void* d_out, int out_size, void* d_ws, size_t ws_size, hipStream_t stream) {
    static int grid = 0;
    if (grid == 0) {
        if (n_in != 30 || in_sizes[0] != M * D || out_size != M * D || ws_size < WS_END) { fprintf(stderr, "kernel_launch: shape/workspace mismatch (n_in %d, ws %zu, need %zu); nothing launched\n", n_in, ws_size, (size_t)WS_END); grid = -1; return; }
        int dev = 0, cus = 0, per_cu = 0;
        if (hipGetDevice(&dev) != hipSuccess || hipDeviceGetAttribute(&cus, hipDeviceAttributeMultiprocessorCount, dev) != hipSuccess) { grid = -1; return; }
        if (hipFuncSetAttribute((const void*)trunk_fwd, hipFuncAttributeMaxDynamicSharedMemorySize, LDS_BYTES) != hipSuccess) { fprintf(stderr, "kernel_launch: hipFuncSetAttribute failed\n"); grid = -1; return; }
        if (hipOccupancyMaxActiveBlocksPerMultiprocessor(&per_cu, (const void*)trunk_fwd, NWAVES * 64, LDS_BYTES) != hipSuccess || per_cu < 1) fprintf(stderr, "kernel_launch: occupancy query reports %d\n", per_cu);
        (void)hipGetLastError();
        if (cus < 256) { fprintf(stderr, "kernel_launch: needs 256 CUs, device has %d\n", cus); grid = -1; return; }
        grid = 256;
    }
    if (grid < 0) return;
    if (hipMemsetAsync((char*)d_ws + WS_CTL, 0, 32 * 1024, stream) != hipSuccess) return;
    Args a{};
    for (int i = 0; i < 30; ++i) a.in[i] = (const float*)d_in[i];
    a.out = (float*)d_out; a.ws = (unsigned char*)d_ws;
#ifndef MK_SPLIT
    a.ph_lo = 0; a.ph_hi = N_PHASES;
    hipLaunchKernelGGL(trunk_fwd, dim3(grid), dim3(NWAVES * 64), LDS_BYTES, stream, a);
#else
    for (int p = 0; p < N_PHASES; ++p) { a.ph_lo = p; a.ph_hi = p + 1; hipLaunchKernelGGL(trunk_fwd, dim3(grid), dim3(NWAVES * 64), LDS_BYTES, stream, a); }
#endif
}
```

```cpp
#include <hip/hip_runtime.h>
#include <hip/hip_bf16.h>
#include <cstdio>
#include <cstdint>
#include <cmath>

namespace pg8 {
#define PG8_LAS __attribute__((address_space(3)))
typedef unsigned short bf16_t;
typedef short bf16x8 __attribute__((ext_vector_type(8)));
typedef float f32x4 __attribute__((ext_vector_type(4)));
typedef float f32x2 __attribute__((ext_vector_type(2)));
typedef unsigned u32x4 __attribute__((ext_vector_type(4)));
typedef unsigned u32x2 __attribute__((ext_vector_type(2)));
constexpr int BM = 256, BK = 64, HALF = 128, HTB = HALF * BK * 2  , STAGE_BYTES = 8 * HTB, NXCD = 8, WGM = 8;

__host__ __device__ __forceinline__ int lds_byte(int r, int c) { const int st = (r >> 4) * 2 + (c >> 5), rr = r & 15, cc = c & 31, ob = rr * 64 + cc * 2; return st * 1024 + (ob ^ (((ob >> 9) & 1) << 5)); }
__host__ __device__ __forceinline__ void stage_rc(int b, int& R, int& C) { const int st = b / 1024, sb = b % 1024, swz = sb ^ (((sb >> 9) & 1) << 5); R = (st >> 1) * 16 + swz / 64; C = (st & 1) * 32 + (swz % 64) / 2; }
__host__ __device__ __forceinline__ int perm32(int rho) { const int n = rho >> 4, i = rho & 15; return 8 * (i >> 2) + 4 * n + (i & 3); }

struct Unit { int pm, pn, x0, x1, x2, kq; };

struct GridOrder {
    int nM, nN, nwg, G, c;
    __device__ __forceinline__ void init(int nM_, int nN_, int G_, int c_) { nM = nM_; nN = nN_; nwg = nM * nN; G = G_; c = c_; }
    __device__ __forceinline__ bool tile(int i, int& pm, int& pn) const {
        const long L = (long)i * G + c; if (L >= nwg) return false;
        int wgid = (int)L; { const int q = nwg / NXCD, r = nwg % NXCD, xcd = wgid % NXCD, off = wgid / NXCD; wgid = (xcd < r ? xcd * (q + 1) : r * (q + 1) + (xcd - r) * q) + off; }
        const int nig = WGM * nN, gid = wgid / nig, fm = gid * WGM, gsz = (nM - fm) < WGM ? (nM - fm) : WGM;
        pm = fm + ((wgid % nig) % gsz); pn = (wgid % nig) / gsz; return true;
    }
    __device__ __forceinline__ bool next(int i, Unit& u) const { u.x0 = 0; u.x1 = i; u.x2 = 0; u.kq = -1; return tile(i, u.pm, u.pn); }
};

__device__ __forceinline__ unsigned cvt_pk_bf16(float lo, float hi) { unsigned r; asm volatile("v_cvt_pk_bf16_f32 %0, %1, %2" : "=v"(r) : "v"(lo), "v"(hi)); return r; }
__device__ __forceinline__ float fast_sigmoid(float v) { return __builtin_amdgcn_rcpf(1.0f + __builtin_amdgcn_exp2f(-1.4426950408889634f * v)); }
__device__ __forceinline__ float gelu_tanh(float y) { const float z2 = y * (1.5957691216057308f + 0.07135481627159282f * y * y); return y * fast_sigmoid(z2); }

typedef int i32x4 __attribute__((ext_vector_type(4)));
typedef int i32x8 __attribute__((ext_vector_type(8)));
template <class Epi, class Sched, class Prob, bool ALIGN_EPI, bool FP8 = false, int EPI_REP = 1>
__device__ __forceinline__ void gemm_phase(PG8_LAS unsigned char* lds, const Prob& P, const Sched& S, const Epi& E) {
    int tid_ = threadIdx.x; asm volatile("" : "+v"(tid_));
    const int tid = tid_, wid = __builtin_amdgcn_readfirstlane(tid >> 6), lane = tid & 63, wr = wid >> 2, wc = wid & 3, fr = lane & 15, fq = lane >> 4;
    unsigned cV[2][2], nV[2][2], voffB[2]; int pR[2], pC[2];
#pragma unroll
    for (int i = 0; i < 2; ++i) { int R, C; stage_rc(tid * 16 + i * 8192, R, C); pR[i] = R; pC[i] = C; const int Rb = Epi::PERM ? ((R & ~31) + perm32(R & 31)) : R;
        voffB[i] = (unsigned)(Rb * P.ldb + C * 2);
        cV[0][i] = (unsigned)(R * P.lda + C * 2); cV[1][i] = (unsigned)((R + HALF) * P.lda + C * 2); nV[0][i] = cV[0][i]; nV[1][i] = cV[1][i]; }
    const size_t kstep = (size_t)(BK * 2);
    const size_t hstepB = (size_t)HALF * P.ldb;
    const unsigned ldsw = (unsigned)wid * 1024u;
    int aofs[2], bofs[2];
    aofs[0] = lds_byte(wr * 64 + fr, fq * 8); aofs[1] = aofs[0] + 1024; bofs[0] = lds_byte(wc * 32 + fr, fq * 8); bofs[1] = bofs[0] + 1024;
#define PG8_SA(b, h) (((b) * 2 + (h)) * HTB)
#define PG8_SB(b, h) ((4 + (b) * 2 + (h)) * HTB)
#define PG8_STAGE(bufoff, gbase, voff) do { _Pragma("unroll") for (int _i = 0; _i < 2; ++_i) \
        __builtin_amdgcn_global_load_lds((const unsigned*)((const char*)(gbase) + (voff)[_i]), (PG8_LAS unsigned*)(lds + (bufoff) + ldsw + _i * 8192), 16, 0, 0); } while (0)
#define PG8_LDA(dst, b, h) do { _Pragma("unroll") for (int m = 0; m < 4; ++m) dst[m] = __builtin_shufflevector(*(const PG8_LAS i32x4*)(lds + PG8_SA(b, h) + aofs[0] + m * 2048), *(const PG8_LAS i32x4*)(lds + PG8_SA(b, h) + aofs[1] + m * 2048), 0, 1, 2, 3, 4, 5, 6, 7); } while (0)
#define PG8_LDB(dst, b, h) do { _Pragma("unroll") for (int n = 0; n < 2; ++n) dst[n] = __builtin_shufflevector(*(const PG8_LAS i32x4*)(lds + PG8_SB(b, h) + bofs[0] + n * 2048), *(const PG8_LAS i32x4*)(lds + PG8_SB(b, h) + bofs[1] + n * 2048), 0, 1, 2, 3, 4, 5, 6, 7); } while (0)
#define PG8_LO(x) __builtin_bit_cast(bf16x8, __builtin_shufflevector(x, x, 0, 1, 2, 3))
#define PG8_HI(x) __builtin_bit_cast(bf16x8, __builtin_shufflevector(x, x, 4, 5, 6, 7))
#define PG8_MMA(ai, bj, At, Bt) do { __builtin_amdgcn_s_setprio(1); _Pragma("unroll") for (int m = 0; m < 4; ++m) _Pragma("unroll") for (int n = 0; n < 2; ++n) { \
        if constexpr (FP8) acc[ai][bj][m][n] = __builtin_amdgcn_mfma_scale_f32_16x16x128_f8f6f4(Bt[n], At[m], acc[ai][bj][m][n], 0, 0, 0, 0x7f7f7f7f, 0, 0x7f7f7f7f); \
        else { acc[ai][bj][m][n] = __builtin_amdgcn_mfma_f32_16x16x32_bf16(PG8_LO(Bt[n]), PG8_LO(At[m]), acc[ai][bj][m][n], 0, 0, 0); acc[ai][bj][m][n] = __builtin_amdgcn_mfma_f32_16x16x32_bf16(PG8_HI(Bt[n]), PG8_HI(At[m]), acc[ai][bj][m][n], 0, 0, 0); } } \
        if constexpr (FP8) { _Pragma("unroll") for (int m = 0; m < 4; ++m) asm volatile("" : "+v"(acc[ai][bj][m][0]), "+v"(acc[ai][bj][m][1])); }     \
        __builtin_amdgcn_s_setprio(0); } while (0)
#define PG8_WAIT_V(n) asm volatile("s_waitcnt vmcnt(" #n ")" ::: "memory")
#define PG8_WAIT_L(n) asm volatile("s_waitcnt lgkmcnt(" #n ")" ::: "memory")
#define PG8_BAR __builtin_amdgcn_s_barrier()
#define PG8_SCHED __builtin_amdgcn_sched_barrier(0)
    Unit cur, nxt, nn; int ui = 0; unsigned nnV[2][2]; bool has_next = false;
    if (!S.next(0, cur)) return;
    f32x4 acc[2][2][4][2];
#pragma unroll
    for (int a = 0; a < 2; ++a)
#pragma unroll
        for (int b = 0; b < 2; ++b)
#pragma unroll
            for (int m = 0; m < 4; ++m)
#pragma unroll
                for (int n = 0; n < 2; ++n) acc[a][b][m][n] = (f32x4){0.f, 0.f, 0.f, 0.f};
    i32x8 At[4], B0[2], B1[2];
    const char* cA; const char* cB; int nt;
    P.ptrs(cur, cA, cB, nt);
    if constexpr (Prob::GATHER) { P.gather(cur, pR, pC, cV); has_next = S.next(1, nxt); if (has_next) P.gather(nxt, pR, pC, nV); }
    PG8_STAGE(PG8_SB(0, 0), cB, voffB); PG8_STAGE(PG8_SB(0, 1), cB + hstepB, voffB); PG8_STAGE(PG8_SA(0, 0), cA, cV[0]); PG8_STAGE(PG8_SA(0, 1), cA, cV[1]);
    if (wr == 1) PG8_BAR;
    PG8_WAIT_V(2); PG8_BAR;
    PG8_STAGE(PG8_SB(1, 0), cB + kstep, voffB); PG8_STAGE(PG8_SA(1, 0), cA + kstep, cV[0]); PG8_STAGE(PG8_SB(1, 1), cB + hstepB + kstep, voffB);
    PG8_WAIT_V(6); PG8_BAR;
    for (;;) {
        bool has_nn = false;
        if constexpr (Prob::GATHER) { if (has_next) { has_nn = S.next(ui + 2, nn); if (has_nn) P.gather(nn, pR, pC, nnV); } }
        else has_next = S.next(ui + 1, nxt);
        const char* nA = cA; const char* nB = cB; int nnt = nt;
        if (has_next) { P.ptrs(nxt, nA, nB, nnt); }
        else { if constexpr (Prob::GATHER) { nV[0][0] = cV[0][0]; nV[0][1] = cV[0][1]; nV[1][0] = cV[1][0]; nV[1][1] = cV[1][1]; } }
        for (int t = 0; t < nt; t += 2) {
            const bool last = (t == nt - 2);
            const char* a1 = cA + (size_t)(t + 1) * kstep;
            const char* a2 = last ? nA : cA + (size_t)(t + 2) * kstep; const char* b2 = last ? nB : cB + (size_t)(t + 2) * kstep;
            const char* a3 = a2 + kstep; const char* b3 = b2 + kstep;
            unsigned v2[2][2];
            if constexpr (Prob::GATHER) { v2[0][0] = last ? nV[0][0] : cV[0][0]; v2[0][1] = last ? nV[0][1] : cV[0][1]; v2[1][0] = last ? nV[1][0] : cV[1][0]; v2[1][1] = last ? nV[1][1] : cV[1][1]; }
            else { v2[0][0] = cV[0][0]; v2[0][1] = cV[0][1]; v2[1][0] = cV[1][0]; v2[1][1] = cV[1][1]; }
            PG8_LDB(B0, 0, 0); PG8_LDB(B1, 0, 1); PG8_SCHED; PG8_LDA(At, 0, 0); PG8_STAGE(PG8_SA(1, 1), a1, cV[1]);
            PG8_WAIT_V(8); PG8_WAIT_L(0); PG8_BAR; PG8_MMA(0, 0, At, B0); PG8_MMA(0, 1, At, B1); PG8_BAR; PG8_SCHED;
            PG8_LDA(At, 0, 1); PG8_STAGE(PG8_SB(0, 0), b2, voffB); PG8_STAGE(PG8_SB(0, 1), b2 + hstepB, voffB); PG8_STAGE(PG8_SA(0, 0), a2, v2[0]);
            PG8_WAIT_V(8); PG8_WAIT_L(0); PG8_BAR; PG8_MMA(1, 0, At, B0); PG8_MMA(1, 1, At, B1); PG8_BAR; PG8_SCHED;
            PG8_LDB(B0, 1, 0); PG8_LDB(B1, 1, 1); PG8_SCHED; PG8_LDA(At, 1, 0); PG8_STAGE(PG8_SA(0, 1), a2, v2[1]);
            PG8_WAIT_V(8); PG8_WAIT_L(0); PG8_BAR; PG8_MMA(0, 0, At, B0); PG8_MMA(0, 1, At, B1); PG8_BAR; PG8_SCHED;
            PG8_LDA(At, 1, 1); PG8_STAGE(PG8_SB(1, 0), b3, voffB); PG8_STAGE(PG8_SB(1, 1), b3 + hstepB, voffB); PG8_STAGE(PG8_SA(1, 0), a3, v2[0]);
            PG8_WAIT_V(8); PG8_WAIT_L(0); PG8_BAR; PG8_MMA(1, 0, At, B0); PG8_MMA(1, 1, At, B1); PG8_BAR; PG8_SCHED;
        }
        if constexpr (ALIGN_EPI) { if (wr == 0) PG8_BAR; }
        if constexpr (!Epi::AFTER_DRAIN) { _Pragma("unroll") for (int rep_ = 0; rep_ < EPI_REP; ++rep_) E(acc, cur, wr, wc, fr, fq); }
        if (!has_next) break;
#pragma unroll
        for (int a = 0; a < 2; ++a)
#pragma unroll
            for (int b = 0; b < 2; ++b)
#pragma unroll
                for (int m = 0; m < 4; ++m)
#pragma unroll
                    for (int n = 0; n < 2; ++n) acc[a][b][m][n] = (f32x4){0.f, 0.f, 0.f, 0.f};
        cur = nxt; cA = nA; cB = nB; nt = nnt; ++ui;
        if constexpr (Prob::GATHER) { cV[0][0] = nV[0][0]; cV[0][1] = nV[0][1]; cV[1][0] = nV[1][0]; cV[1][1] = nV[1][1];
            if (has_nn) { nxt = nn; nV[0][0] = nnV[0][0]; nV[0][1] = nnV[0][1]; nV[1][0] = nnV[1][0]; nV[1][1] = nnV[1][1]; } has_next = has_nn; }
        if constexpr (ALIGN_EPI) { if (wr == 1) PG8_BAR; }
    }
    PG8_WAIT_V(0);
    if constexpr (!ALIGN_EPI) { if (wr == 0) PG8_BAR; }
    PG8_BAR;
    if constexpr (Epi::AFTER_DRAIN) { E.fused(acc, cur, wr, wc, fr, fq, lds, wid, lane); }
#undef PG8_SA
#undef PG8_SB
#undef PG8_STAGE
#undef PG8_LDA
#undef PG8_LDB
#undef PG8_MMA
#undef PG8_LO
#undef PG8_HI
#undef PG8_WAIT_V
#undef PG8_WAIT_L
#undef PG8_BAR
#undef PG8_SCHED
}
}
#include <hip/hip_bf16.h>
#include <cmath>
namespace attn_body {
using bf16=__hip_bfloat16;
using bf16x8=__attribute__((ext_vector_type(8)))short;
using s16x4=__attribute__((ext_vector_type(4)))short;
using f32x16=__attribute__((ext_vector_type(16)))float;
using u32x4=__attribute__((ext_vector_type(4)))unsigned;
constexpr int BATCH=8,NHEAD=8,SEQ=2048,D=64,DM=NHEAD*D,DMO=1024;
constexpr int NW=8,QBLK=32,QB=QBLK*NW,KVBLK=64,NQB=SEQ/QB;
constexpr int ATTN_PITCH=DM, ATTN_OPITCH=DMO, ATTN_UNIT_ROWS=QB;
__device__ __forceinline__ int crow(int r,int hi){return (r&3)+8*(r>>2)+4*hi;}
#define SBAR() __builtin_amdgcn_sched_barrier(0)
__device__ __forceinline__ void cmask(f32x16&p0,f32x16&p1,int jb,int qrel,int hi){
  const float NEG=-INFINITY; int kb=64*jb+4*hi;
  #pragma unroll
  for(int r=0;r<16;++r){int kv=kb+(r&3)+8*(r>>2); if(kv>qrel)p0[r]=NEG; if(kv+32>qrel)p1[r]=NEG;}
}

constexpr int NSLOT=3, SLOTB=8192;
constexpr int LDS_K=0, LDS_V=NSLOT*SLOTB, LDS_WS=2*NSLOT*SLOTB, LDS_OST=LDS_WS+NW*64*4, LDS_BIAS=LDS_OST+NW*4096, LDS_BYTES=LDS_BIAS+SEQ*4;
constexpr float C2=0.125f*1.4426950408889634f;
__device__ __forceinline__ void glds16(const void*gsrc,unsigned lds_dst){unsigned keep;
  asm volatile("s_mov_b32 %0, m0\n\ts_mov_b32 m0, %2\n\ts_nop 0\n\tglobal_load_lds_dwordx4 %1, off\n\ts_mov_b32 m0, %0":"=&s"(keep):"v"(gsrc),"s"(lds_dst):"memory");}
__device__ __forceinline__ float max3f(float a,float b,float c){float r;asm("v_max3_f32 %0, %1, %2, %3":"=v"(r):"v"(a),"v"(b),"v"(c));return r;}
__device__ __forceinline__ float max2f(float a,float b){float r;asm("v_max_f32_e32 %0, %1, %2":"=v"(r):"v"(a),"v"(b));return r;}
__device__ __forceinline__ float fadd_s(float a,float b){float r;asm("v_add_f32_e32 %0, %1, %2":"=v"(r):"v"(a),"v"(b));return r;}
__device__ __forceinline__ float fsub_s(float a,float b){float r;asm("v_sub_f32_e32 %0, %1, %2":"=v"(r):"v"(a),"v"(b));return r;}
typedef float f32x2_t __attribute__((ext_vector_type(2))); typedef float f32x4_t __attribute__((ext_vector_type(4))); typedef __bf16 bf16x2_t __attribute__((ext_vector_type(2)));
__device__ __forceinline__ unsigned cvtpk_s(float lo,float hi){f32x2_t v={lo,hi};bf16x2_t b=__builtin_convertvector(v,bf16x2_t);return __builtin_bit_cast(unsigned,b);}
#define WAIT_BAR(N) asm volatile("s_waitcnt vmcnt(" #N ") lgkmcnt(0)\n\ts_barrier":::"memory")

__device__ __forceinline__ void qkt(f32x16&p0,f32x16&p1,const char*Kslot,const bf16x8*qr,const f32x16&negm,int r32,int hi){
  const char*kb=Kslot+hi*1024+r32*16;
  #pragma unroll
  for(int d0=0;d0<4;++d0){
    const bf16x8 b0=*reinterpret_cast<const bf16x8*>(kb+d0*2048);
    const bf16x8 b1=*reinterpret_cast<const bf16x8*>(kb+d0*2048+512);
    if(d0==0){p0=__builtin_amdgcn_mfma_f32_32x32x16_bf16(b0,qr[0],negm,0,0,0);p1=__builtin_amdgcn_mfma_f32_32x32x16_bf16(b1,qr[0],negm,0,0,0);}
    else{p0=__builtin_amdgcn_mfma_f32_32x32x16_bf16(b0,qr[d0],p0,0,0,0);p1=__builtin_amdgcn_mfma_f32_32x32x16_bf16(b1,qr[d0],p1,0,0,0);}}
}
typedef __attribute__((address_space(3))) const char* lds_cptr;
typedef short v4i16_t __attribute__((ext_vector_type(4)));
__device__ __forceinline__ void kload8(bf16x8*kf,lds_cptr kp){
  kf[0]=*(const __attribute__((address_space(3))) bf16x8*)(kp);      kf[1]=*(const __attribute__((address_space(3))) bf16x8*)(kp+512);
  kf[2]=*(const __attribute__((address_space(3))) bf16x8*)(kp+2048); kf[3]=*(const __attribute__((address_space(3))) bf16x8*)(kp+2560);
  kf[4]=*(const __attribute__((address_space(3))) bf16x8*)(kp+4096); kf[5]=*(const __attribute__((address_space(3))) bf16x8*)(kp+4608);
  kf[6]=*(const __attribute__((address_space(3))) bf16x8*)(kp+6144); kf[7]=*(const __attribute__((address_space(3))) bf16x8*)(kp+6656);
}
__device__ __forceinline__ void kload2(bf16x8*kf,lds_cptr kp,int j){ kf[2*j]=*(const __attribute__((address_space(3))) bf16x8*)(kp+j*2048); kf[2*j+1]=*(const __attribute__((address_space(3))) bf16x8*)(kp+j*2048+512); }
__device__ __forceinline__ s16x4 vtr(lds_cptr p){ return __builtin_bit_cast(s16x4,__builtin_amdgcn_ds_read_tr16_b64_v4i16((__attribute__((address_space(3))) v4i16_t*)p)); }
__device__ __forceinline__ float rowmax(const f32x16&p0,const f32x16&p1){
  float a=max3f(p0[0],p0[1],p1[0]),b=max3f(p0[2],p0[3],p1[1]);a=max3f(a,p1[2],p1[3]);
  #pragma unroll
  for(int r=4;r<16;r+=4){a=max3f(a,p0[r],p0[r+1]);b=max3f(b,p0[r+2],p0[r+3]);a=max3f(a,p1[r],p1[r+1]);b=max3f(b,p1[r+2],p1[r+3]);}
  const float m=max2f(a,b);
  auto rr=__builtin_amdgcn_permlane32_swap(__float_as_uint(m),__float_as_uint(m),false,false);
  return max2f(__uint_as_float(rr[0]),__uint_as_float(rr[1]));
}
__device__ __forceinline__ void pv(f32x16*o,int vb,bf16x8 pa0,bf16x8 pa1,bf16x8 pa2,bf16x8 pa3){
  #pragma unroll
  for(int d0=0;d0<2;++d0){s16x4 lo[4],hi[4];
    #pragma unroll
    for(int ks=0;ks<4;++ks){
      asm volatile("ds_read_b64_tr_b16 %0,%1 offset:%c2":"=&v"(lo[ks]):"v"(vb),"i"(d0*4096+ks*1024):"memory");
      asm volatile("ds_read_b64_tr_b16 %0,%1 offset:%c2":"=&v"(hi[ks]):"v"(vb),"i"(d0*4096+ks*1024+512):"memory");}
    asm volatile("s_waitcnt lgkmcnt(0)":::"memory");SBAR();
    #define PK(k) (bf16x8){lo[k][0],lo[k][1],lo[k][2],lo[k][3],hi[k][0],hi[k][1],hi[k][2],hi[k][3]}
    o[d0]=__builtin_amdgcn_mfma_f32_32x32x16_bf16(pa0,PK(0),o[d0],0,0,0);
    o[d0]=__builtin_amdgcn_mfma_f32_32x32x16_bf16(pa1,PK(1),o[d0],0,0,0);
    o[d0]=__builtin_amdgcn_mfma_f32_32x32x16_bf16(pa2,PK(2),o[d0],0,0,0);
    o[d0]=__builtin_amdgcn_mfma_f32_32x32x16_bf16(pa3,PK(3),o[d0],0,0,0);
    #undef PK
  }
}

#ifndef ATTN_STORE16
#define ATTN_STORE16(p,v) (*(u32x4*)(p)=(v))
#endif
template<int THRL> __device__ __forceinline__ void attn_unit(int b,int h,int qb,const bf16*Q,const bf16*__restrict__ K,const bf16*__restrict__ V,bf16*O,const float*__restrict__ Fb,char*shm){
  asm volatile("":"+s"(Q),"+s"(K),"+s"(V),"+s"(O),"+s"(Fb));
  int tid_=threadIdx.x; asm volatile("":"+v"(tid_));
  const int tid=tid_,lane=tid&63,r32=lane&31,hi=lane>>5; const int wid=__builtin_amdgcn_readfirstlane(tid>>6);
  const long rowbase=(long)b*SEQ; const int q0=qb*QB;
  const bf16*Qw=Q+(rowbase+q0+wid*QBLK)*DM+h*D;
  const bf16*Kh=K+rowbase*DM+h*D,*Vh=V+rowbase*DM+h*D;
  const unsigned lds0=(unsigned)(uintptr_t)shm;
  float*wsf=(float*)(shm+LDS_WS)+wid*64;
  const bf16*ksrc=Kh+(long)lane*DM+wid*8;
  const bf16*vsrc=Vh+(long)(16*(wid&3)+(lane>>2))*DM+(wid>>2)*32+(lane&3)*8;
  const unsigned kdst=lds0+LDS_K+wid*1024, vdst=lds0+LDS_V+wid*1024;
  #define DMA_K(t,slot) glds16(ksrc+(long)(t)*KVBLK*DM,(unsigned)__builtin_amdgcn_readfirstlane(kdst+(slot)))
  #define DMA_V(t,slot) glds16(vsrc+(long)(t)*KVBLK*DM,(unsigned)__builtin_amdgcn_readfirstlane(vdst+(slot)))
  const int vb0=(int)(lds0+LDS_V)+((lane>>4)&1)*32+(lane&3)*8+(4*hi+((lane&15)>>2))*64;
  const char*Kbase=shm+LDS_K; bf16x8 kf[8];
  const lds_cptr shm3=(lds_cptr)shm; const lds_cptr kp0=shm3+LDS_K+hi*1024+r32*16; const lds_cptr vp0=shm3+LDS_V+((lane>>4)&1)*32+(lane&3)*8+(4*hi+((lane&15)>>2))*64;
  const int NT=(q0+QB)/KVBLK;
  glds16(Fb+wid*256+lane*4,(unsigned)__builtin_amdgcn_readfirstlane(lds0+LDS_BIAS+wid*1024));
  DMA_K(0,0);DMA_V(0,0);DMA_K(1,SLOTB);
  bf16x8 qr[4];
  #pragma unroll
  for(int d0=0;d0<4;++d0)qr[d0]=*reinterpret_cast<const bf16x8*>(&Qw[(long)r32*DM+d0*16+hi*8]);
  float mhat=0.f,l_reg=0.f;f32x16 o[2];o[0]=f32x16{};o[1]=f32x16{};f32x16 negm;
  #pragma unroll
  for(int r=0;r<16;++r)asm volatile("v_mov_b32 %0, 0":"=v"(negm[r]));
  asm volatile("":"+v"(negm));
  const int qrel=wid*QBLK+r32;
  #define CMASK(P0,P1,t) do{int jb_=(t)-(NT-4); if(jb_>=0)cmask(P0,P1,jb_,qrel,hi);}while(0)
  #define BIAS(P0,P1,t) do{ const __attribute__((address_space(3))) f32x4_t* bp_=(const __attribute__((address_space(3))) f32x4_t*)(shm3+LDS_BIAS)+(t)*16+hi; \
    _Pragma("unroll") for(int j_=0;j_<4;++j_){ const f32x4_t b0_=bp_[2*j_], b1_=bp_[8+2*j_]; \
      P0[4*j_]+=b0_[0]; P0[4*j_+1]+=b0_[1]; P0[4*j_+2]+=b0_[2]; P0[4*j_+3]+=b0_[3]; \
      P1[4*j_]+=b1_[0]; P1[4*j_+1]+=b1_[1]; P1[4*j_+2]+=b1_[2]; P1[4*j_+3]+=b1_[3]; } }while(0)
  bool resc=false;
  #define START(P0,P1) do{ _Pragma("unroll") for(int r=0;r<16;++r)P0[r]=__builtin_amdgcn_exp2f(P0[r]); }while(0)
  #define RESC() do{}while(0)
  f32x16 pA0,pA1,pB0,pB1;
  int sl_prev=0,sl_cur=0,sl_next=SLOTB;
  #define ROT() do{sl_prev=sl_cur;sl_cur=sl_next;sl_next=(sl_next==(NSLOT-1)*SLOTB)?0:sl_next+SLOTB;}while(0)
  DMA_K(2,2*SLOTB);
  WAIT_BAR(3);
  { mhat=*(const __attribute__((address_space(3))) float*)(shm3+LDS_BIAS+(q0+qrel)*4);
    _Pragma("unroll") for(int r=0;r<16;++r)negm[r]=-mhat; asm volatile("":"+v"(negm)); }
  qkt(pA0,pA1,Kbase,qr,negm,r32,hi);asm volatile("s_nop 15\n\ts_nop 7":"+v"(pA0),"+v"(pA1));BIAS(pA0,pA1,0);CMASK(pA0,pA1,0);
  START(pA0,pA1);
  _Pragma("unroll") for(int r=0;r<16;++r)pA1[r]=__builtin_amdgcn_exp2f(pA1[r]);
  WAIT_BAR(0);
  DMA_K(3,0);DMA_V(1,SLOTB);
  ROT();
  kload8(kf,kp0+sl_cur);
  WAIT_BAR(2);
  s16x4 vlo[8],vhi[8]; u32x4 pw0,pw1,pw2,pw3;
  #define PKW(P,B) cvtpk_s(P[B],P[B+1])
  #define PAF(k) __builtin_bit_cast(bf16x8,pw##k)
  #define VFR(i) (bf16x8){vlo[i][0],vlo[i][1],vlo[i][2],vlo[i][3],vhi[i][0],vhi[i][1],vhi[i][2],vhi[i][3]}
  #define PIN(x) asm volatile("":"+v"(x))
  #define MX3(a,b,c) __builtin_fmaxf(__builtin_fmaxf((a),(b)),(c))
  #define GAPA(MF,A0,A1,A2,A3,W0,W1,PW) do{ MF; sacc+=A0; sacc+=A1; sacc+=A2; sacc+=A3; PIN(sacc); W0; W1; PIN(PW); SBAR(); }while(0)
  #define EX(v) __builtin_amdgcn_exp2f(v)
  #define GAPB(MF,X,B) do{ MF; X[B]=EX(X[B]); X[B+1]=EX(X[B+1]); X[B+2]=EX(X[B+2]); X[B+3]=EX(X[B+3]); PIN(X); SBAR(); }while(0)
  #define VRD(i) do{ vlo[i]=vtr(vp_+(((i)>>2)*4096+((i)&3)*1024)); vhi[i]=vtr(vp_+(((i)>>2)*4096+((i)&3)*1024+512)); }while(0)
  #define KRD(G,j) do{ if(G){ kload2(kf,kp0+sl_next,j); SBAR(); } }while(0)
  #define STEP(C0,C1,P0,P1,t,GK,GV,GL) do{ SBAR(); \
    const lds_cptr vp_=vp0+sl_prev; \
    VRD(0); SBAR(); float sacc=(P0[0]+P0[1]); \
    GAPA(C0=__builtin_amdgcn_mfma_f32_32x32x16_bf16(kf[0],qr[0],negm,0,0,0), P0[2],P0[3],P0[4],P0[5],     pw0[0]=PKW(P0,0), pw0[1]=PKW(P0,2), pw0); \
    VRD(4); SBAR(); GAPA(C1=__builtin_amdgcn_mfma_f32_32x32x16_bf16(kf[1],qr[0],negm,0,0,0), P0[6],P0[7],P0[8],P0[9],     pw0[2]=PKW(P0,4), pw0[3]=PKW(P0,6), pw0); \
    VRD(1); SBAR(); GAPA(C0=__builtin_amdgcn_mfma_f32_32x32x16_bf16(kf[2],qr[1],C0,0,0,0),   P0[10],P0[11],P0[12],P0[13], pw1[0]=PKW(P0,8), pw1[1]=PKW(P0,10), pw1); \
    VRD(5); SBAR(); GAPA(C1=__builtin_amdgcn_mfma_f32_32x32x16_bf16(kf[3],qr[1],C1,0,0,0),   P0[14],P0[15],P1[0],P1[1],   pw1[2]=PKW(P0,12),pw1[3]=PKW(P0,14), pw1); \
    VRD(2); SBAR(); GAPA(C0=__builtin_amdgcn_mfma_f32_32x32x16_bf16(kf[4],qr[2],C0,0,0,0),   P1[2],P1[3],P1[4],P1[5],     pw2[0]=PKW(P1,0), pw2[1]=PKW(P1,2), pw2); \
    VRD(6); SBAR(); GAPA(C1=__builtin_amdgcn_mfma_f32_32x32x16_bf16(kf[5],qr[2],C1,0,0,0),   P1[6],P1[7],P1[8],P1[9],     pw2[2]=PKW(P1,4), pw2[3]=PKW(P1,6), pw2); \
    VRD(3); SBAR(); GAPA(C0=__builtin_amdgcn_mfma_f32_32x32x16_bf16(kf[6],qr[3],C0,0,0,0),   P1[10],P1[11],P1[12],P1[13], pw3[0]=PKW(P1,8), pw3[1]=PKW(P1,10), pw3); \
    VRD(7); SBAR(); GAPA(C1=__builtin_amdgcn_mfma_f32_32x32x16_bf16(kf[7],qr[3],C1,0,0,0),   P1[14],P1[15],0.f,0.f,       pw3[2]=PKW(P1,12),pw3[3]=PKW(P1,14), pw3); \
    l_reg+=sacc; \
    if(GK){DMA_K((t)+3,sl_cur);} if(GV){DMA_V((t)+1,sl_next);} \
    BIAS(C0,C1,t); CMASK(C0,C1,t); \
    SBAR(); \
    GAPB(o[0]=__builtin_amdgcn_mfma_f32_32x32x16_bf16(PAF(0),VFR(0),o[0],0,0,0), C0,0); \
    GAPB(o[1]=__builtin_amdgcn_mfma_f32_32x32x16_bf16(PAF(0),VFR(4),o[1],0,0,0), C0,4); \
    KRD(GL,0); GAPB(o[0]=__builtin_amdgcn_mfma_f32_32x32x16_bf16(PAF(1),VFR(1),o[0],0,0,0), C0,8); \
    KRD(GL,1); GAPB(o[1]=__builtin_amdgcn_mfma_f32_32x32x16_bf16(PAF(1),VFR(5),o[1],0,0,0), C0,12); \
    KRD(GL,2); GAPB(o[0]=__builtin_amdgcn_mfma_f32_32x32x16_bf16(PAF(2),VFR(2),o[0],0,0,0), C1,0); \
    KRD(GL,3); GAPB(o[1]=__builtin_amdgcn_mfma_f32_32x32x16_bf16(PAF(2),VFR(6),o[1],0,0,0), C1,4); \
    GAPB(o[0]=__builtin_amdgcn_mfma_f32_32x32x16_bf16(PAF(3),VFR(3),o[0],0,0,0), C1,8); \
    GAPB(o[1]=__builtin_amdgcn_mfma_f32_32x32x16_bf16(PAF(3),VFR(7),o[1],0,0,0), C1,12); \
    }while(0)
  int t=1;
  #undef CMASK
  #define CMASK(P0,P1,t) do{}while(0)
  for(;t+5<NT;t+=2){
    STEP(pB0,pB1,pA0,pA1,t,true,true,true);     WAIT_BAR(2); RESC(); ROT();
    STEP(pA0,pA1,pB0,pB1,t+1,true,true,true);   WAIT_BAR(2); RESC(); ROT();
  }
  #undef CMASK
  #define CMASK(P0,P1,t) do{int jb_=(t)-(NT-4); if(jb_>=0)cmask(P0,P1,jb_,qrel,hi);}while(0)
  #define ENDW(tt) do{ if((tt)+3<NT){WAIT_BAR(2);} else if((tt)+2<NT){WAIT_BAR(1);} else {WAIT_BAR(0);} }while(0)
  for(;t+1<NT;t+=2){
    STEP(pB0,pB1,pA0,pA1,t,(t+3<NT),(t+1<NT),(t+1<NT));       ENDW(t);   RESC(); ROT();
    STEP(pA0,pA1,pB0,pB1,t+1,(t+4<NT),(t+2<NT),(t+2<NT));     ENDW(t+1); RESC(); ROT();
  }
  STEP(pB0,pB1,pA0,pA1,NT-1,false,false,false); RESC();
  { float sacc=pB0[0]+pB0[1]; _Pragma("unroll") for(int r=2;r<16;++r)sacc+=pB0[r]; _Pragma("unroll") for(int r=0;r<16;++r)sacc+=pB1[r]; l_reg+=sacc;
    pw0=(u32x4){PKW(pB0,0),PKW(pB0,2),PKW(pB0,4),PKW(pB0,6)};pw1=(u32x4){PKW(pB0,8),PKW(pB0,10),PKW(pB0,12),PKW(pB0,14)};pw2=(u32x4){PKW(pB1,0),PKW(pB1,2),PKW(pB1,4),PKW(pB1,6)};pw3=(u32x4){PKW(pB1,8),PKW(pB1,10),PKW(pB1,12),PKW(pB1,14)};
    SBAR(); pv(o,vb0+sl_cur,PAF(0),PAF(1),PAF(2),PAF(3)); }
  #undef PKW
  #undef PAF
  #undef VFR
  #undef PIN
  #undef MX3
  #undef GAPA
  #undef GAPB
  #undef EX
  #undef VRD
  #undef KRD
  #undef STEP
  #undef ENDW
  {auto rr=__builtin_amdgcn_permlane32_swap(__float_as_uint(l_reg),__float_as_uint(l_reg),false,false);l_reg=__uint_as_float(rr[0])+__uint_as_float(rr[1]);}
  {
    int tid2=threadIdx.x; asm volatile("":"+v"(tid2)); const int lane2=tid2&63,r32b=lane2&31,hib=lane2>>5; const int wid2=__builtin_amdgcn_readfirstlane(tid2>>6);
    float*wsf2=(float*)(shm+LDS_WS)+wid2*64;
    if(hib==0)wsf2[32+r32b]=l_reg;asm volatile("s_waitcnt lgkmcnt(0)":::"memory");
    float rli[16];
    #pragma unroll
    for(int r=0;r<16;++r)rli[r]=__builtin_amdgcn_rcpf(wsf2[32+crow(r,hib)]);
    bf16*Ow=O+((long)b*SEQ+qb*QB+wid2*QBLK)*DMO+h*D;
    bf16*stg=(bf16*)(shm+LDS_OST)+wid2*2048;
    #pragma unroll
    for(int r=0;r<16;++r){const int orow=crow(r,hib);
      #pragma unroll
      for(int d0=0;d0<2;++d0)stg[orow*64+d0*32+r32b]=__float2bfloat16(o[d0][r]*rli[r]);}
    asm volatile("s_waitcnt lgkmcnt(0)":::"memory");
    #pragma unroll
    for(int i=0;i<4;++i){const int row=i*8+(lane2>>3),ch=lane2&7; const u32x4 v=*(const u32x4*)(stg+row*64+ch*8); ATTN_STORE16(Ow+(long)row*DMO+ch*8,v);} }
  asm volatile("s_waitcnt lgkmcnt(0)\n\ts_barrier":::"memory");
  #undef DMA_K
  #undef DMA_V
  #undef CMASK
  #undef START
  #undef RESC
  #undef ROT
}
constexpr int ATTN_LDS_BYTES=LDS_BYTES;
struct AttnTensors { const bf16* Q; const bf16* K; const bf16* V; bf16* O; const float* Fneg; };
struct AttnUnit { int bh; int qb; };
struct StaticOrder {
  int vcu;
  __device__ __forceinline__ explicit StaticOrder(int grid,int block):vcu((block%8)*(grid/8)+block/8){}
  __device__ __forceinline__ bool next(int i,AttnUnit&u)const{ if(i>=2||vcu>=256)return false; const int s=vcu&3; u.bh=vcu>>2; u.qb=(i==0)?s:7-s; return true; }
  __device__ __forceinline__ void a_ready(const AttnUnit&)const{}
  __device__ __forceinline__ void done(const AttnUnit&)const{}
};
template<class Sched,int THRL=8> __device__ __forceinline__ void attn_phase(char*lds,const AttnTensors&T,const Sched&S){
  AttnUnit u;
  for(int i=0;S.next(i,u);++i){ S.a_ready(u); attn_unit<THRL>(u.bh/NHEAD,u.bh%NHEAD,u.qb,T.Q,T.K,T.V,T.O,T.Fneg+(long)u.bh*SEQ,lds); S.done(u); }
}
#undef SBAR
#undef WAIT_BAR
}
#define GAS __attribute__((address_space(1)))
#define LAS __attribute__((address_space(3)))
typedef unsigned short bf16;
typedef unsigned v4u __attribute__((ext_vector_type(4)));
typedef float f32x4 __attribute__((ext_vector_type(4)));
typedef short bf16x8 __attribute__((ext_vector_type(8)));
typedef GAS unsigned gu32;
typedef GAS unsigned long long gu64;
#define RLX_AGENT __ATOMIC_RELAXED, __HIP_MEMORY_SCOPE_AGENT
#define LDS_WAIT() asm volatile("s_waitcnt lgkmcnt(0)" ::: "memory")
#define VM_WAIT() asm volatile("s_waitcnt vmcnt(0)" ::: "memory")
__device__ __forceinline__ unsigned long long rt() { return __builtin_amdgcn_s_memrealtime(); }
__device__ __forceinline__ unsigned f2bf(float f) { unsigned u = __builtin_bit_cast(unsigned, f); return (u + 0x7fffu + ((u >> 16) & 1u)) >> 16; }
__device__ __forceinline__ unsigned pk2(float lo, float hi) { return f2bf(lo) | (f2bf(hi) << 16); }

#define XB_TMO      128
#define XB_XCNT(j)  (256  + 64 * (j))
#define XB_XSUB(j)  (1280 + 64 * (j))
#define XB_XGEN(j)  (2304 + 64 * (j))
#define XB_TOP      3328
#define XB_TOPGEN   3392
#define XCD_BAR_WORDS 3456
#define XB_SPIN_CAP (1u << 18)

__device__ __forceinline__ unsigned xb_ld(unsigned* p)              { return __hip_atomic_load(p, __ATOMIC_RELAXED, __HIP_MEMORY_SCOPE_AGENT); }
__device__ __forceinline__ unsigned xb_add(unsigned* p, unsigned v) { return __hip_atomic_fetch_add(p, v, __ATOMIC_RELAXED, __HIP_MEMORY_SCOPE_AGENT); }
__device__ __forceinline__ unsigned xb_xcc_id() { return (unsigned)__builtin_amdgcn_s_getreg((3 << 11) | 20) & 0xFu; }
#define XB_SPIN(cond, bar) do { unsigned _sp = 0; while (cond) { __builtin_amdgcn_s_sleep(1); \
    if ((++_sp & 255u) == 0u) { if (xb_ld(&(bar)[XB_TMO])) break; if (_sp > XB_SPIN_CAP) { atomicAdd(&(bar)[XB_TMO], 1u); break; } } } } while (0)

struct XcdBarrier {
    unsigned* bar; unsigned x;
    volatile LAS unsigned* st;
};

__device__ __forceinline__ XcdBarrier xcd_barrier_post(unsigned* bar, volatile LAS unsigned* st) {
    XcdBarrier b; b.bar = bar; b.x = xb_xcc_id(); b.st = st;
    if (threadIdx.x == 0) (void)xb_add(&bar[XB_XCNT(b.x)], 1u);
    return b;
}
__device__ __forceinline__ void xcd_barrier_complete(unsigned* bar, unsigned x, unsigned& nloc, unsigned& nx) {
    const unsigned G = gridDim.x * gridDim.y * gridDim.z;
    unsigned sum, cnt, mine, sp = 0u;
    for (;;) {
        sum = 0u; cnt = 0u; mine = 0u;
#pragma unroll
        for (unsigned j = 0; j < 16; ++j) { const unsigned c = xb_ld(&bar[XB_XCNT(j)]); sum += c; cnt += (c > 0u) ? 1u : 0u; mine = (j == x) ? c : mine; }
        if (sum == G) break;
        __builtin_amdgcn_s_sleep(1);
        if ((++sp & 255u) == 0u) { if (xb_ld(&bar[XB_TMO])) break; if (sp > XB_SPIN_CAP) { atomicAdd(&bar[XB_TMO], 1u); break; } }
    }
    nloc = mine > 0u ? mine : 1u; nx = cnt > 0u ? cnt : 1u;
}

__device__ __forceinline__ void xcd_barrier(const XcdBarrier& b) {
    asm volatile("s_waitcnt vmcnt(0)" ::: "memory");
    __syncthreads();
    if (threadIdx.x == 0) {
        unsigned* bar = b.bar;
        __builtin_amdgcn_s_waitcnt(0);
        unsigned nloc = b.st[0], nx = b.st[1];
        if (nloc == 0u) { xcd_barrier_complete(bar, b.x, nloc, nx); b.st[0] = nloc; b.st[1] = nx; }
        const unsigned old = xb_add(&bar[XB_XSUB(b.x)], 1u);
        const unsigned gen = old / nloc;
        if (old + 1u == (gen + 1u) * nloc) {
            __builtin_amdgcn_fence(__ATOMIC_RELEASE, "agent");
            asm volatile("s_waitcnt vmcnt(0)" ::: "memory");
            const unsigned og = xb_add(&bar[XB_TOP], 1u);
            const unsigned tg = og / nx;
            if (og + 1u == (tg + 1u) * nx) xb_add(&bar[XB_TOPGEN], 1u);
            else XB_SPIN(xb_ld(&bar[XB_TOPGEN]) == tg, bar);
            __builtin_amdgcn_fence(__ATOMIC_ACQUIRE, "agent");
            xb_add(&bar[XB_XGEN(b.x)], 1u);
            asm volatile("s_waitcnt vmcnt(0)" ::: "memory");
        } else {
            XB_SPIN(xb_ld(&bar[XB_XGEN(b.x)]) == gen, bar);
            __builtin_amdgcn_fence(__ATOMIC_ACQUIRE, "agent");
            asm volatile("s_waitcnt vmcnt(0)" ::: "memory");
        }
    }
    __syncthreads();
}

constexpr int NWAVES = 8;
constexpr int NB = 8, SEQ = 2048, M = NB * SEQ, D = 1024, NH = 8, DH = 64, FW = 512, PW = 512, INW = 2056, DFF = 2816, NE = 8;
constexpr int SG = 64, SGH = 16, SP = 64;
constexpr int CL = 32, NCH = SEQ / CL, NBC = NB * NCH, KA = 2 * SP + CL * SGH;
constexpr float EPS = 1e-6f, LOG2E = 1.4426950408889634f;
static_assert(KA == 640 && NBC == 512, "ssm chunk geometry");

constexpr size_t MiB = 1u << 20, KiB = 1024;
constexpr size_t WS_CTL = 0, CTL_ZERO_BYTES = 1 * MiB;
constexpr size_t WS_LOGF = 1 * MiB;
constexpr size_t WS_FNEG = WS_LOGF + 512 * KiB;
constexpr size_t WS_SSQ1 = 2 * MiB;
constexpr size_t WS_SSQ2 = WS_SSQ1 + 256 * KiB;
constexpr size_t WS_AL   = WS_SSQ2 + 256 * KiB;
constexpr size_t WS_TOKE = WS_AL + 64 * KiB;
constexpr size_t WS_GATE = WS_TOKE + 64 * KiB;
constexpr size_t WS_POS  = WS_GATE + 128 * KiB;
constexpr size_t WS_CNT  = WS_POS + 128 * KiB;
constexpr size_t WS_TAB  = WS_CNT + 16 * KiB;
constexpr size_t WS_TOKS = WS_TAB + 16 * KiB;
constexpr size_t WS_RS0  = 3 * MiB + 256 * KiB;
static_assert(WS_TOKS + (2 * M + 256) * 4 <= 4 * MiB, "small tables");
constexpr size_t WS_WIN0 = 4 * MiB;
constexpr size_t WS_WOT  = 8 * MiB;
constexpr size_t WS_W13  = 10 * MiB;
constexpr size_t WS_W2T  = 21 * MiB;
constexpr size_t WS_WIN1 = 27 * MiB;
constexpr size_t WS_WGLU = 29 * MiB;
constexpr size_t WS_W13E = 34 * MiB;
constexpr size_t WS_BT2  = 34 * MiB;
constexpr size_t WS_MG   = 74 * MiB;
constexpr size_t WS_YS   = 34 * MiB;
constexpr size_t WS_YP   = 70 * MiB;
constexpr size_t WS_W2E  = 122 * MiB;
constexpr size_t WS_R    = 166 * MiB;
constexpr size_t WS_H0   = WS_R;
constexpr size_t WS_QKVP = WS_R + 32 * MiB;
constexpr size_t WS_ACT0 = WS_R + 96 * MiB;
constexpr size_t WS_MIX  = WS_ACT0;
constexpr size_t WS_ACTS = WS_R + 32 * MiB;
constexpr size_t WS_H3   = 344 * MiB;
constexpr size_t WS_END  = 376 * MiB;
static_assert(WS_ACTS + (size_t)(2 * M + 256) * DFF <= WS_H3 && WS_ACT0 + (size_t)M * DFF * 2 <= WS_END && WS_W13E + (size_t)NE * 2 * DFF * D * 2 <= WS_W2E && WS_W2E + (size_t)NE * D * DFF * 2 <= WS_R, "d_ws map");
static_assert(WS_MG + (size_t)SG * 128 * 512 * 2 <= WS_W2E && WS_BT2 + (size_t)SG * 512 * KA * 2 <= WS_MG && WS_YS + (size_t)(2 * M + 256) * D * 2 <= WS_W2E, "d_ws map 2");
constexpr int CW_BAR = 4096;
constexpr int CW_W2E = 192;
constexpr int CW_RDY = 64;

constexpr int RING_OFF = 0, RING_BYTES = 131072;
constexpr int LDSCTL_OFF = RING_BYTES, MISC_OFF = LDSCTL_OFF + 320;
constexpr int LDS_BYTES = 147456;
static_assert(MISC_OFF + 128 <= LDS_BYTES && attn_body::ATTN_LDS_BYTES <= RING_BYTES, "LDS map");

struct Args { const float* in[30]; float* out; unsigned char* ws; int ph_lo, ph_hi; };
enum { I_X = 0, I_N0, I_WIN0, I_BF, I_WPOOL, I_PSCALE, I_WOUT, I_N1, I_W1, I_W3, I_W2, I_N2, I_WIN1, I_ARE, I_AIM, I_LOGDT, I_BRE, I_BIM, I_CRE, I_CIM, I_SD, I_GA, I_GB, I_N3, I_RW, I_RB, I_EW1, I_EW3, I_EW2, I_NF };

__device__ __forceinline__ float wave_sum(float v) {
#pragma unroll
    for (int o = 1; o < 64; o <<= 1) v += __shfl_xor(v, o);
    return v;
}
__device__ __forceinline__ void transpose_item(const float* W, int ldw, int k0, int c0, const float* gain, bf16* WT, int ldt, int drow0, LAS unsigned char* scr, int lane) {
    const int lr = lane >> 4, lc = lane & 15; f32x4 v[16];
    const GAS f32x4* src = (const GAS f32x4*)(W + (size_t)(k0 + lr) * ldw + c0) + lc;
#pragma unroll
    for (int i = 0; i < 16; ++i) v[i] = __builtin_nontemporal_load(src + (size_t)i * ldw);
    if (gain) {
#pragma unroll
        for (int i = 0; i < 16; ++i) v[i] = v[i] * gain[k0 + 4 * i + lr];
    }
#pragma unroll
    for (int i = 0; i < 16; ++i) { typedef unsigned u32x2v __attribute__((ext_vector_type(2))); u32x2v w; w.x = pk2(v[i].x, v[i].y); w.y = pk2(v[i].z, v[i].w);
        *(LAS u32x2v*)(scr + (4 * i + lr) * 136 + 8 * lc) = w; }
    LDS_WAIT(); asm volatile("" ::: "memory");
    const int c = lane & 7;
#pragma unroll
    for (int it = 0; it < 4; ++it) { const int np = (lane >> 3) + 8 * it; unsigned w[8];
#pragma unroll
        for (int j = 0; j < 8; ++j) w[j] = *(const LAS unsigned*)(scr + (8 * c + j) * 136 + 4 * np);
        v4u lo, hi;
        lo.x = (w[0] & 0xffffu) | (w[1] << 16); lo.y = (w[2] & 0xffffu) | (w[3] << 16); lo.z = (w[4] & 0xffffu) | (w[5] << 16); lo.w = (w[6] & 0xffffu) | (w[7] << 16);
        hi.x = (w[0] >> 16) | (w[1] & 0xffff0000u); hi.y = (w[2] >> 16) | (w[3] & 0xffff0000u); hi.z = (w[4] >> 16) | (w[5] & 0xffff0000u); hi.w = (w[6] >> 16) | (w[7] & 0xffff0000u);
        bf16* o = WT + (size_t)(drow0 + 2 * np) * ldt + k0 + 8 * c;
        *(GAS v4u*)o = lo; *(GAS v4u*)(o + ldt) = hi; }
    LDS_WAIT(); asm volatile("" ::: "memory");
}

__device__ __forceinline__ unsigned pk4_fp8(float a, float b, float c, float d) { int w = 0; w = __builtin_amdgcn_cvt_pk_fp8_f32(a, b, w, false); w = __builtin_amdgcn_cvt_pk_fp8_f32(c, d, w, true); return (unsigned)w; }
constexpr float W8_SCALE = 64.0f, W8_INV = 1.0f / 64.0f;
__device__ __forceinline__ void transpose_item_f8(const float* W, int ldw, int k0, int c0, float scale, unsigned char* WT, int ldt, int drow0, LAS unsigned char* scr, int lane) {
    const int lr = lane >> 4, lc = lane & 15; f32x4 v[32];
    const GAS f32x4* src = (const GAS f32x4*)(W + (size_t)(k0 + lr) * ldw + c0) + lc;
#pragma unroll
    for (int i = 0; i < 32; ++i) v[i] = __builtin_nontemporal_load(src + (size_t)i * ldw);
#pragma unroll
    for (int i = 0; i < 32; ++i) *(LAS unsigned*)(scr + (4 * i + lr) * 68 + 4 * lc) = pk4_fp8(v[i].x * scale, v[i].y * scale, v[i].z * scale, v[i].w * scale);
    LDS_WAIT(); asm volatile("" ::: "memory");
#pragma unroll
    for (int it = 0; it < 2; ++it) { const int nq = lane & 15, c = (lane >> 4) + 4 * it; unsigned d[16];
#pragma unroll
        for (int j = 0; j < 16; ++j) d[j] = *(const LAS unsigned*)(scr + (16 * c + j) * 68 + 4 * nq);
        v4u y[4];
#pragma unroll
        for (int q = 0; q < 4; ++q) { const unsigned x0 = d[4 * q], x1 = d[4 * q + 1], x2 = d[4 * q + 2], x3 = d[4 * q + 3];
            const unsigned t01l = __builtin_amdgcn_perm(x1, x0, 0x05010400u), t01h = __builtin_amdgcn_perm(x1, x0, 0x07030602u), t23l = __builtin_amdgcn_perm(x3, x2, 0x05010400u), t23h = __builtin_amdgcn_perm(x3, x2, 0x07030602u);
            y[0][q] = __builtin_amdgcn_perm(t23l, t01l, 0x05040100u); y[1][q] = __builtin_amdgcn_perm(t23l, t01l, 0x07060302u); y[2][q] = __builtin_amdgcn_perm(t23h, t01h, 0x05040100u); y[3][q] = __builtin_amdgcn_perm(t23h, t01h, 0x07060302u); }
        unsigned char* o = WT + (size_t)(drow0 + 4 * nq) * ldt + k0 + 16 * c;
#pragma unroll
        for (int b = 0; b < 4; ++b) *(GAS v4u*)(o + (size_t)b * ldt) = y[b]; }
    LDS_WAIT(); asm volatile("" ::: "memory");
}

struct PlainProb {
    static constexpr bool GATHER = false;
    const bf16* A; const bf16* Bt; int lda, ldb, ntk;
    __device__ __forceinline__ void ptrs(const pg8::Unit& u, const char*& a, const char*& b, int& nt) const { a = (const char*)A + (size_t)u.pm * 256 * lda; b = (const char*)Bt + (size_t)u.pn * 256 * ldb; nt = ntk; }
    __device__ __forceinline__ void gather(const pg8::Unit&, const int (&)[2], const int (&)[2], unsigned (&)[2][2]) const {}
};
struct SsmProb {
    static constexpr bool GATHER = false;
    const bf16* AG; const bf16* BT; int lda, ldb;
    __device__ __forceinline__ void ptrs(const pg8::Unit& u, const char*& a, const char*& b, int& nt) const {
        a = (const char*)(AG + ((size_t)u.x2 * NBC + (size_t)u.pm * 256) * KA); b = (const char*)(BT + ((size_t)u.x2 * 512 + (size_t)u.pn * 256) * KA); nt = 6 + 4 * u.pn; }
    __device__ __forceinline__ void gather(const pg8::Unit&, const int (&)[2], const int (&)[2], unsigned (&)[2][2]) const {}
};
struct SsmOrder {
    int vcu, G;
    __device__ __forceinline__ bool next(int i, pg8::Unit& u) const { const int L = i * G + vcu; if (L >= 256) return false; u.x2 = L >> 2; u.pm = (L >> 1) & 1; u.pn = L & 1; u.x0 = 0; u.x1 = 0; u.kq = -1; return true; }
};
struct MoeOrder : pg8::GridOrder {
    const unsigned* tab;
    __device__ __forceinline__ bool next(int i, pg8::Unit& u) const {
        if (!tile(i, u.pm, u.pn)) return false;
        u.kq = -1; int e = 0;
#pragma unroll
        for (int k = 1; k < NE; ++k) e += ((int)tab[16 + k] <= u.pm) ? 1 : 0;
        u.x2 = e; u.x0 = (int)tab[e] + 256 * (u.pm - (int)tab[16 + e]); u.x1 = (int)tab[e + 1]; return true;
    }
};
constexpr int YP_ROWS = 8 * 256 + 256, MAIN_TILES = 128;
struct MoeDownOrder {
    pg8::GridOrder G4; const unsigned* tab; int nM, G, c, nmain_c;
    __device__ __forceinline__ void init(const unsigned* tab_, int G_, int c_) { tab = tab_; nM = (int)tab[24]; G = G_; c = c_; const int nmt = nM < MAIN_TILES ? nM : MAIN_TILES; G4.init(nmt, D / 256, G_, c_); nmain_c = (G4.nwg - c_ + G_ - 1) / G_; if (nmain_c < 0) nmain_c = 0; }
    __device__ __forceinline__ bool next(int i, pg8::Unit& u) const {
        if (i < nmain_c) { if (!G4.tile(i, u.pm, u.pn)) return false; u.kq = -1; }
        else if (i == nmain_c) { const int nl = nM - MAIN_TILES; if (nl <= 0 || c >= 16 * nl) return false; u.pm = MAIN_TILES + c / 16; u.pn = (c >> 2) & 3; u.kq = c & 3; }
        else return false;
        int e = 0;
#pragma unroll
        for (int k = 1; k < NE; ++k) e += ((int)tab[16 + k] <= u.pm) ? 1 : 0;
        u.x2 = e; u.x0 = (int)tab[e] + 256 * (u.pm - (int)tab[16 + e]); u.x1 = (int)tab[e + 1]; return true;
    }
};
struct MoeUpProb {
    static constexpr bool GATHER = true;
    const unsigned char* H3; const unsigned char* W; const unsigned* toks; int lda, ldb;
    __device__ __forceinline__ void ptrs(const pg8::Unit& u, const char*& a, const char*& b, int& nt) const { a = (const char*)H3; b = (const char*)(W + ((size_t)u.x2 * (2 * DFF) + (size_t)u.pn * 256) * D); nt = D / 128; }
    __device__ __forceinline__ void gather(const pg8::Unit& u, const int (&pR)[2], const int (&pC)[2], unsigned (&V)[2][2]) const {
#pragma unroll
        for (int h = 0; h < 2; ++h)
#pragma unroll
            for (int i = 0; i < 2; ++i) V[h][i] = toks[u.x0 + 128 * h + pR[i]] * (unsigned)D + (unsigned)(pC[i] * 2);
    }
};
struct MoeDownProb {
    static constexpr bool GATHER = false;
    const unsigned char* ACTS; const unsigned char* W; int lda, ldb;
    __device__ __forceinline__ void ptrs(const pg8::Unit& u, const char*& a, const char*& b, int& nt) const { const int k0 = u.kq < 0 ? 0 : 6 * u.kq;
        a = (const char*)(ACTS + (size_t)u.x0 * DFF) + 128 * k0; b = (const char*)(W + ((size_t)u.x2 * D + (size_t)u.pn * 256) * DFF) + 128 * k0; nt = u.kq < 0 ? DFF / 128 : (u.kq == 3 ? 4 : 6); }
    __device__ __forceinline__ void gather(const pg8::Unit&, const int (&)[2], const int (&)[2], unsigned (&)[2][2]) const {}
};

using pg8::u32x4; using pg8::Unit; using pg8::cvt_pk_bf16;
#define ACC_T const pg8::f32x4 (&acc)[2][2][4][2]

struct EpiSplitBf16 {
    static constexpr bool PERM = true, AFTER_DRAIN = false;
    bf16* O; float scale0; const LAS float* RSL;
    __device__ __forceinline__ void operator()(ACC_T, const Unit& u, int wr, int wc, int fr, int fq) const {
        const int t = u.pn >> 1; bf16* base = O + (size_t)t * M * 512; const float sc0 = (t == 0) ? scale0 : 1.f;
        const int row0 = u.pm * 256 + wr * 64 + fr, col0 = (u.pn & 1) * 256 + wc * 32 + 8 * fq;
#pragma unroll
        for (int ai = 0; ai < 2; ++ai)
#pragma unroll
            for (int m = 0; m < 4; ++m) { bf16* rowp = base + (size_t)(row0 + ai * 128 + m * 16) * 512 + col0; const float sc = sc0 * RSL[u.x1 * 256 + ai * 128 + wr * 64 + m * 16 + fr];
#pragma unroll
                for (int bj = 0; bj < 2; ++bj) { const f32x4 v0 = acc[ai][bj][m][0] * sc, v1 = acc[ai][bj][m][1] * sc;
                    u32x4 w; w.x = cvt_pk_bf16(v0[0], v0[1]); w.y = cvt_pk_bf16(v0[2], v0[3]); w.z = cvt_pk_bf16(v1[0], v1[1]); w.w = cvt_pk_bf16(v1[2], v1[3]);
                    *(u32x4*)(rowp + bj * 128) = w; } }
    }
};
__device__ __forceinline__ f32x4 bf16x4_lo(u32x4 w) { return (f32x4){__uint_as_float(w.x << 16), __uint_as_float(w.x & 0xffff0000u), __uint_as_float(w.y << 16), __uint_as_float(w.y & 0xffff0000u)}; }
__device__ __forceinline__ f32x4 bf16x4_hi(u32x4 w) { return (f32x4){__uint_as_float(w.z << 16), __uint_as_float(w.z & 0xffff0000u), __uint_as_float(w.w << 16), __uint_as_float(w.w & 0xffff0000u)}; }
template <bool BASE_F32> struct EpiResid {
    static constexpr bool PERM = true, AFTER_DRAIN = true;
    const void* base; bf16* outb; float* ssq;
    __device__ __forceinline__ void fused(pg8::f32x4 (&acc)[2][2][4][2], const Unit& u, int wr, int wc, int fr, int fq, LAS unsigned char* lds, int wid, int lane) const {
        LAS float* Pq = (LAS float*)lds;
        const int col0 = u.pn * 256 + wc * 32 + 8 * fq;
#pragma unroll
        for (int ai = 0; ai < 2; ++ai)
#pragma unroll
            for (int m = 0; m < 4; ++m) { const int rl = ai * 128 + wr * 64 + m * 16 + fr; const size_t off = (size_t)(u.pm * 256 + rl) * D + col0; float s = 0.f;
#pragma unroll
                for (int bj = 0; bj < 2; ++bj) { f32x4 b0, b1;
                    if constexpr (BASE_F32) { const float* bp = (const float*)base + off + bj * 128; b0 = __builtin_nontemporal_load((const f32x4*)bp); b1 = __builtin_nontemporal_load((const f32x4*)(bp + 4)); }
                    else { const u32x4 bw = *(const u32x4*)((const bf16*)base + off + bj * 128); b0 = bf16x4_lo(bw); b1 = bf16x4_hi(bw); }
                    const f32x4 o0 = b0 + acc[ai][bj][m][0], o1 = b1 + acc[ai][bj][m][1];
                    u32x4 w; w.x = cvt_pk_bf16(o0[0], o0[1]); w.y = cvt_pk_bf16(o0[2], o0[3]); w.z = cvt_pk_bf16(o1[0], o1[1]); w.w = cvt_pk_bf16(o1[2], o1[3]);
                    *(u32x4*)(outb + off + bj * 128) = w;
                    s += ((o0[0] * o0[0] + o0[1] * o0[1]) + (o0[2] * o0[2] + o0[3] * o0[3])) + ((o1[0] * o1[0] + o1[1] * o1[1]) + (o1[2] * o1[2] + o1[3] * o1[3])); }
                s += __shfl_xor(s, 16); s += __shfl_xor(s, 32);
                if (fq == 0) Pq[rl * 4 + wc] = s;
                if (BASE_F32 && m == 3) asm volatile("" ::: "memory"); }
        asm volatile("s_waitcnt lgkmcnt(0)" ::: "memory"); __builtin_amdgcn_s_barrier(); asm volatile("" ::: "memory");
        const int tid = wid * 64 + lane;
        if (tid < 256) { const f32x4 p = *(const LAS f32x4*)(Pq + tid * 4); ssq[(size_t)(u.pm * 256 + tid) * 4 + u.pn] = (p[0] + p[1]) + (p[2] + p[3]); }
    }
};
constexpr int RS_OFF = RING_BYTES + 512, RS_SLOTS = 6;
static_assert(RS_OFF + RS_SLOTS * 256 * 4 <= LDS_BYTES, "rs table");
template <class Sched> __device__ __forceinline__ void fill_rs(LAS float* RSL, const float* ssq, const Sched& S, int tid) {
    for (int i0 = 0; i0 < RS_SLOTS; i0 += 2) { const int i = i0 + (tid >> 8); int pm, pn;
        if (S.tile(i, pm, pn)) { const f32x4 q = *(const f32x4*)(ssq + (size_t)(pm * 256 + (tid & 255)) * 4); RSL[i * 256 + (tid & 255)] = __builtin_amdgcn_rsqf(((q[0] + q[1]) + (q[2] + q[3])) * (1.0f / D) + EPS); } }
    __syncthreads();
}
template <class Sched> __device__ __forceinline__ void fill_rs_direct(LAS float* RSL, const float* rs, const Sched& S, int tid) {
    for (int i0 = 0; i0 < RS_SLOTS; i0 += 2) { const int i = i0 + (tid >> 8); int pm, pn; if (S.tile(i, pm, pn)) RSL[i * 256 + (tid & 255)] = rs[pm * 256 + (tid & 255)]; }
    __syncthreads();
}
constexpr int UT_OFF = RS_OFF + RS_SLOTS * 256 * 4, UT_MAX = 16;
static_assert(UT_OFF + UT_MAX * 32 <= LDS_BYTES, "unit table");
struct TableOrder {
    const LAS int* T;
    __device__ __forceinline__ bool next(int i, pg8::Unit& u) const {
        if (i >= UT_MAX) return false; const LAS int* t = T + i * 8;
        if (__builtin_amdgcn_readfirstlane(t[5]) == 0) return false;
        u.pm = __builtin_amdgcn_readfirstlane(t[0]); u.pn = __builtin_amdgcn_readfirstlane(t[1]); u.x0 = __builtin_amdgcn_readfirstlane(t[2]); u.x1 = __builtin_amdgcn_readfirstlane(t[3]); u.x2 = __builtin_amdgcn_readfirstlane(t[4]); u.kq = __builtin_amdgcn_readfirstlane(t[6]); return true;
    }
};
template <class Sched> __device__ __forceinline__ TableOrder build_units(LAS unsigned char* lds, const Sched& S, int tid) {
    LAS int* T = (LAS int*)(lds + UT_OFF);
    if (tid < UT_MAX) { pg8::Unit u; const bool ok = S.next(tid, u); T[tid * 8 + 0] = u.pm; T[tid * 8 + 1] = u.pn; T[tid * 8 + 2] = u.x0; T[tid * 8 + 3] = u.x1; T[tid * 8 + 4] = u.x2; T[tid * 8 + 5] = ok ? 1 : 0; T[tid * 8 + 6] = u.kq; }
    __syncthreads();
    return TableOrder{T};
}
__device__ __forceinline__ pg8::f32x2 swiglu_pk(pg8::f32x2 a, pg8::f32x2 b, float c1, float c2) {
    pg8::f32x2 t = a * c1; t.x = __builtin_amdgcn_exp2f(t.x); t.y = __builtin_amdgcn_exp2f(t.y);
    const pg8::f32x2 d = t + 1.0f; pg8::f32x2 r; r.x = __builtin_amdgcn_rcpf(d.x); r.y = __builtin_amdgcn_rcpf(d.y);
    return (a * b) * (r * c2);
}
struct EpiSwiglu {
    static constexpr bool PERM = true, AFTER_DRAIN = false;
    bf16* O; const LAS float* RSL;
    __device__ __forceinline__ void operator()(ACC_T, const Unit& u, int wr, int wc, int fr, int fq) const {
        const int col0 = u.pn * 128 + wc * 32 + 8 * fq;
#pragma unroll
        for (int ai = 0; ai < 2; ++ai)
#pragma unroll
            for (int m = 0; m < 4; ++m) { const int rl = ai * 128 + wr * 64 + m * 16 + fr, row = u.pm * 256 + rl; const float rs = RSL[u.x1 * 256 + rl];
                const f32x4 a0 = acc[ai][0][m][0], a1 = acc[ai][0][m][1], b0 = acc[ai][1][m][0], b1 = acc[ai][1][m][1]; const float c1 = -LOG2E * rs, c2 = rs * rs;
                const pg8::f32x2 v0 = swiglu_pk((pg8::f32x2){a0[0], a0[1]}, (pg8::f32x2){b0[0], b0[1]}, c1, c2), v1 = swiglu_pk((pg8::f32x2){a0[2], a0[3]}, (pg8::f32x2){b0[2], b0[3]}, c1, c2);
                const pg8::f32x2 v2 = swiglu_pk((pg8::f32x2){a1[0], a1[1]}, (pg8::f32x2){b1[0], b1[1]}, c1, c2), v3 = swiglu_pk((pg8::f32x2){a1[2], a1[3]}, (pg8::f32x2){b1[2], b1[3]}, c1, c2);
                u32x4 w; w.x = cvt_pk_bf16(v0.x, v0.y); w.y = cvt_pk_bf16(v1.x, v1.y); w.z = cvt_pk_bf16(v2.x, v2.y); w.w = cvt_pk_bf16(v3.x, v3.y);
                *(u32x4*)(O + (size_t)row * DFF + col0) = w; }
    }
};
struct EpiSsmU {
    static constexpr bool PERM = true, AFTER_DRAIN = false;
    bf16* AG; const LAS float* RSL;
    __device__ __forceinline__ void operator()(ACC_T, const Unit& u, int wr, int wc, int fr, int fq) const {
#pragma unroll
        for (int ai = 0; ai < 2; ++ai)
#pragma unroll
            for (int m = 0; m < 4; ++m) { const int rl = ai * 128 + wr * 64 + m * 16 + fr, row = u.pm * 256 + rl; const float rs = RSL[u.x1 * 256 + rl]; const int bc = row >> 5, l = row & 31;
#pragma unroll
                for (int bj = 0; bj < 2; ++bj) { const int c0 = u.pn * 256 + bj * 128 + wc * 32 + 8 * fq, g = c0 >> 4, h0 = c0 & 15; const f32x4 v0 = acc[ai][bj][m][0] * rs, v1 = acc[ai][bj][m][1] * rs;
                    u32x4 w; w.x = cvt_pk_bf16(v0[0], v0[1]); w.y = cvt_pk_bf16(v0[2], v0[3]); w.z = cvt_pk_bf16(v1[0], v1[1]); w.w = cvt_pk_bf16(v1[2], v1[3]);
                    *(u32x4*)(AG + ((size_t)g * NBC + bc) * KA + 2 * SP + l * SGH + h0) = w; } }
    }
};
struct EpiGelu {
    static constexpr bool PERM = true, AFTER_DRAIN = false;
    bf16* GB;
    __device__ __forceinline__ void operator()(ACC_T, const Unit& u, int wr, int wc, int fr, int fq) const {
#pragma unroll
        for (int ai = 0; ai < 2; ++ai)
#pragma unroll
            for (int m = 0; m < 4; ++m) { const int bc = u.pm * 256 + ai * 128 + wr * 64 + m * 16 + fr;
#pragma unroll
                for (int bj = 0; bj < 2; ++bj) { const int n0 = u.pn * 256 + bj * 128 + wc * 32 + 8 * fq, l = n0 >> 4, h0 = n0 & 15; const f32x4 v0 = acc[ai][bj][m][0], v1 = acc[ai][bj][m][1];
                    u32x4 w; w.x = cvt_pk_bf16(pg8::gelu_tanh(v0[0]), pg8::gelu_tanh(v0[1])); w.y = cvt_pk_bf16(pg8::gelu_tanh(v0[2]), pg8::gelu_tanh(v0[3]));
                    w.z = cvt_pk_bf16(pg8::gelu_tanh(v1[0]), pg8::gelu_tanh(v1[1])); w.w = cvt_pk_bf16(pg8::gelu_tanh(v1[2]), pg8::gelu_tanh(v1[3]));
                    *(u32x4*)(GB + ((size_t)bc * CL + l) * D + u.x2 * SGH + h0) = w; } }
    }
};
struct EpiGlu {
    static constexpr bool PERM = true, AFTER_DRAIN = false;
    bf16* X;
    __device__ __forceinline__ void operator()(ACC_T, const Unit& u, int wr, int wc, int fr, int fq) const {
        const int col0 = u.pn * 128 + wc * 32 + 8 * fq;
#pragma unroll
        for (int ai = 0; ai < 2; ++ai)
#pragma unroll
            for (int m = 0; m < 4; ++m) { bf16* pp = X + (size_t)(u.pm * 256 + ai * 128 + wr * 64 + m * 16 + fr) * D + col0; const u32x4 xw = *(const u32x4*)pp;
                f32x4 o0 = bf16x4_lo(xw), o1 = bf16x4_hi(xw); const f32x4 a0 = acc[ai][0][m][0], a1 = acc[ai][0][m][1], b0 = acc[ai][1][m][0], b1 = acc[ai][1][m][1];
#pragma unroll
                for (int i = 0; i < 4; ++i) { o0[i] += a0[i] * pg8::fast_sigmoid(b0[i]); o1[i] += a1[i] * pg8::fast_sigmoid(b1[i]); }
                u32x4 w; w.x = cvt_pk_bf16(o0[0], o0[1]); w.y = cvt_pk_bf16(o0[2], o0[3]); w.z = cvt_pk_bf16(o1[0], o1[1]); w.w = cvt_pk_bf16(o1[2], o1[3]);
                *(u32x4*)pp = w; }
    }
};
struct EpiSwigluF8 {
    static constexpr bool PERM = true, AFTER_DRAIN = false;
    unsigned char* O;
    __device__ __forceinline__ void operator()(ACC_T, const Unit& u, int wr, int wc, int fr, int fq) const {
        const int col0 = u.pn * 128 + wc * 32 + 8 * fq;
#pragma unroll
        for (int ai = 0; ai < 2; ++ai)
#pragma unroll
            for (int m = 0; m < 4; ++m) { const int row = u.x0 + ai * 128 + wr * 64 + m * 16 + fr;
                const f32x4 a0 = acc[ai][0][m][0], a1 = acc[ai][0][m][1], b0 = acc[ai][1][m][0], b1 = acc[ai][1][m][1]; constexpr float c1 = -LOG2E * W8_INV, c2 = W8_INV * W8_INV;
                const pg8::f32x2 v0 = swiglu_pk((pg8::f32x2){a0[0], a0[1]}, (pg8::f32x2){b0[0], b0[1]}, c1, c2), v1 = swiglu_pk((pg8::f32x2){a0[2], a0[3]}, (pg8::f32x2){b0[2], b0[3]}, c1, c2);
                const pg8::f32x2 v2 = swiglu_pk((pg8::f32x2){a1[0], a1[1]}, (pg8::f32x2){b1[0], b1[1]}, c1, c2), v3 = swiglu_pk((pg8::f32x2){a1[2], a1[3]}, (pg8::f32x2){b1[2], b1[3]}, c1, c2);
                pg8::u32x2 w; w.x = pk4_fp8(v0.x, v0.y, v1.x, v1.y); w.y = pk4_fp8(v2.x, v2.y, v3.x, v3.y);
                if (row < u.x1) *(pg8::u32x2*)(O + (size_t)row * DFF + col0) = w; }
    }
};
struct EpiMaskF8 {
    static constexpr bool PERM = true, AFTER_DRAIN = false;
    unsigned char* Y; unsigned char* YP; int rowL;
    __device__ __forceinline__ void operator()(ACC_T, const Unit& u, int wr, int wc, int fr, int fq) const {
#pragma unroll
        for (int ai = 0; ai < 2; ++ai)
#pragma unroll
            for (int m = 0; m < 4; ++m) { const int row = u.x0 + ai * 128 + wr * 64 + m * 16 + fr;
                unsigned char* dst = (u.kq <= 0) ? Y + (size_t)row * D : YP + ((size_t)(u.kq - 1) * YP_ROWS + (size_t)(row - rowL)) * D;
#pragma unroll
                for (int bj = 0; bj < 2; ++bj) { const f32x4 v0 = acc[ai][bj][m][0] * W8_INV, v1 = acc[ai][bj][m][1] * W8_INV;
                    pg8::u32x2 w; w.x = pk4_fp8(v0[0], v0[1], v0[2], v0[3]); w.y = pk4_fp8(v1[0], v1[1], v1[2], v1[3]);
                    if (row < u.x1) *(pg8::u32x2*)(dst + u.pn * 256 + bj * 128 + wc * 32 + 8 * fq) = w; } }
    }
};

struct Frame {
    LAS unsigned char* lds; volatile LAS unsigned* MISC; gu32* ctl;
    int tid, lane, wave, vcu, G;
    const float* const __attribute__((address_space(4)))* in;
    float* out; unsigned char* ws;
};
#define WSP(T, off) ((T*)(F.ws + (off)))

__device__ __forceinline__ void tr_job(const float* W, int ldw, int ncb, int cbase, const float* gain, bf16* WT, int ldt, int mode, int rowoff, int item, LAS unsigned char* scr, int lane) {
    const int kb = item / ncb, nb = item % ncb, n0 = 64 * nb;
    const int drow0 = (mode == 0) ? rowoff + n0 : (n0 >> 7) * 256 + (n0 & 127) + rowoff;
    transpose_item(W, ldw, 64 * kb, cbase + n0, gain, WT, ldt, drow0, scr, lane);
}

__device__ __forceinline__ void tr_job_f8(const float* W, int ldw, int ncb, unsigned char* WT, int ldt, int mode, int rowoff, int item, LAS unsigned char* scr, int lane) {
    const int kb = item / ncb, nb = item % ncb, n0 = 64 * nb;
    const int drow0 = (mode == 0) ? rowoff + n0 : (n0 >> 7) * 256 + (n0 & 127) + rowoff;
    transpose_item_f8(W, ldw, 128 * kb, n0, W8_SCALE, WT, ldt, drow0, scr, lane);
}

__device__ __forceinline__ void ssm_prep_job(Frame& F, int g, int q, bool fresh = true) {
    LAS float* PWR = (LAS float*)(F.lds + RING_OFF);
    LAS float* PWI = PWR + 33 * 64;
    LAS float* BBR = PWI + 33 * 64;
    LAS float* BBI = BBR + 1024;
    LAS float* CR = BBI + 1024;
    LAS float* CI = CR + 1024;
    LAS float* KT = CI + 1024;
    LAS float* COEF = KT + 2048;
    const int tid = F.tid;
    const float* are = F.in[I_ARE]; const float* aim = F.in[I_AIM]; const float* logdt = F.in[I_LOGDT];
    if (fresh) {
    float pbr[2], pbi[2], pcr[2], pci[2];
#pragma unroll
    for (int it = 0; it < 2; ++it) { const int i = tid + 512 * it; pbr[it] = F.in[I_BRE][g * 1024 + i]; pbi[it] = F.in[I_BIM][g * 1024 + i]; pcr[it] = F.in[I_CRE][g * 1024 + i]; pci[it] = F.in[I_CIM][g * 1024 + i]; }
    if (tid < 64) {
        const int p = tid; const float dt = expf(logdt[g]); const float ar = are[g * SP + p], ai = aim[g * SP + p];
        const float mag = expf(ar * dt), th = ai * dt; const float abr = mag * cosf(th), abi = mag * sinf(th);
        const float sh = sinf(0.5f * th); const float nr = expm1f(ar * dt) - 2.0f * mag * sh * sh, ni = abi;
        const float den = ar * ar + ai * ai;
        COEF[2 * p] = (nr * ar + ni * ai) / den; COEF[2 * p + 1] = (ni * ar - nr * ai) / den;
        float pr = 1.0f, pi = 0.0f;
        for (int t = 0; t <= CL; ++t) { PWR[t * 64 + p] = pr; PWI[t * 64 + p] = pi; const float nr2 = pr * abr - pi * abi, ni2 = pr * abi + pi * abr; pr = nr2; pi = ni2; }
        if (q == 0) { float* AL = WSP(float, WS_AL); AL[(g * SP + p) * 2] = PWR[CL * 64 + p]; AL[(g * SP + p) * 2 + 1] = PWI[CL * 64 + p]; }
    }
    __syncthreads();
#pragma unroll
    for (int it = 0; it < 2; ++it) { const int i = tid + 512 * it, p = i >> 4; const float cr = COEF[2 * p], ci = COEF[2 * p + 1];
        BBR[i] = cr * pbr[it] - ci * pbi[it]; BBI[i] = cr * pbi[it] + ci * pbr[it]; CR[i] = pcr[it]; CI[i] = pci[it]; }
    __syncthreads();
    }
    { const int tl = tid >> 6, h = (tid >> 2) & 15, pq = tid & 3, tau = 8 * q + tl; float a[16];
#pragma unroll
        for (int i = 0; i < 16; ++i) a[i] = 0.f;
#pragma unroll 4
        for (int pp = 0; pp < 16; ++pp) { const int p = 16 * pq + pp; const float cr = CR[h * 64 + p], ci = CI[h * 64 + p], pr = PWR[tau * 64 + p], pi = PWI[tau * 64 + p];
            const float zr = cr * pr - ci * pi, zi = cr * pi + ci * pr;
#pragma unroll
            for (int i4 = 0; i4 < 4; ++i4) { const f32x4 br = *(const LAS f32x4*)(BBR + p * 16 + 4 * i4), bi = *(const LAS f32x4*)(BBI + p * 16 + 4 * i4);
                a[4 * i4] += zr * br.x - zi * bi.x; a[4 * i4 + 1] += zr * br.y - zi * bi.y; a[4 * i4 + 2] += zr * br.z - zi * bi.z; a[4 * i4 + 3] += zr * br.w - zi * bi.w; } }
#pragma unroll
        for (int i = 0; i < 16; ++i) { a[i] += __shfl_xor(a[i], 1); a[i] += __shfl_xor(a[i], 2); }
        f32x4 o;
        o.x = pq == 0 ? a[0] : pq == 1 ? a[4] : pq == 2 ? a[8] : a[12]; o.y = pq == 0 ? a[1] : pq == 1 ? a[5] : pq == 2 ? a[9] : a[13];
        o.z = pq == 0 ? a[2] : pq == 1 ? a[6] : pq == 2 ? a[10] : a[14]; o.w = pq == 0 ? a[3] : pq == 1 ? a[7] : pq == 2 ? a[11] : a[15];
        if (tau == 0 && (h >> 2) == pq) { const float dv = F.in[I_SD][g * SGH + h]; if ((h & 3) == 0) o.x += dv; else if ((h & 3) == 1) o.y += dv; else if ((h & 3) == 2) o.z += dv; else o.w += dv; }
        *(LAS f32x4*)(KT + tl * 256 + h * 16 + 4 * pq) = o; }
    __syncthreads();
    bf16* BT = WSP(bf16, WS_BT2) + (size_t)g * 512 * KA; bf16* MG = WSP(bf16, WS_MG) + (size_t)g * 128 * 512;
    for (int it = tid; it < 8192; it += 512) { const int half = it & 1, h = (it >> 1) & 15, tl = (it >> 5) & 7, l = it >> 8, l2 = l - (8 * q + tl);
        if (l2 >= 0) { const LAS float* s = KT + tl * 256 + h * 16 + 8 * half; v4u o; o.x = pk2(s[0], s[1]); o.y = pk2(s[2], s[3]); o.z = pk2(s[4], s[5]); o.w = pk2(s[6], s[7]);
            *(GAS v4u*)(BT + (size_t)(16 * l + h) * KA + 128 + 16 * l2 + 8 * half) = o; } }
    for (int it = tid; it < 16384; it += 512) { const int half = it & 1, h = (it >> 1) & 15, dl = (it >> 5) & 15, l = it >> 9, l2 = l + dl;
        if (dl >= 1 && (dl & 3) == q && l2 <= 16 * (l >> 4) + 15) *(GAS v4u*)(BT + (size_t)(16 * l + h) * KA + 128 + 16 * l2 + 8 * half) = (v4u){0u, 0u, 0u, 0u}; }
    for (int it = tid; it < 2048; it += 512) { const int pc = it & 7, part = (it >> 3) & 1, h = (it >> 4) & 15, l = 8 * q + (it >> 8); float v[8];
#pragma unroll
        for (int j = 0; j < 8; ++j) { const int p = 8 * pc + j; const float cr = CR[h * 64 + p], ci = CI[h * 64 + p], pr = PWR[(l + 1) * 64 + p], pi = PWI[(l + 1) * 64 + p];
            v[j] = part == 0 ? (cr * pr - ci * pi) : -(cr * pi + ci * pr); }
        v4u o; o.x = pk2(v[0], v[1]); o.y = pk2(v[2], v[3]); o.z = pk2(v[4], v[5]); o.w = pk2(v[6], v[7]);
        *(GAS v4u*)(BT + (size_t)(16 * l + h) * KA + 64 * part + 8 * pc) = o; }
    for (int it = tid; it < 2048; it += 512) { const int half = it & 1, ll = (it >> 1) & 7, p = (it >> 4) & 63, part = it >> 10, l2 = 8 * q + ll; float v[8];
        const float pr = PWR[(CL - 1 - l2) * 64 + p], pi = PWI[(CL - 1 - l2) * 64 + p];
#pragma unroll
        for (int j = 0; j < 8; ++j) { const float br = BBR[p * 16 + 8 * half + j], bi = BBI[p * 16 + 8 * half + j]; v[j] = part == 0 ? (pr * br - pi * bi) : (pr * bi + pi * br); }
        v4u o; o.x = pk2(v[0], v[1]); o.y = pk2(v[2], v[3]); o.z = pk2(v[4], v[5]); o.w = pk2(v[6], v[7]);
        *(GAS v4u*)(MG + (size_t)(part * 64 + p) * 512 + 16 * l2 + 8 * half) = o; }
    __syncthreads();
}


__device__ __forceinline__ float reduce8(const float (&d)[8], int lane) {
    const bool b5 = lane & 32, b4 = lane & 16, b3 = lane & 8; float a[4], b[2];
#pragma unroll
    for (int i = 0; i < 4; ++i) { const float keep = b5 ? d[4 + i] : d[i], send = b5 ? d[i] : d[4 + i]; a[i] = keep + __shfl_xor(send, 32); }
#pragma unroll
    for (int i = 0; i < 2; ++i) { const float keep = b4 ? a[2 + i] : a[i], send = b4 ? a[i] : a[2 + i]; b[i] = keep + __shfl_xor(send, 16); }
    float c = (b3 ? b[1] : b[0]) + __shfl_xor(b3 ? b[0] : b[1], 8);
    c += __shfl_xor(c, 4); c += __shfl_xor(c, 2); c += __shfl_xor(c, 1);
    return c;
}
__device__ __forceinline__ void fill_w8(LAS float* WL, const float* W, int ldw, const float* gain, int tid) {
#pragma unroll
    for (int it = 0; it < 16; ++it) { const int idx = tid + 512 * it, k = idx >> 3, e = idx & 7; const float v = W[(size_t)k * ldw + e] * gain[k];
        WL[((((k >> 8) * 4 + (k & 3)) * 64 + ((k >> 2) & 63)) << 3) + e] = v; }
}
__device__ __forceinline__ void row_dots(const f32x4 (&v)[4], const LAS float* WL, int lane, float& rs, float& red) {
    float s = 0.f, dot[8];
#pragma unroll
    for (int e = 0; e < 8; ++e) dot[e] = 0.f;
#pragma unroll
    for (int j = 0; j < 4; ++j) { s += (v[j].x * v[j].x + v[j].y * v[j].y) + (v[j].z * v[j].z + v[j].w * v[j].w);
#pragma unroll
        for (int i = 0; i < 4; ++i) { const LAS f32x4* wp = (const LAS f32x4*)(WL + (((j * 4 + i) * 64 + lane) << 3)); const f32x4 w0 = wp[0], w1 = wp[1]; const float xv = v[j][i];
            dot[0] += xv * w0.x; dot[1] += xv * w0.y; dot[2] += xv * w0.z; dot[3] += xv * w0.w; dot[4] += xv * w1.x; dot[5] += xv * w1.y; dot[6] += xv * w1.z; dot[7] += xv * w1.w; } }
    rs = 1.0f / sqrtf(wave_sum(s) * (1.0f / D) + EPS);
    red = reduce8(dot, lane) * rs;
}

__device__ __forceinline__ void p0_prologue(Frame& F) {
    const int gw = F.vcu * NWAVES + F.wave, NGW = F.G * NWAVES;
#ifndef P0_REP_SSM
#define P0_REP_SSM 1
#define P0_REP_TR 1
#define P0_REP_FOLD 1
#define P0_REP_ROWS 1
#endif
#ifndef SSM_IN_P4
#define SSM_IN_P4 1
#endif
    if (!SSM_IN_P4 && (F.vcu & 1) == 0) {
    for (int rep = 0; rep < P0_REP_SSM; ++rep)
    for (int job = F.vcu; job < 4 * SG; job += F.G) ssm_prep_job(F, job >> 2, job & 3);
    }
    {
    LAS float* WFG = (LAS float*)(F.lds + RING_OFF + 98304);
    fill_w8(WFG, F.in[I_WIN0] + 3 * FW, INW, F.in[I_N0], F.tid);
    __syncthreads();
    LAS unsigned char* scr = F.lds + RING_OFF + F.wave * 8704;
    {
        constexpr int J1 = 16 * 24, J2 = 16 * 8, J3 = 8 * 16, J4 = 16 * 44, J5 = J4, J6 = 44 * 16, J7 = 16 * 16, J8 = J7, J9 = J7, NJ = J1 + J2 + J3 + J4 + J5 + J6 + J7 + J8 + J9;
        for (int rep = 0; rep < P0_REP_TR; ++rep)
        for (int it = gw; it < NJ; it += NGW) {
            int r = it;
            if (r < J1) { tr_job(F.in[I_WIN0], INW, 24, 0, F.in[I_N0], WSP(bf16, WS_WIN0), D, 0, 0, r, scr, F.lane); continue; } r -= J1;
            if (r < J2) { tr_job(F.in[I_WIN0], INW, 8, 3 * FW + NH, F.in[I_N0], WSP(bf16, WS_WIN0), D, 0, 3 * FW, r, scr, F.lane); continue; } r -= J2;
            if (r < J3) { tr_job(F.in[I_WOUT], D, 16, 0, nullptr, WSP(bf16, WS_WOT), D, 0, 0, r, scr, F.lane); continue; } r -= J3;
            if (r < J4) { tr_job(F.in[I_W1], DFF, 44, 0, F.in[I_N1], WSP(bf16, WS_W13), D, 1, 0, r, scr, F.lane); continue; } r -= J4;
            if (r < J5) { tr_job(F.in[I_W3], DFF, 44, 0, F.in[I_N1], WSP(bf16, WS_W13), D, 1, 128, r, scr, F.lane); continue; } r -= J5;
            if (r < J6) { tr_job(F.in[I_W2], D, 16, 0, nullptr, WSP(bf16, WS_W2T), DFF, 0, 0, r, scr, F.lane); continue; } r -= J6;
            if (r < J7) { tr_job(F.in[I_WIN1], D, 16, 0, F.in[I_N2], WSP(bf16, WS_WIN1), D, 0, 0, r, scr, F.lane); continue; } r -= J7;
            if (r < J8) { tr_job(F.in[I_GA], D, 16, 0, nullptr, WSP(bf16, WS_WGLU), D, 1, 0, r, scr, F.lane); continue; } r -= J8;
            tr_job(F.in[I_GB], D, 16, 0, nullptr, WSP(bf16, WS_WGLU), D, 1, 128, r, scr, F.lane);
        }
    }
    for (int rep = 0; rep < P0_REP_FOLD; ++rep)
    for (int it = gw; it < 16 * 64; it += NGW) {
        const int n = 64 * (it & 15) + F.lane, kk0 = 8 * (it >> 4), g = kk0 >> 7, kl0 = kk0 & 127;
        const float* wp = F.in[I_WPOOL] + ((size_t)g * 128 + kl0) * 128; const float* ps = F.in[I_PSCALE] + g * 128; const float* wo = F.in[I_WOUT] + (size_t)(FW + g * 128) * D + n;
        float a[8];
#pragma unroll
        for (int i = 0; i < 8; ++i) a[i] = 0.f;
#pragma unroll 16
        for (int j = 0; j < 128; ++j) { const float w = wo[(size_t)j * D] * ps[j];
#pragma unroll
            for (int i = 0; i < 8; ++i) a[i] += wp[i * 128 + j] * w; }
        v4u o; o.x = pk2(a[0], a[1]); o.y = pk2(a[2], a[3]); o.z = pk2(a[4], a[5]); o.w = pk2(a[6], a[7]);
        *(GAS v4u*)(WSP(bf16, WS_WOT) + (size_t)n * D + FW + kk0) = o;
    }
    for (int rep = 0; rep < P0_REP_ROWS; ++rep)
    {
        f32x4 nx[4];
        if (gw < M) { const GAS f32x4* xr = (const GAS f32x4*)(F.in[I_X] + (size_t)gw * D) + F.lane;
#pragma unroll
            for (int j = 0; j < 4; ++j) nx[j] = __builtin_nontemporal_load(xr + 64 * j); }
        for (int m = gw; m < M; m += NGW) {
            f32x4 v[4];
#pragma unroll
            for (int j = 0; j < 4; ++j) v[j] = nx[j];
            if (m + NGW < M) { const GAS f32x4* xr = (const GAS f32x4*)(F.in[I_X] + (size_t)(m + NGW) * D) + F.lane;
#pragma unroll
                for (int j = 0; j < 4; ++j) nx[j] = __builtin_nontemporal_load(xr + 64 * j); }
            float rs, red; row_dots(v, WFG, F.lane, rs, red);
            GAS unsigned long long* o8 = (GAS unsigned long long*)(WSP(bf16, WS_H0) + (size_t)m * D) + F.lane;
#pragma unroll
            for (int j = 0; j < 4; ++j) o8[64 * j] = (unsigned long long)pk2(v[j].x, v[j].y) | ((unsigned long long)pk2(v[j].z, v[j].w) << 32);
            if (F.lane == 0) WSP(float, WS_RS0)[m] = rs;
            if ((F.lane & 7) == 0) { const int e = F.lane >> 3; const float a = red + F.in[I_BF][e]; WSP(float, WS_LOGF)[(size_t)m * 8 + e] = fminf(a, 0.f) - log1pf(expf(-fabsf(a))); }
        }
    }
    __syncthreads();
    }
    if (!SSM_IN_P4 && (F.vcu & 1) != 0) { for (int job = F.vcu; job < 4 * SG; job += F.G) ssm_prep_job(F, job >> 2, job & 3); }
}

__device__ __forceinline__ void forget_cumsum(Frame& F, int b, int h) {
    const float* lf = WSP(float, WS_LOGF) + ((size_t)b * SEQ + 32 * F.lane) * 8 + h; float v[32]; float s = 0.f;
#pragma unroll
    for (int i = 0; i < 32; ++i) { s += lf[i * 8]; v[i] = s; }
    float incl = s;
#pragma unroll
    for (int o = 1; o < 64; o <<= 1) { const float t = __shfl_up(incl, o); if (F.lane >= o) incl += t; }
    const float excl = incl - s; float* fo = WSP(float, WS_FNEG) + ((size_t)b * NH + h) * SEQ + 32 * F.lane;
#pragma unroll
    for (int i = 0; i < 32; i += 4) *(f32x4*)(fo + i) = (f32x4){-(excl + v[i]) * LOG2E, -(excl + v[i + 1]) * LOG2E, -(excl + v[i + 2]) * LOG2E, -(excl + v[i + 3]) * LOG2E};
}

__device__ __forceinline__ void pool_rows(Frame& F, int row0) {
    const unsigned* Pp = (const unsigned*)(WSP(bf16, WS_QKVP) + (size_t)3 * M * 512); unsigned* mix = (unsigned*)WSP(bf16, WS_MIX);
    const int cp = F.tid & 255, half = F.tid >> 8, w = 2 << (cp >> 6), t0 = row0 + 32 * half, bs = t0 & ~(SEQ - 1);
    unsigned u[48];
#pragma unroll
    for (int i = 0; i < 48; ++i) { const int t = t0 - 16 + i; u[i] = (t >= bs) ? Pp[(size_t)t * 256 + cp] : 0u; }
    float s0 = 0.f, s1 = 0.f;
#pragma unroll
    for (int i = 0; i < 16; ++i) { if (16 - i <= w) { s0 += __uint_as_float(u[i] << 16); s1 += __uint_as_float(u[i] & 0xffff0000u); } }
#pragma unroll
    for (int i = 0; i < 32; ++i) { const int t = t0 + i; const float p0 = __uint_as_float(u[16 + i] << 16), p1 = __uint_as_float(u[16 + i] & 0xffff0000u);
        const unsigned uo = (w == 2) ? u[14 + i] : (w == 4) ? u[12 + i] : (w == 8) ? u[8 + i] : u[i];
        s0 += p0 - __uint_as_float(uo << 16); s1 += p1 - __uint_as_float(uo & 0xffff0000u);
        const int cnt = (t - bs + 1) < w ? (t - bs + 1) : w; const float ic = 1.0f / (float)cnt;
        mix[(size_t)t * 512 + 256 + cp] = pk2(s0 * ic - p0, s1 * ic - p1); }
}

__device__ __forceinline__ void ssm_state_unit(Frame& F, int g, int bp) {
    typedef short bf16x8v __attribute__((ext_vector_type(8)));
    LAS unsigned char* BL = F.lds + RING_OFF;
    LAS float* SL = (LAS float*)(F.lds + RING_OFF);
    LAS float* TL = SL + 128 * 132;
    bf16* AGg = WSP(bf16, WS_QKVP) + ((size_t)g * NBC + 128 * bp) * KA; const bf16* MGg = WSP(bf16, WS_MG) + (size_t)g * 128 * 512;
    const int r16 = F.lane & 15, quad = F.lane >> 4;
#pragma unroll
    for (int i = 0; i < 16; ++i) { const int n = 16 * F.wave + i, cs = (F.lane & ~7) | ((F.lane ^ n) & 7);
        __builtin_amdgcn_global_load_lds((const unsigned*)(MGg + (size_t)n * 512 + 8 * cs), (LAS unsigned*)(BL + n * 1024), 16, 0, 0); }
    f32x4 acc[8];
#pragma unroll
    for (int nb = 0; nb < 8; ++nb) acc[nb] = (f32x4){0.f, 0.f, 0.f, 0.f};
    const bf16* ap = AGg + (size_t)(16 * F.wave + r16) * KA + 128 + 8 * quad;
    bf16x8v a[8];
#pragma unroll
    for (int ks = 0; ks < 8; ++ks) a[ks] = *(const bf16x8v*)(ap + 32 * ks);
    asm volatile("s_waitcnt vmcnt(0)" ::: "memory"); __syncthreads();
    const int n7 = r16 & 7; const LAS unsigned char* be = BL + r16 * 1024 + 16 * (quad ^ n7); const LAS unsigned char* bo = BL + r16 * 1024 + 16 * ((4 + quad) ^ n7);
#pragma unroll 1
    for (int kh = 0; kh < 2; ++kh) {
#pragma unroll
        for (int ks = 0; ks < 8; ++ks) { const LAS unsigned char* bb = ((ks & 1) ? bo : be) + kh * 512 + (ks >> 1) * 128;
#pragma unroll
            for (int nb = 0; nb < 8; ++nb) { const bf16x8v b = *(const LAS bf16x8v*)(bb + nb * 16384); acc[nb] = __builtin_amdgcn_mfma_f32_16x16x32_bf16(a[ks], b, acc[nb], 0, 0, 0); } }
        if (kh == 0) {
#pragma unroll
            for (int ks = 0; ks < 8; ++ks) a[ks] = *(const bf16x8v*)(ap + 256 + 32 * ks); }
    }
    __syncthreads();
#pragma unroll
    for (int nb = 0; nb < 8; ++nb)
#pragma unroll
        for (int r = 0; r < 4; ++r) SL[(16 * F.wave + 4 * quad + r) * 132 + 16 * nb + r16] = acc[nb][r];
    __syncthreads();
    { const int seg = F.tid >> 7, b2 = (F.tid >> 6) & 1, p = F.tid & 63; const float alr = WSP(float, WS_AL)[(g * SP + p) * 2], ali = WSP(float, WS_AL)[(g * SP + p) * 2 + 1];
      float lr[16], li[16], xr = 0.f, xi = 0.f, pr = 1.f, pi = 0.f;
#pragma unroll
      for (int j = 0; j < 16; ++j) { const int row = b2 * NCH + 16 * seg + j; lr[j] = xr; li[j] = xi;
          const float sr = SL[row * 132 + p], si = SL[row * 132 + SP + p]; const float nr = alr * xr - ali * xi + sr, ni = alr * xi + ali * xr + si; xr = nr; xi = ni;
          const float qr = pr * alr - pi * ali, qi = pr * ali + pi * alr; pr = qr; pi = qi; }
      TL[(seg * 128 + b2 * 64 + p) * 2] = xr; TL[(seg * 128 + b2 * 64 + p) * 2 + 1] = xi;
      __syncthreads();
      float cr = 0.f, ci = 0.f;
      for (int s2 = 0; s2 < seg; ++s2) { const float tr = TL[(s2 * 128 + b2 * 64 + p) * 2], ti = TL[(s2 * 128 + b2 * 64 + p) * 2 + 1]; const float nr = pr * cr - pi * ci + tr, ni = pr * ci + pi * cr + ti; cr = nr; ci = ni; }
      float wr_ = 1.f, wi_ = 0.f;
#pragma unroll
      for (int j = 0; j < 16; ++j) { const int row = b2 * NCH + 16 * seg + j; bf16* o = AGg + (size_t)row * KA + p;
          o[0] = (bf16)f2bf(lr[j] + wr_ * cr - wi_ * ci); o[SP] = (bf16)f2bf(li[j] + wr_ * ci + wi_ * cr);
          const float qr = wr_ * alr - wi_ * ali, qi = wr_ * ali + wi_ * alr; wr_ = qr; wi_ = qi; } }
    __syncthreads();
}

__device__ __forceinline__ void router_rows(Frame& F, const LAS float* WR, LAS unsigned* CN) {
    const int m0 = 64 * F.vcu + 16 * F.wave;
    unsigned long long nxb[4];
    { const GAS unsigned long long* xr = (const GAS unsigned long long*)(WSP(bf16, WS_H0) + (size_t)m0 * D) + F.lane;
#pragma unroll
        for (int j = 0; j < 4; ++j) nxb[j] = xr[64 * j]; }
    for (int r = 0; r < 16; ++r) { const int m = m0 + r;
        f32x4 v[4];
#pragma unroll
        for (int j = 0; j < 4; ++j) { const unsigned lo = (unsigned)nxb[j], hi = (unsigned)(nxb[j] >> 32); v[j] = (f32x4){__uint_as_float(lo << 16), __uint_as_float(lo & 0xffff0000u), __uint_as_float(hi << 16), __uint_as_float(hi & 0xffff0000u)}; }
        if (r + 1 < 16) { const GAS unsigned long long* xr = (const GAS unsigned long long*)(WSP(bf16, WS_H0) + (size_t)(m + 1) * D) + F.lane;
#pragma unroll
            for (int j = 0; j < 4; ++j) nxb[j] = xr[64 * j]; }
        float rs, red; row_dots(v, WR, F.lane, rs, red);
        GAS unsigned* o4 = (GAS unsigned*)(WSP(unsigned char, WS_H3) + (size_t)m * D) + F.lane;
#pragma unroll
        for (int j = 0; j < 4; ++j) { const f32x4 g = *(const GAS f32x4*)(F.in[I_N3] + 4 * F.lane + 256 * j);
            o4[64 * j] = pk4_fp8(v[j].x * rs * g.x, v[j].y * rs * g.y, v[j].z * rs * g.z, v[j].w * rs * g.w); }
        float lg[8];
#pragma unroll
        for (int e = 0; e < 8; ++e) lg[e] = __builtin_bit_cast(float, __builtin_amdgcn_readlane(__builtin_bit_cast(int, red), 8 * e)) + F.in[I_RB][e];
        int e1 = 0; float l1 = lg[0];
#pragma unroll
        for (int e = 1; e < 8; ++e) if (lg[e] > l1) { l1 = lg[e]; e1 = e; }
        int e2 = -1; float l2 = -INFINITY;
#pragma unroll
        for (int e = 0; e < 8; ++e) if (e != e1 && lg[e] > l2) { l2 = lg[e]; e2 = e; }
        if (F.lane == 0) { const float g2 = 1.0f / (1.0f + expf(l1 - l2)); WSP(unsigned, WS_TOKE)[m] = (unsigned)e1 | ((unsigned)e2 << 8);
            WSP(float, WS_GATE)[2 * m] = 1.0f - g2; WSP(float, WS_GATE)[2 * m + 1] = g2; atomicAdd((unsigned*)&CN[e1], 1u); atomicAdd((unsigned*)&CN[e2], 1u); }
    }
}

__device__ __forceinline__ void moe_sort(Frame& F) {
    LAS unsigned* TOT = (LAS unsigned*)(F.lds + RING_OFF);
    LAS unsigned* BASE = TOT + 2048;
    for (int i = F.tid; i < F.G * 8; i += 512) TOT[i] = WSP(unsigned, WS_CNT)[i];
    __syncthreads();
    if (F.tid < 8) { unsigned tot = 0, pre = 0; for (int b = 0; b < F.G; ++b) { if (b == F.vcu) pre = tot; tot += TOT[b * 8 + F.tid]; } BASE[F.tid] = pre; BASE[8 + F.tid] = tot; }
    __syncthreads();
    if (F.tid == 0) { unsigned s = 0, tl = 0; for (int e = 0; e < 8; ++e) { BASE[16 + e] = s; if (F.vcu == 0) { WSP(unsigned, WS_TAB)[e] = s; WSP(unsigned, WS_TAB)[16 + e] = tl; } s += BASE[8 + e]; tl += (BASE[8 + e] + 255u) >> 8; }
        BASE[24] = s; if (F.vcu == 0) { WSP(unsigned, WS_TAB)[8] = s; WSP(unsigned, WS_TAB)[24] = tl;
            unsigned rowL = 2u * M, t0 = 0, r0 = 0; for (int e = 0; e < 8; ++e) { const unsigned nt_ = (BASE[8 + e] + 255u) >> 8; if (t0 <= (unsigned)MAIN_TILES && (unsigned)MAIN_TILES < t0 + nt_) rowL = r0 + 256u * ((unsigned)MAIN_TILES - t0); t0 += nt_; r0 += BASE[8 + e]; }
            WSP(unsigned, WS_TAB)[25] = rowL; } }
    __syncthreads();
    if (F.vcu == 1 && F.tid < 256) WSP(unsigned, WS_TOKS)[2 * M + F.tid] = 0u;
    if (F.wave == 0) { const int t = 64 * F.vcu + F.lane; const unsigned te = WSP(unsigned, WS_TOKE)[t]; const int e1 = te & 255, e2 = (te >> 8) & 255;
        unsigned p1 = 0, p2 = 0; const unsigned long long lt = (1ull << F.lane) - 1ull;
#pragma unroll
        for (int e = 0; e < 8; ++e) { const unsigned long long b1 = __ballot(e1 == e), b2 = __ballot(e2 == e);
            if (e1 == e) p1 = BASE[16 + e] + BASE[e] + (unsigned)__popcll(b1 & lt);
            if (e2 == e) p2 = BASE[16 + e] + BASE[e] + (unsigned)__popcll(b1) + (unsigned)__popcll(b2 & lt); }
        WSP(unsigned, WS_POS)[2 * t] = p1; WSP(unsigned, WS_POS)[2 * t + 1] = p2; WSP(unsigned, WS_TOKS)[p1] = (unsigned)t; WSP(unsigned, WS_TOKS)[p2] = (unsigned)t; }
}

__device__ __forceinline__ void final_rows(Frame& F) {
    const int gw = F.vcu * NWAVES + F.wave, NGW = F.G * NWAVES; int lane_ = F.lane; asm volatile("" : "+v"(lane_));
    unsigned pp1 = 0, pp2 = 0; float gg1 = 0.f, gg2 = 0.f; const unsigned rowL = WSP(unsigned, WS_TAB)[25];
    { const int mi = gw + (lane_ & 7) * NGW; if (mi < M) { pp1 = WSP(unsigned, WS_POS)[2 * mi]; pp2 = WSP(unsigned, WS_POS)[2 * mi + 1]; gg1 = WSP(float, WS_GATE)[2 * mi]; gg2 = WSP(float, WS_GATE)[2 * mi + 1]; } }
#define FR_LOAD(i, X, A, B) do { const int m_ = gw + (i) * NGW; const unsigned q1_ = (unsigned)__builtin_amdgcn_readlane((int)pp1, (i) & 7), q2_ = (unsigned)__builtin_amdgcn_readlane((int)pp2, (i) & 7); \
        const GAS unsigned long long* xr_ = (const GAS unsigned long long*)(WSP(bf16, WS_H0) + (size_t)m_ * D) + lane_; const GAS unsigned* y1_ = (const GAS unsigned*)(WSP(unsigned char, WS_YS) + (size_t)q1_ * D) + lane_; \
        const GAS unsigned* y2_ = (const GAS unsigned*)(WSP(unsigned char, WS_YS) + (size_t)q2_ * D) + lane_; \
        _Pragma("unroll") for (int j = 0; j < 4; ++j) { X[j] = __builtin_nontemporal_load(xr_ + 64 * j); A[j] = __builtin_nontemporal_load(y1_ + 64 * j); B[j] = __builtin_nontemporal_load(y2_ + 64 * j); } } while (0)
    unsigned long long nx[4]; unsigned na[4], nb[4];
    if (gw < M) FR_LOAD(0, nx, na, nb);
    for (int i = 0; gw + i * NGW < M; ++i) { const int m = gw + i * NGW;
        f32x4 v[4]; unsigned ya[4], yb[4];
#pragma unroll
        for (int j = 0; j < 4; ++j) { const unsigned lo = (unsigned)nx[j], hi = (unsigned)(nx[j] >> 32); v[j] = (f32x4){__uint_as_float(lo << 16), __uint_as_float(lo & 0xffff0000u), __uint_as_float(hi << 16), __uint_as_float(hi & 0xffff0000u)}; ya[j] = na[j]; yb[j] = nb[j]; }
        const float g1 = __builtin_bit_cast(float, __builtin_amdgcn_readlane(__builtin_bit_cast(int, gg1), i & 7)), g2 = __builtin_bit_cast(float, __builtin_amdgcn_readlane(__builtin_bit_cast(int, gg2), i & 7));
        if (gw + (i + 1) * NGW < M) FR_LOAD(i + 1, nx, na, nb);
        float s = 0.f;
        typedef float f32x2v __attribute__((ext_vector_type(2)));
#pragma unroll
        for (int j = 0; j < 4; ++j) {
            const f32x2v a0 = __builtin_amdgcn_cvt_pk_f32_fp8((int)ya[j], false), a1 = __builtin_amdgcn_cvt_pk_f32_fp8((int)ya[j], true), b0 = __builtin_amdgcn_cvt_pk_f32_fp8((int)yb[j], false), b1 = __builtin_amdgcn_cvt_pk_f32_fp8((int)yb[j], true);
            v[j].x += g1 * a0.x + g2 * b0.x; v[j].y += g1 * a0.y + g2 * b0.y; v[j].z += g1 * a1.x + g2 * b1.x; v[j].w += g1 * a1.y + g2 * b1.y; }
        { const unsigned q1 = (unsigned)__builtin_amdgcn_readlane((int)pp1, i & 7), q2 = (unsigned)__builtin_amdgcn_readlane((int)pp2, i & 7);
#pragma unroll
          for (int sl = 0; sl < 2; ++sl) { const unsigned q = sl ? q2 : q1; const float gg = sl ? g2 : g1;
            if (q >= rowL) { const GAS unsigned* yp = (const GAS unsigned*)(WSP(unsigned char, WS_YP) + (size_t)(q - rowL) * D) + lane_;
#pragma unroll
                for (int part = 0; part < 3; ++part)
#pragma unroll
                    for (int j = 0; j < 4; ++j) { const unsigned w = yp[(size_t)part * (YP_ROWS * D / 4) + 64 * j]; const f32x2v c0 = __builtin_amdgcn_cvt_pk_f32_fp8((int)w, false), c1 = __builtin_amdgcn_cvt_pk_f32_fp8((int)w, true);
                        v[j].x += gg * c0.x; v[j].y += gg * c0.y; v[j].z += gg * c1.x; v[j].w += gg * c1.y; } } } }
#pragma unroll
        for (int j = 0; j < 4; ++j) {
            s += (v[j].x * v[j].x + v[j].y * v[j].y) + (v[j].z * v[j].z + v[j].w * v[j].w); }
        const float rs = 1.0f / sqrtf(wave_sum(s) * (1.0f / D) + EPS);
        GAS f32x4* xw = (GAS f32x4*)(F.out + (size_t)m * D) + lane_;
#pragma unroll
        for (int j = 0; j < 4; ++j) { const f32x4 g = *(const GAS f32x4*)(F.in[I_NF] + 4 * lane_ + 256 * j); __builtin_nontemporal_store((f32x4){v[j].x * rs * g.x, v[j].y * rs * g.y, v[j].z * rs * g.z, v[j].w * rs * g.w}, xw + 64 * j); }
    }
#undef FR_LOAD
}

constexpr int N_PHASES = 15;
#ifndef REP_P4
#define REP_P4 1
#endif
#ifndef REP_P12
#define REP_P12 1
#endif
#ifndef REP_P13
#define REP_P13 1
#endif
__global__ void __launch_bounds__(NWAVES * 64, 2) trunk_fwd(Args args) {
    extern __shared__ __attribute__((aligned(16))) unsigned char lds[];
    Frame F;
    F.lds = (LAS unsigned char*)lds;
    F.MISC = (volatile LAS unsigned*)(F.lds + MISC_OFF);
    F.tid = threadIdx.x; F.lane = F.tid & 63; F.wave = __builtin_amdgcn_readfirstlane(F.tid >> 6);
    F.G = gridDim.x; { const int bx = blockIdx.x; F.vcu = (F.G % 8 == 0) ? (bx % 8) * (F.G / 8) + bx / 8 : bx; }
    F.in = (const float* const __attribute__((address_space(4)))*)__builtin_amdgcn_kernarg_segment_ptr();
    F.out = args.out; F.ws = args.ws; F.ctl = (gu32*)(args.ws + WS_CTL);
    for (int u = F.tid; u < (LDS_BYTES - LDSCTL_OFF) / 4; u += NWAVES * 64) ((LAS unsigned*)(F.lds + LDSCTL_OFF))[u] = 0u;
    __syncthreads();
    const int lo = args.ph_lo, hi = args.ph_hi;
    const bool use_bar = (hi - lo) > 1;
    XcdBarrier bar; bar.bar = (unsigned*)(F.ctl + CW_BAR); bar.x = 0; bar.st = nullptr;
    if (use_bar) bar = xcd_barrier_post((unsigned*)(F.ctl + CW_BAR), F.MISC + 8);
#ifndef PHMASK
#define PHMASK 0x7fff
#endif
#define IN(k) ((((PHMASK) >> (k)) & 1) && lo <= (k) && (k) < hi)
#define SEAM(k) do { if (lo <= (k) && (k) + 1 < hi) xcd_barrier(bar); } while (0)
#ifndef DBLMASK
#define DBLMASK 0
#endif
#define RETID() do { int t_ = threadIdx.x; asm volatile("" : "+v"(t_)); F.tid = t_; F.lane = t_ & 63; } while (0)
#define PH(k, ...) if (IN(k)) { RETID(); { __VA_ARGS__ } if (((DBLMASK) >> (k)) & 1) { xcd_barrier(bar); { __VA_ARGS__ } } } SEAM(k);
    LAS unsigned char* ring = F.lds + RING_OFF;

    PH(0, p0_prologue(F); )

    PH(1,
        if (blockIdx.x < NB * NH && F.wave == 0) forget_cumsum(F, blockIdx.x >> 3, blockIdx.x & 7);
        PlainProb P{WSP(bf16, WS_H0), WSP(bf16, WS_WIN0), 2 * D, 2 * D, D / 64}; pg8::GridOrder S; S.init(M / 256, 2048 / 256, F.G, (int)blockIdx.x);
        LAS float* RSL = (LAS float*)(F.lds + RS_OFF); fill_rs_direct(RSL, WSP(float, WS_RS0), S, F.tid);
        EpiSplitBf16 E{WSP(bf16, WS_QKVP), attn_body::C2, RSL};
        const TableOrder TS = build_units(F.lds, S, F.tid);
        pg8::gemm_phase<EpiSplitBf16, TableOrder, PlainProb, true>(ring, P, TS, E);
    )

    PH(2,
        for (int r = F.vcu; r < M / 64; r += F.G) pool_rows(F, 64 * r);
        const attn_body::bf16* qkv = (const attn_body::bf16*)WSP(bf16, WS_QKVP);
        const attn_body::AttnTensors AT{qkv, qkv + (size_t)M * 512, qkv + (size_t)2 * M * 512, (attn_body::bf16*)WSP(bf16, WS_MIX), WSP(float, WS_FNEG)};
        const attn_body::StaticOrder S((int)F.G, (int)blockIdx.x);
        attn_body::attn_phase<attn_body::StaticOrder>((char*)lds + RING_OFF, AT, S);
    )

    PH(3,
        PlainProb P{WSP(bf16, WS_MIX), WSP(bf16, WS_WOT), 2 * D, 2 * D, D / 64}; pg8::GridOrder S; S.init(M / 256, D / 256, F.G, (int)blockIdx.x);
        EpiResid<false> E{WSP(bf16, WS_H0), WSP(bf16, WS_QKVP), WSP(float, WS_SSQ1)};
        pg8::gemm_phase<EpiResid<false>, pg8::GridOrder, PlainProb, false>(ring, P, S, E);
    )

    PH(4,
        PlainProb P{WSP(bf16, WS_QKVP), WSP(bf16, WS_W13), 2 * D, 2 * D, D / 64}; pg8::GridOrder S; S.init(M / 256, 2 * DFF / 256, F.G, (int)blockIdx.x);
        LAS float* RSL = (LAS float*)(F.lds + RS_OFF); fill_rs(RSL, WSP(float, WS_SSQ1), S, F.tid);
        EpiSwiglu E{WSP(bf16, WS_ACT0), RSL};
        const TableOrder TS = build_units(F.lds, S, F.tid);
        pg8::gemm_phase<EpiSwiglu, TableOrder, PlainProb, true, false, REP_P4>(ring, P, TS, E);
        if (SSM_IN_P4) { int pm_, pn_; if (!S.tile(5, pm_, pn_)) { const int k_ = (int)blockIdx.x - 128; if (k_ >= 0) { ssm_prep_job(F, k_ >> 1, k_ & 1, true); ssm_prep_job(F, k_ >> 1, (k_ & 1) + 2, false); } } }
    )

    PH(5,
        PlainProb P{WSP(bf16, WS_ACT0), WSP(bf16, WS_W2T), 2 * DFF, 2 * DFF, DFF / 64}; pg8::GridOrder S; S.init(M / 256, D / 256, F.G, (int)blockIdx.x);
        EpiResid<false> E{WSP(bf16, WS_QKVP), WSP(bf16, WS_H0), WSP(float, WS_SSQ2)};
        pg8::gemm_phase<EpiResid<false>, pg8::GridOrder, PlainProb, false>(ring, P, S, E);
    )

    PH(6,
        PlainProb P{WSP(bf16, WS_H0), WSP(bf16, WS_WIN1), 2 * D, 2 * D, D / 64}; pg8::GridOrder S; S.init(M / 256, D / 256, F.G, (int)blockIdx.x);
        LAS float* RSL = (LAS float*)(F.lds + RS_OFF); fill_rs(RSL, WSP(float, WS_SSQ2), S, F.tid);
        EpiSsmU E{WSP(bf16, WS_QKVP), RSL};
        pg8::gemm_phase<EpiSsmU, pg8::GridOrder, PlainProb, false>(ring, P, S, E);
    )

    PH(7, for (int j = F.vcu; j < 4 * SG; j += F.G) ssm_state_unit(F, j >> 2, j & 3); )

    PH(8,
        SsmProb P{WSP(bf16, WS_QKVP), WSP(bf16, WS_BT2), 2 * KA, 2 * KA}; SsmOrder S{F.vcu, F.G};
        EpiGelu E{WSP(bf16, WS_ACT0)};
        pg8::gemm_phase<EpiGelu, SsmOrder, SsmProb, false>(ring, P, S, E);
    )

    PH(9,
        PlainProb P{WSP(bf16, WS_ACT0), WSP(bf16, WS_WGLU), 2 * D, 2 * D, D / 64}; pg8::GridOrder S; S.init(M / 256, 2 * D / 256, F.G, (int)blockIdx.x);
        EpiGlu E{WSP(bf16, WS_H0)};
        const TableOrder TS = build_units(F.lds, S, F.tid);
        pg8::gemm_phase<EpiGlu, TableOrder, PlainProb, true>(ring, P, TS, E);
    )

    PH(10,
        LAS float* WR = (LAS float*)(F.lds + RING_OFF + 69632);
        LAS unsigned* CN = (LAS unsigned*)(F.lds + RING_OFF + 69632 + 32768);
        fill_w8(WR, F.in[I_RW], NE, F.in[I_N3], F.tid);
        if (F.tid < 16) CN[F.tid] = 0u;
        __syncthreads();
        if (F.wave < 4) router_rows(F, WR, CN);
        { LAS unsigned char* scr = F.lds + RING_OFF + F.wave * 8704;
          constexpr int JE = 8 * 44; constexpr int NIT = NE * 2 * JE;
          for (;;) { unsigned k = 0; if (F.lane == 0) k = atomicAdd((unsigned*)&CN[8], 1u); k = (unsigned)__builtin_amdgcn_readfirstlane((int)k);
              const int it = F.vcu + (int)k * F.G; if (it >= NIT) break; const int e = it / (2 * JE), r = it % (2 * JE);
              if (r < JE) tr_job_f8(F.in[I_EW1] + (size_t)e * D * DFF, DFF, 44, WSP(unsigned char, WS_W13E) + (size_t)e * 2 * DFF * D, D, 1, 0, r, scr, F.lane);
              else tr_job_f8(F.in[I_EW3] + (size_t)e * D * DFF, DFF, 44, WSP(unsigned char, WS_W13E) + (size_t)e * 2 * DFF * D, D, 1, 128, r - JE, scr, F.lane); } }
        __syncthreads();
        if (F.tid < 8) WSP(unsigned, WS_CNT)[F.vcu * 8 + F.tid] = CN[F.tid];
    )

    PH(11, moe_sort(F); )

    PH(12,
        const int nM_ = (int)WSP(unsigned, WS_TAB)[24], nwg_ = nM_ * (2 * DFF / 256), rounds_ = (nwg_ + F.G - 1) / F.G; int Gp_ = rounds_ > 0 ? (nwg_ + rounds_ - 1) / rounds_ : F.G; if (Gp_ > F.G) Gp_ = F.G;
        if ((int)blockIdx.x < Gp_) {
            MoeOrder S; S.tab = WSP(unsigned, WS_TAB); S.init(nM_, 2 * DFF / 256, Gp_, (int)blockIdx.x);
            MoeUpProb P{WSP(unsigned char, WS_H3), WSP(unsigned char, WS_W13E), WSP(unsigned, WS_TOKS), D, D};
            EpiSwigluF8 E{WSP(unsigned char, WS_ACTS)};
            const TableOrder TS = build_units(F.lds, S, F.tid);
            pg8::gemm_phase<EpiSwigluF8, TableOrder, MoeUpProb, true, true, REP_P12>(ring, P, TS, E);
        }
        { LAS unsigned char* scr = F.lds + RING_OFF + F.wave * 8704; constexpr int JE = 8 * 44; constexpr int NIT2 = NE * JE;
          for (;;) { __syncthreads(); if (F.tid == 0) F.MISC[16] = __hip_atomic_fetch_add((unsigned*)(F.ctl + CW_W2E), 8u, RLX_AGENT); __syncthreads();
              const int base = (int)F.MISC[16]; if (base >= NIT2) break; const int it = base + F.wave;
              if (it < NIT2) { const int e = it / JE, r = it % JE; tr_job_f8(F.in[I_EW2] + (size_t)e * DFF * D, D, 16, WSP(unsigned char, WS_W2E) + (size_t)e * D * DFF, DFF, 0, 0, r, scr, F.lane); } } }
    )

    PH(13,
        MoeDownOrder S; S.init(WSP(unsigned, WS_TAB), F.G, (int)blockIdx.x);
        MoeDownProb P{WSP(unsigned char, WS_ACTS), WSP(unsigned char, WS_W2E), DFF, DFF};
        EpiMaskF8 E{WSP(unsigned char, WS_YS), WSP(unsigned char, WS_YP), (int)WSP(unsigned, WS_TAB)[25]};
        const TableOrder TS = build_units(F.lds, S, F.tid);
        pg8::gemm_phase<EpiMaskF8, TableOrder, MoeDownProb, true, true, REP_P13>(ring, P, TS, E);
    )

    PH(14, final_rows(F); )
#undef IN
#undef SEAM
}

extern "C" void kernel_launch(void* const* d_in, const int* in_sizes, int n_in, void* d_out, int out_size, void* d_ws, size_t ws_size, hipStream_t stream) {
    static int grid = 0;
    if (grid == 0) {
        if (n_in != 30 || in_sizes[0] != M * D || out_size != M * D || ws_size < WS_END) { fprintf(stderr, "kernel_launch: shape/workspace mismatch (n_in %d, ws %zu, need %zu); nothing launched\n", n_in, ws_size, (size_t)WS_END); grid = -1; return; }
        int dev = 0, cus = 0, per_cu = 0;
        if (hipGetDevice(&dev) != hipSuccess || hipDeviceGetAttribute(&cus, hipDeviceAttributeMultiprocessorCount, dev) != hipSuccess) { grid = -1; return; }
        if (hipFuncSetAttribute((const void*)trunk_fwd, hipFuncAttributeMaxDynamicSharedMemorySize, LDS_BYTES) != hipSuccess) { fprintf(stderr, "kernel_launch: hipFuncSetAttribute failed\n"); grid = -1; return; }
        if (hipOccupancyMaxActiveBlocksPerMultiprocessor(&per_cu, (const void*)trunk_fwd, NWAVES * 64, LDS_BYTES) != hipSuccess || per_cu < 1) fprintf(stderr, "kernel_launch: occupancy query reports %d\n", per_cu);
        (void)hipGetLastError();
        if (cus < 256) { fprintf(stderr, "kernel_launch: needs 256 CUs, device has %d\n", cus); grid = -1; return; }
        grid = 256;
    }
    if (grid < 0) return;
    if (hipMemsetAsync((char*)d_ws + WS_CTL, 0, 32 * 1024, stream) != hipSuccess) return;
    Args a{};
    for (int i = 0; i < 30; ++i) a.in[i] = (const float*)d_in[i];
    a.out = (float*)d_out; a.ws = (unsigned char*)d_ws;
#ifndef MK_SPLIT
    a.ph_lo = 0; a.ph_hi = N_PHASES;
    hipLaunchKernelGGL(trunk_fwd, dim3(grid), dim3(NWAVES * 64), LDS_BYTES, stream, a);
#else
    for (int p = 0; p < N_PHASES; ++p) { a.ph_lo = p; a.ph_hi = p + 1; hipLaunchKernelGGL(trunk_fwd, dim3(grid), dim3(NWAVES * 64), LDS_BYTES, stream, a); }
#endif
}
```

```cpp
#include <hip/hip_runtime.h>
#include <hip/hip_bf16.h>
#include <cstdio>
#include <cstdint>
#include <cmath>

namespace pg8 {
#define PG8_LAS __attribute__((address_space(3)))
typedef unsigned short bf16_t;
typedef short bf16x8 __attribute__((ext_vector_type(8)));
typedef float f32x4 __attribute__((ext_vector_type(4)));
typedef float f32x2 __attribute__((ext_vector_type(2)));
typedef unsigned u32x4 __attribute__((ext_vector_type(4)));
typedef unsigned u32x2 __attribute__((ext_vector_type(2)));
constexpr int BM = 256, BK = 64, HALF = 128, HTB = HALF * BK * 2  , STAGE_BYTES = 8 * HTB, NXCD = 8, WGM = 8;

__host__ __device__ __forceinline__ int lds_byte(int r, int c) { const int st = (r >> 4) * 2 + (c >> 5), rr = r & 15, cc = c & 31, ob = rr * 64 + cc * 2; return st * 1024 + (ob ^ (((ob >> 9) & 1) << 5)); }
__host__ __device__ __forceinline__ void stage_rc(int b, int& R, int& C) { const int st = b / 1024, sb = b % 1024, swz = sb ^ (((sb >> 9) & 1) << 5); R = (st >> 1) * 16 + swz / 64; C = (st & 1) * 32 + (swz % 64) / 2; }
__host__ __device__ __forceinline__ int perm32(int rho) { const int n = rho >> 4, i = rho & 15; return 8 * (i >> 2) + 4 * n + (i & 3); }

struct Unit { int pm, pn, x0, x1, x2, kq; };

struct GridOrder {
    int nM, nN, nwg, G, c;
    __device__ __forceinline__ void init(int nM_, int nN_, int G_, int c_) { nM = nM_; nN = nN_; nwg = nM * nN; G = G_; c = c_; }
    __device__ __forceinline__ bool tile(int i, int& pm, int& pn) const {
        const long L = (long)i * G + c; if (L >= nwg) return false;
        int wgid = (int)L; { const int q = nwg / NXCD, r = nwg % NXCD, xcd = wgid % NXCD, off = wgid / NXCD; wgid = (xcd < r ? xcd * (q + 1) : r * (q + 1) + (xcd - r) * q) + off; }
        const int nig = WGM * nN, gid = wgid / nig, fm = gid * WGM, gsz = (nM - fm) < WGM ? (nM - fm) : WGM;
        pm = fm + ((wgid % nig) % gsz); pn = (wgid % nig) / gsz; return true;
    }
    __device__ __forceinline__ bool next(int i, Unit& u) const { u.x0 = 0; u.x1 = i; u.x2 = 0; u.kq = -1; return tile(i, u.pm, u.pn); }
};

__device__ __forceinline__ unsigned cvt_pk_bf16(float lo, float hi) { unsigned r; asm volatile("v_cvt_pk_bf16_f32 %0, %1, %2" : "=v"(r) : "v"(lo), "v"(hi)); return r; }
__device__ __forceinline__ float fast_sigmoid(float v) { return __builtin_amdgcn_rcpf(1.0f + __builtin_amdgcn_exp2f(-1.4426950408889634f * v)); }
__device__ __forceinline__ float gelu_tanh(float y) { const float z2 = y * (1.5957691216057308f + 0.07135481627159282f * y * y); return y * fast_sigmoid(z2); }

typedef int i32x4 __attribute__((ext_vector_type(4)));
typedef int i32x8 __attribute__((ext_vector_type(8)));
template <class Epi, class Sched, class Prob, bool ALIGN_EPI, bool FP8 = false, int EPI_REP = 1>
__device__ __forceinline__ void gemm_phase(PG8_LAS unsigned char* lds, const Prob& P, const Sched& S, const Epi& E) {
    int tid_ = threadIdx.x; asm volatile("" : "+v"(tid_));
    const int tid = tid_, wid = __builtin_amdgcn_readfirstlane(tid >> 6), lane = tid & 63, wr = wid >> 2, wc = wid & 3, fr = lane & 15, fq = lane >> 4;
    unsigned cV[2][2], nV[2][2], voffB[2]; int pR[2], pC[2];
#pragma unroll
    for (int i = 0; i < 2; ++i) { int R, C; stage_rc(tid * 16 + i * 8192, R, C); pR[i] = R; pC[i] = C; const int Rb = Epi::PERM ? ((R & ~31) + perm32(R & 31)) : R;
        voffB[i] = (unsigned)(Rb * P.ldb + C * 2);
        cV[0][i] = (unsigned)(R * P.lda + C * 2); cV[1][i] = (unsigned)((R + HALF) * P.lda + C * 2); nV[0][i] = cV[0][i]; nV[1][i] = cV[1][i]; }
    const size_t kstep = (size_t)(BK * 2);
    const size_t hstepB = (size_t)HALF * P.ldb;
    const unsigned ldsw = (unsigned)wid * 1024u;
    int aofs[2], bofs[2];
    aofs[0] = lds_byte(wr * 64 + fr, fq * 8); aofs[1] = aofs[0] + 1024; bofs[0] = lds_byte(wc * 32 + fr, fq * 8); bofs[1] = bofs[0] + 1024;
#define PG8_SA(b, h) (((b) * 2 + (h)) * HTB)
#define PG8_SB(b, h) ((4 + (b) * 2 + (h)) * HTB)
#define PG8_STAGE(bufoff, gbase, voff) do { _Pragma("unroll") for (int _i = 0; _i < 2; ++_i) \
        __builtin_amdgcn_global_load_lds((const unsigned*)((const char*)(gbase) + (voff)[_i]), (PG8_LAS unsigned*)(lds + (bufoff) + ldsw + _i * 8192), 16, 0, 0); } while (0)
#define PG8_LDA(dst, b, h) do { _Pragma("unroll") for (int m = 0; m < 4; ++m) dst[m] = __builtin_shufflevector(*(const PG8_LAS i32x4*)(lds + PG8_SA(b, h) + aofs[0] + m * 2048), *(const PG8_LAS i32x4*)(lds + PG8_SA(b, h) + aofs[1] + m * 2048), 0, 1, 2, 3, 4, 5, 6, 7); } while (0)
#define PG8_LDB(dst, b, h) do { _Pragma("unroll") for (int n = 0; n < 2; ++n) dst[n] = __builtin_shufflevector(*(const PG8_LAS i32x4*)(lds + PG8_SB(b, h) + bofs[0] + n * 2048), *(const PG8_LAS i32x4*)(lds + PG8_SB(b, h) + bofs[1] + n * 2048), 0, 1, 2, 3, 4, 5, 6, 7); } while (0)
#define PG8_LO(x) __builtin_bit_cast(bf16x8, __builtin_shufflevector(x, x, 0, 1, 2, 3))
#define PG8_HI(x) __builtin_bit_cast(bf16x8, __builtin_shufflevector(x, x, 4, 5, 6, 7))
#define PG8_MMA(ai, bj, At, Bt) do { __builtin_amdgcn_s_setprio(1); _Pragma("unroll") for (int m = 0; m < 4; ++m) _Pragma("unroll") for (int n = 0; n < 2; ++n) { \
        if constexpr (FP8) acc[ai][bj][m][n] = __builtin_amdgcn_mfma_scale_f32_16x16x128_f8f6f4(Bt[n], At[m], acc[ai][bj][m][n], 0, 0, 0, 0x7f7f7f7f, 0, 0x7f7f7f7f); \
        else { acc[ai][bj][m][n] = __builtin_amdgcn_mfma_f32_16x16x32_bf16(PG8_LO(Bt[n]), PG8_LO(At[m]), acc[ai][bj][m][n], 0, 0, 0); acc[ai][bj][m][n] = __builtin_amdgcn_mfma_f32_16x16x32_bf16(PG8_HI(Bt[n]), PG8_HI(At[m]), acc[ai][bj][m][n], 0, 0, 0); } } \
        if constexpr (FP8) { _Pragma("unroll") for (int m = 0; m < 4; ++m) asm volatile("" : "+v"(acc[ai][bj][m][0]), "+v"(acc[ai][bj][m][1])); }     \
        __builtin_amdgcn_s_setprio(0); } while (0)
#define PG8_WAIT_V(n) asm volatile("s_waitcnt vmcnt(" #n ")" ::: "memory")
#define PG8_WAIT_L(n) asm volatile("s_waitcnt lgkmcnt(" #n ")" ::: "memory")
#define PG8_BAR __builtin_amdgcn_s_barrier()
#define PG8_SCHED __builtin_amdgcn_sched_barrier(0)
    Unit cur, nxt, nn; int ui = 0; unsigned nnV[2][2]; bool has_next = false;
    if (!S.next(0, cur)) return;
    f32x4 acc[2][2][4][2];
#pragma unroll
    for (int a = 0; a < 2; ++a)
#pragma unroll
        for (int b = 0; b < 2; ++b)
#pragma unroll
            for (int m = 0; m < 4; ++m)
#pragma unroll
                for (int n = 0; n < 2; ++n) acc[a][b][m][n] = (f32x4){0.f, 0.f, 0.f, 0.f};
    i32x8 At[4], B0[2], B1[2];
    const char* cA; const char* cB; int nt;
    P.ptrs(cur, cA, cB, nt);
    if constexpr (Prob::GATHER) { P.gather(cur, pR, pC, cV); has_next = S.next(1, nxt); if (has_next) P.gather(nxt, pR, pC, nV); }
    PG8_STAGE(PG8_SB(0, 0), cB, voffB); PG8_STAGE(PG8_SB(0, 1), cB + hstepB, voffB); PG8_STAGE(PG8_SA(0, 0), cA, cV[0]); PG8_STAGE(PG8_SA(0, 1), cA, cV[1]);
    if (wr == 1) PG8_BAR;
    PG8_WAIT_V(2); PG8_BAR;
    PG8_STAGE(PG8_SB(1, 0), cB + kstep, voffB); PG8_STAGE(PG8_SA(1, 0), cA + kstep, cV[0]); PG8_STAGE(PG8_SB(1, 1), cB + hstepB + kstep, voffB);
    PG8_WAIT_V(6); PG8_BAR;
    for (;;) {
        bool has_nn = false;
        if constexpr (Prob::GATHER) { if (has_next) { has_nn = S.next(ui + 2, nn); if (has_nn) P.gather(nn, pR, pC, nnV); } }
        else has_next = S.next(ui + 1, nxt);
        const char* nA = cA; const char* nB = cB; int nnt = nt;
        if (has_next) { P.ptrs(nxt, nA, nB, nnt); }
        else { if constexpr (Prob::GATHER) { nV[0][0] = cV[0][0]; nV[0][1] = cV[0][1]; nV[1][0] = cV[1][0]; nV[1][1] = cV[1][1]; } }
        for (int t = 0; t < nt; t += 2) {
            const bool last = (t == nt - 2);
            const char* a1 = cA + (size_t)(t + 1) * kstep;
            const char* a2 = last ? nA : cA + (size_t)(t + 2) * kstep; const char* b2 = last ? nB : cB + (size_t)(t + 2) * kstep;
            const char* a3 = a2 + kstep; const char* b3 = b2 + kstep;
            unsigned v2[2][2];
            if constexpr (Prob::GATHER) { v2[0][0] = last ? nV[0][0] : cV[0][0]; v2[0][1] = last ? nV[0][1] : cV[0][1]; v2[1][0] = last ? nV[1][0] : cV[1][0]; v2[1][1] = last ? nV[1][1] : cV[1][1]; }
            else { v2[0][0] = cV[0][0]; v2[0][1] = cV[0][1]; v2[1][0] = cV[1][0]; v2[1][1] = cV[1][1]; }
            PG8_LDB(B0, 0, 0); PG8_LDB(B1, 0, 1); PG8_SCHED; PG8_LDA(At, 0, 0); PG8_STAGE(PG8_SA(1, 1), a1, cV[1]);
            PG8_WAIT_V(8); PG8_WAIT_L(0); PG8_BAR; PG8_MMA(0, 0, At, B0); PG8_MMA(0, 1, At, B1); PG8_BAR; PG8_SCHED;
            PG8_LDA(At, 0, 1); PG8_STAGE(PG8_SB(0, 0), b2, voffB); PG8_STAGE(PG8_SB(0, 1), b2 + hstepB, voffB); PG8_STAGE(PG8_SA(0, 0), a2, v2[0]);
            PG8_WAIT_V(8); PG8_WAIT_L(0); PG8_BAR; PG8_MMA(1, 0, At, B0); PG8_MMA(1, 1, At, B1); PG8_BAR; PG8_SCHED;
            PG8_LDB(B0, 1, 0); PG8_LDB(B1, 1, 1); PG8_SCHED; PG8_LDA(At, 1, 0); PG8_STAGE(PG8_SA(0, 1), a2, v2[1]);
            PG8_WAIT_V(8); PG8_WAIT_L(0); PG8_BAR; PG8_MMA(0, 0, At, B0); PG8_MMA(0, 1, At, B1); PG8_BAR; PG8_SCHED;
            PG8_LDA(At, 1, 1); PG8_STAGE(PG8_SB(1, 0), b3, voffB); PG8_STAGE(PG8_SB(1, 1), b3 + hstepB, voffB); PG8_STAGE(PG8_SA(1, 0), a3, v2[0]);
            PG8_WAIT_V(8); PG8_WAIT_L(0); PG8_BAR; PG8_MMA(1, 0, At, B0); PG8_MMA(1, 1, At, B1); PG8_BAR; PG8_SCHED;
        }
        if constexpr (ALIGN_EPI) { if (wr == 0) PG8_BAR; }
        if constexpr (!Epi::AFTER_DRAIN) { _Pragma("unroll") for (int rep_ = 0; rep_ < EPI_REP; ++rep_) E(acc, cur, wr, wc, fr, fq); }
        if (!has_next) break;
#pragma unroll
        for (int a = 0; a < 2; ++a)
#pragma unroll
            for (int b = 0; b < 2; ++b)
#pragma unroll
                for (int m = 0; m < 4; ++m)
#pragma unroll
                    for (int n = 0; n < 2; ++n) acc[a][b][m][n] = (f32x4){0.f, 0.f, 0.f, 0.f};
        cur = nxt; cA = nA; cB = nB; nt = nnt; ++ui;
        if constexpr (Prob::GATHER) { cV[0][0] = nV[0][0]; cV[0][1] = nV[0][1]; cV[1][0] = nV[1][0]; cV[1][1] = nV[1][1];
            if (has_nn) { nxt = nn; nV[0][0] = nnV[0][0]; nV[0][1] = nnV[0][1]; nV[1][0] = nnV[1][0]; nV[1][1] = nnV[1][1]; } has_next = has_nn; }
        if constexpr (ALIGN_EPI) { if (wr == 1) PG8_BAR; }
    }
    PG8_WAIT_V(0);
    if constexpr (!ALIGN_EPI) { if (wr == 0) PG8_BAR; }
    PG8_BAR;
    if constexpr (Epi::AFTER_DRAIN) { E.fused(acc, cur, wr, wc, fr, fq, lds, wid, lane); }
#undef PG8_SA
#undef PG8_SB
#undef PG8_STAGE
#undef PG8_LDA
#undef PG8_LDB
#undef PG8_MMA
#undef PG8_LO
#undef PG8_HI
#undef PG8_WAIT_V
#undef PG8_WAIT_L
#undef PG8_BAR
#undef PG8_SCHED
}
}
#include <hip/hip_bf16.h>
#include <cmath>
namespace attn_body {
using bf16=__hip_bfloat16;
using bf16x8=__attribute__((ext_vector_type(8)))short;
using s16x4=__attribute__((ext_vector_type(4)))short;
using f32x16=__attribute__((ext_vector_type(16)))float;
using u32x4=__attribute__((ext_vector_type(4)))unsigned;
constexpr int BATCH=8,NHEAD=8,SEQ=2048,D=64,DM=NHEAD*D,DMO=1024;
constexpr int NW=8,QBLK=32,QB=QBLK*NW,KVBLK=64,NQB=SEQ/QB;
constexpr int ATTN_PITCH=DM, ATTN_OPITCH=DMO, ATTN_UNIT_ROWS=QB;
__device__ __forceinline__ int crow(int r,int hi){return (r&3)+8*(r>>2)+4*hi;}
#define SBAR() __builtin_amdgcn_sched_barrier(0)
__device__ __forceinline__ void cmask(f32x16&p0,f32x16&p1,int jb,int qrel,int hi){
  const float NEG=-INFINITY; int kb=64*jb+4*hi;
  #pragma unroll
  for(int r=0;r<16;++r){int kv=kb+(r&3)+8*(r>>2); if(kv>qrel)p0[r]=NEG; if(kv+32>qrel)p1[r]=NEG;}
}

constexpr int NSLOT=3, SLOTB=8192;
constexpr int LDS_K=0, LDS_V=NSLOT*SLOTB, LDS_WS=2*NSLOT*SLOTB, LDS_OST=LDS_WS+NW*64*4, LDS_BIAS=LDS_OST+NW*4096, LDS_BYTES=LDS_BIAS+SEQ*4;
constexpr float C2=0.125f*1.4426950408889634f;
__device__ __forceinline__ void glds16(const void*gsrc,unsigned lds_dst){unsigned keep;
  asm volatile("s_mov_b32 %0, m0\n\ts_mov_b32 m0, %2\n\ts_nop 0\n\tglobal_load_lds_dwordx4 %1, off\n\ts_mov_b32 m0, %0":"=&s"(keep):"v"(gsrc),"s"(lds_dst):"memory");}
__device__ __forceinline__ float max3f(float a,float b,float c){float r;asm("v_max3_f32 %0, %1, %2, %3":"=v"(r):"v"(a),"v"(b),"v"(c));return r;}
__device__ __forceinline__ float max2f(float a,float b){float r;asm("v_max_f32_e32 %0, %1, %2":"=v"(r):"v"(a),"v"(b));return r;}
__device__ __forceinline__ float fadd_s(float a,float b){float r;asm("v_add_f32_e32 %0, %1, %2":"=v"(r):"v"(a),"v"(b));return r;}
__device__ __forceinline__ float fsub_s(float a,float b){float r;asm("v_sub_f32_e32 %0, %1, %2":"=v"(r):"v"(a),"v"(b));return r;}
typedef float f32x2_t __attribute__((ext_vector_type(2))); typedef float f32x4_t __attribute__((ext_vector_type(4))); typedef __bf16 bf16x2_t __attribute__((ext_vector_type(2)));
__device__ __forceinline__ unsigned cvtpk_s(float lo,float hi){f32x2_t v={lo,hi};bf16x2_t b=__builtin_convertvector(v,bf16x2_t);return __builtin_bit_cast(unsigned,b);}
#define WAIT_BAR(N) asm volatile("s_waitcnt vmcnt(" #N ") lgkmcnt(0)\n\ts_barrier":::"memory")

__device__ __forceinline__ void qkt(f32x16&p0,f32x16&p1,const char*Kslot,const bf16x8*qr,const f32x16&negm,int r32,int hi){
  const char*kb=Kslot+hi*1024+r32*16;
  #pragma unroll
  for(int d0=0;d0<4;++d0){
    const bf16x8 b0=*reinterpret_cast<const bf16x8*>(kb+d0*2048);
    const bf16x8 b1=*reinterpret_cast<const bf16x8*>(kb+d0*2048+512);
    if(d0==0){p0=__builtin_amdgcn_mfma_f32_32x32x16_bf16(b0,qr[0],negm,0,0,0);p1=__builtin_amdgcn_mfma_f32_32x32x16_bf16(b1,qr[0],negm,0,0,0);}
    else{p0=__builtin_amdgcn_mfma_f32_32x32x16_bf16(b0,qr[d0],p0,0,0,0);p1=__builtin_amdgcn_mfma_f32_32x32x16_bf16(b1,qr[d0],p1,0,0,0);}}
}
typedef __attribute__((address_space(3))) const char* lds_cptr;
typedef short v4i16_t __attribute__((ext_vector_type(4)));
__device__ __forceinline__ void kload8(bf16x8*kf,lds_cptr kp){
  kf[0]=*(const __attribute__((address_space(3))) bf16x8*)(kp);      kf[1]=*(const __attribute__((address_space(3))) bf16x8*)(kp+512);
  kf[2]=*(const __attribute__((address_space(3))) bf16x8*)(kp+2048); kf[3]=*(const __attribute__((address_space(3))) bf16x8*)(kp+2560);
  kf[4]=*(const __attribute__((address_space(3))) bf16x8*)(kp+4096); kf[5]=*(const __attribute__((address_space(3))) bf16x8*)(kp+4608);
  kf[6]=*(const __attribute__((address_space(3))) bf16x8*)(kp+6144); kf[7]=*(const __attribute__((address_space(3))) bf16x8*)(kp+6656);
}
__device__ __forceinline__ void kload2(bf16x8*kf,lds_cptr kp,int j){ kf[2*j]=*(const __attribute__((address_space(3))) bf16x8*)(kp+j*2048); kf[2*j+1]=*(const __attribute__((address_space(3))) bf16x8*)(kp+j*2048+512); }
__device__ __forceinline__ s16x4 vtr(lds_cptr p){ return __builtin_bit_cast(s16x4,__builtin_amdgcn_ds_read_tr16_b64_v4i16((__attribute__((address_space(3))) v4i16_t*)p)); }
__device__ __forceinline__ float rowmax(const f32x16&p0,const f32x16&p1){
  float a=max3f(p0[0],p0[1],p1[0]),b=max3f(p0[2],p0[3],p1[1]);a=max3f(a,p1[2],p1[3]);
  #pragma unroll
  for(int r=4;r<16;r+=4){a=max3f(a,p0[r],p0[r+1]);b=max3f(b,p0[r+2],p0[r+3]);a=max3f(a,p1[r],p1[r+1]);b=max3f(b,p1[r+2],p1[r+3]);}
  const float m=max2f(a,b);
  auto rr=__builtin_amdgcn_permlane32_swap(__float_as_uint(m),__float_as_uint(m),false,false);
  return max2f(__uint_as_float(rr[0]),__uint_as_float(rr[1]));
}
__device__ __forceinline__ void pv(f32x16*o,int vb,bf16x8 pa0,bf16x8 pa1,bf16x8 pa2,bf16x8 pa3){
  #pragma unroll
  for(int d0=0;d0<2;++d0){s16x4 lo[4],hi[4];
    #pragma unroll
    for(int ks=0;ks<4;++ks){
      asm volatile("ds_read_b64_tr_b16 %0,%1 offset:%c2":"=&v"(lo[ks]):"v"(vb),"i"(d0*4096+ks*1024):"memory");
      asm volatile("ds_read_b64_tr_b16 %0,%1 offset:%c2":"=&v"(hi[ks]):"v"(vb),"i"(d0*4096+ks*1024+512):"memory");}
    asm volatile("s_waitcnt lgkmcnt(0)":::"memory");SBAR();
    #define PK(k) (bf16x8){lo[k][0],lo[k][1],lo[k][2],lo[k][3],hi[k][0],hi[k][1],hi[k][2],hi[k][3]}
    o[d0]=__builtin_amdgcn_mfma_f32_32x32x16_bf16(pa0,PK(0),o[d0],0,0,0);
    o[d0]=__builtin_amdgcn_mfma_f32_32x32x16_bf16(pa1,PK(1),o[d0],0,0,0);
    o[d0]=__builtin_amdgcn_mfma_f32_32x32x16_bf16(pa2,PK(2),o[d0],0,0,0);
    o[d0]=__builtin_amdgcn_mfma_f32_32x32x16_bf16(pa3,PK(3),o[d0],0,0,0);
    #undef PK
  }
}

#ifndef ATTN_STORE16
#define ATTN_STORE16(p,v) (*(u32x4*)(p)=(v))
#endif
template<int THRL> __device__ __forceinline__ void attn_unit(int b,int h,int qb,const bf16*Q,const bf16*__restrict__ K,const bf16*__restrict__ V,bf16*O,const float*__restrict__ Fb,char*shm){
  asm volatile("":"+s"(Q),"+s"(K),"+s"(V),"+s"(O),"+s"(Fb));
  int tid_=threadIdx.x; asm volatile("":"+v"(tid_));
  const int tid=tid_,lane=tid&63,r32=lane&31,hi=lane>>5; const int wid=__builtin_amdgcn_readfirstlane(tid>>6);
  const long rowbase=(long)b*SEQ; const int q0=qb*QB;
  const bf16*Qw=Q+(rowbase+q0+wid*QBLK)*DM+h*D;
  const bf16*Kh=K+rowbase*DM+h*D,*Vh=V+rowbase*DM+h*D;
  const unsigned lds0=(unsigned)(uintptr_t)shm;
  float*wsf=(float*)(shm+LDS_WS)+wid*64;
  const bf16*ksrc=Kh+(long)lane*DM+wid*8;
  const bf16*vsrc=Vh+(long)(16*(wid&3)+(lane>>2))*DM+(wid>>2)*32+(lane&3)*8;
  const unsigned kdst=lds0+LDS_K+wid*1024, vdst=lds0+LDS_V+wid*1024;
  #define DMA_K(t,slot) glds16(ksrc+(long)(t)*KVBLK*DM,(unsigned)__builtin_amdgcn_readfirstlane(kdst+(slot)))
  #define DMA_V(t,slot) glds16(vsrc+(long)(t)*KVBLK*DM,(unsigned)__builtin_amdgcn_readfirstlane(vdst+(slot)))
  const int vb0=(int)(lds0+LDS_V)+((lane>>4)&1)*32+(lane&3)*8+(4*hi+((lane&15)>>2))*64;
  const char*Kbase=shm+LDS_K; bf16x8 kf[8];
  const lds_cptr shm3=(lds_cptr)shm; const lds_cptr kp0=shm3+LDS_K+hi*1024+r32*16; const lds_cptr vp0=shm3+LDS_V+((lane>>4)&1)*32+(lane&3)*8+(4*hi+((lane&15)>>2))*64;
  const int NT=(q0+QB)/KVBLK;
  glds16(Fb+wid*256+lane*4,(unsigned)__builtin_amdgcn_readfirstlane(lds0+LDS_BIAS+wid*1024));
  DMA_K(0,0);DMA_V(0,0);DMA_K(1,SLOTB);
  bf16x8 qr[4];
  #pragma unroll
  for(int d0=0;d0<4;++d0)qr[d0]=*reinterpret_cast<const bf16x8*>(&Qw[(long)r32*DM+d0*16+hi*8]);
  float mhat=0.f,l_reg=0.f;f32x16 o[2];o[0]=f32x16{};o[1]=f32x16{};f32x16 negm;
  #pragma unroll
  for(int r=0;r<16;++r)asm volatile("v_mov_b32 %0, 0":"=v"(negm[r]));
  asm volatile("":"+v"(negm));
  const int qrel=wid*QBLK+r32;
  #define CMASK(P0,P1,t) do{int jb_=(t)-(NT-4); if(jb_>=0)cmask(P0,P1,jb_,qrel,hi);}while(0)
  #define BIAS(P0,P1,t) do{ const __attribute__((address_space(3))) f32x4_t* bp_=(const __attribute__((address_space(3))) f32x4_t*)(shm3+LDS_BIAS)+(t)*16+hi; \
    _Pragma("unroll") for(int j_=0;j_<4;++j_){ const f32x4_t b0_=bp_[2*j_], b1_=bp_[8+2*j_]; \
      P0[4*j_]+=b0_[0]; P0[4*j_+1]+=b0_[1]; P0[4*j_+2]+=b0_[2]; P0[4*j_+3]+=b0_[3]; \
      P1[4*j_]+=b1_[0]; P1[4*j_+1]+=b1_[1]; P1[4*j_+2]+=b1_[2]; P1[4*j_+3]+=b1_[3]; } }while(0)
  bool resc=false;
  #define START(P0,P1) do{ _Pragma("unroll") for(int r=0;r<16;++r)P0[r]=__builtin_amdgcn_exp2f(P0[r]); }while(0)
  #define RESC() do{}while(0)
  f32x16 pA0,pA1,pB0,pB1;
  int sl_prev=0,sl_cur=0,sl_next=SLOTB;
  #define ROT() do{sl_prev=sl_cur;sl_cur=sl_next;sl_next=(sl_next==(NSLOT-1)*SLOTB)?0:sl_next+SLOTB;}while(0)
  DMA_K(2,2*SLOTB);
  WAIT_BAR(3);
  { mhat=*(const __attribute__((address_space(3))) float*)(shm3+LDS_BIAS+(q0+qrel)*4);
    _Pragma("unroll") for(int r=0;r<16;++r)negm[r]=-mhat; asm volatile("":"+v"(negm)); }
  qkt(pA0,pA1,Kbase,qr,negm,r32,hi);asm volatile("s_nop 15\n\ts_nop 7":"+v"(pA0),"+v"(pA1));BIAS(pA0,pA1,0);CMASK(pA0,pA1,0);
  START(pA0,pA1);
  _Pragma("unroll") for(int r=0;r<16;++r)pA1[r]=__builtin_amdgcn_exp2f(pA1[r]);
  WAIT_BAR(0);
  DMA_K(3,0);DMA_V(1,SLOTB);
  ROT();
  kload8(kf,kp0+sl_cur);
  WAIT_BAR(2);
  s16x4 vlo[8],vhi[8]; u32x4 pw0,pw1,pw2,pw3;
  #define PKW(P,B) cvtpk_s(P[B],P[B+1])
  #define PAF(k) __builtin_bit_cast(bf16x8,pw##k)
  #define VFR(i) (bf16x8){vlo[i][0],vlo[i][1],vlo[i][2],vlo[i][3],vhi[i][0],vhi[i][1],vhi[i][2],vhi[i][3]}
  #define PIN(x) asm volatile("":"+v"(x))
  #define MX3(a,b,c) __builtin_fmaxf(__builtin_fmaxf((a),(b)),(c))
  #define GAPA(MF,A0,A1,A2,A3,W0,W1,PW) do{ MF; sacc+=A0; sacc+=A1; sacc+=A2; sacc+=A3; PIN(sacc); W0; W1; PIN(PW); SBAR(); }while(0)
  #define EX(v) __builtin_amdgcn_exp2f(v)
  #define GAPB(MF,X,B) do{ MF; X[B]=EX(X[B]); X[B+1]=EX(X[B+1]); X[B+2]=EX(X[B+2]); X[B+3]=EX(X[B+3]); PIN(X); SBAR(); }while(0)
  #define VRD(i) do{ vlo[i]=vtr(vp_+(((i)>>2)*4096+((i)&3)*1024)); vhi[i]=vtr(vp_+(((i)>>2)*4096+((i)&3)*1024+512)); }while(0)
  #define KRD(G,j) do{ if(G){ kload2(kf,kp0+sl_next,j); SBAR(); } }while(0)
  #define STEP(C0,C1,P0,P1,t,GK,GV,GL) do{ SBAR(); \
    const lds_cptr vp_=vp0+sl_prev; \
    VRD(0); SBAR(); float sacc=(P0[0]+P0[1]); \
    GAPA(C0=__builtin_amdgcn_mfma_f32_32x32x16_bf16(kf[0],qr[0],negm,0,0,0), P0[2],P0[3],P0[4],P0[5],     pw0[0]=PKW(P0,0), pw0[1]=PKW(P0,2), pw0); \
    VRD(4); SBAR(); GAPA(C1=__builtin_amdgcn_mfma_f32_32x32x16_bf16(kf[1],qr[0],negm,0,0,0), P0[6],P0[7],P0[8],P0[9],     pw0[2]=PKW(P0,4), pw0[3]=PKW(P0,6), pw0); \
    VRD(1); SBAR(); GAPA(C0=__builtin_amdgcn_mfma_f32_32x32x16_bf16(kf[2],qr[1],C0,0,0,0),   P0[10],P0[11],P0[12],P0[13], pw1[0]=PKW(P0,8), pw1[1]=PKW(P0,10), pw1); \
    VRD(5); SBAR(); GAPA(C1=__builtin_amdgcn_mfma_f32_32x32x16_bf16(kf[3],qr[1],C1,0,0,0),   P0[14],P0[15],P1[0],P1[1],   pw1[2]=PKW(P0,12),pw1[3]=PKW(P0,14), pw1); \
    VRD(2); SBAR(); GAPA(C0=__builtin_amdgcn_mfma_f32_32x32x16_bf16(kf[4],qr[2],C0,0,0,0),   P1[2],P1[3],P1[4],P1[5],     pw2[0]=PKW(P1,0), pw2[1]=PKW(P1,2), pw2); \
    VRD(6); SBAR(); GAPA(C1=__builtin_amdgcn_mfma_f32_32x32x16_bf16(kf[5],qr[2],C1,0,0,0),   P1[6],P1[7],P1[8],P1[9],     pw2[2]=PKW(P1,4), pw2[3]=PKW(P1,6), pw2); \
    VRD(3); SBAR(); GAPA(C0=__builtin_amdgcn_mfma_f32_32x32x16_bf16(kf[6],qr[3],C0,0,0,0),   P1[10],P1[11],P1[12],P1[13], pw3[0]=PKW(P1,8), pw3[1]=PKW(P1,10), pw3); \
    VRD(7); SBAR(); GAPA(C1=__builtin_amdgcn_mfma_f32_32x32x16_bf16(kf[7],qr[3],C1,0,0,0),   P1[14],P1[15],0.f,0.f,       pw3[2]=PKW(P1,12),pw3[3]=PKW(P1,14), pw3); \
    l_reg+=sacc; \
    if(GK){DMA_K((t)+3,sl_cur);} if(GV){DMA_V((t)+1,sl_next);} \
    BIAS(C0,C1,t); CMASK(C0,C1,t); \
    SBAR(); \
    GAPB(o[0]=__builtin_amdgcn_mfma_f32_32x32x16_bf16(PAF(0),VFR(0),o[0],0,0,0), C0,0); \
    GAPB(o[1]=__builtin_amdgcn_mfma_f32_32x32x16_bf16(PAF(0),VFR(4),o[1],0,0,0), C0,4); \
    KRD(GL,0); GAPB(o[0]=__builtin_amdgcn_mfma_f32_32x32x16_bf16(PAF(1),VFR(1),o[0],0,0,0), C0,8); \
    KRD(GL,1); GAPB(o[1]=__builtin_amdgcn_mfma_f32_32x32x16_bf16(PAF(1),VFR(5),o[1],0,0,0), C0,12); \
    KRD(GL,2); GAPB(o[0]=__builtin_amdgcn_mfma_f32_32x32x16_bf16(PAF(2),VFR(2),o[0],0,0,0), C1,0); \
    KRD(GL,3); GAPB(o[1]=__builtin_amdgcn_mfma_f32_32x32x16_bf16(PAF(2),VFR(6),o[1],0,0,0), C1,4); \
    GAPB(o[0]=__builtin_amdgcn_mfma_f32_32x32x16_bf16(PAF(3),VFR(3),o[0],0,0,0), C1,8); \
    GAPB(o[1]=__builtin_amdgcn_mfma_f32_32x32x16_bf16(PAF(3),VFR(7),o[1],0,0,0), C1,12); \
    }while(0)
  int t=1;
  #undef CMASK
  #define CMASK(P0,P1,t) do{}while(0)
  for(;t+5<NT;t+=2){
    STEP(pB0,pB1,pA0,pA1,t,true,true,true);     WAIT_BAR(2); RESC(); ROT();
    STEP(pA0,pA1,pB0,pB1,t+1,true,true,true);   WAIT_BAR(2); RESC(); ROT();
  }
  #undef CMASK
  #define CMASK(P0,P1,t) do{int jb_=(t)-(NT-4); if(jb_>=0)cmask(P0,P1,jb_,qrel,hi);}while(0)
  #define ENDW(tt) do{ if((tt)+3<NT){WAIT_BAR(2);} else if((tt)+2<NT){WAIT_BAR(1);} else {WAIT_BAR(0);} }while(0)
  for(;t+1<NT;t+=2){
    STEP(pB0,pB1,pA0,pA1,t,(t+3<NT),(t+1<NT),(t+1<NT));       ENDW(t);   RESC(); ROT();
    STEP(pA0,pA1,pB0,pB1,t+1,(t+4<NT),(t+2<NT),(t+2<NT));     ENDW(t+1); RESC(); ROT();
  }
  STEP(pB0,pB1,pA0,pA1,NT-1,false,false,false); RESC();
  { float sacc=pB0[0]+pB0[1]; _Pragma("unroll") for(int r=2;r<16;++r)sacc+=pB0[r]; _Pragma("unroll") for(int r=0;r<16;++r)sacc+=pB1[r]; l_reg+=sacc;
    pw0=(u32x4){PKW(pB0,0),PKW(pB0,2),PKW(pB0,4),PKW(pB0,6)};pw1=(u32x4){PKW(pB0,8),PKW(pB0,10),PKW(pB0,12),PKW(pB0,14)};pw2=(u32x4){PKW(pB1,0),PKW(pB1,2),PKW(pB1,4),PKW(pB1,6)};pw3=(u32x4){PKW(pB1,8),PKW(pB1,10),PKW(pB1,12),PKW(pB1,14)};
    SBAR(); pv(o,vb0+sl_cur,PAF(0),PAF(1),PAF(2),PAF(3)); }
  #undef PKW
  #undef PAF
  #undef VFR
  #undef PIN
  #undef MX3
  #undef GAPA
  #undef GAPB
  #undef EX
  #undef VRD
  #undef KRD
  #undef STEP
  #undef ENDW
  {auto rr=__builtin_amdgcn_permlane32_swap(__float_as_uint(l_reg),__float_as_uint(l_reg),false,false);l_reg=__uint_as_float(rr[0])+__uint_as_float(rr[1]);}
  {
    int tid2=threadIdx.x; asm volatile("":"+v"(tid2)); const int lane2=tid2&63,r32b=lane2&31,hib=lane2>>5; const int wid2=__builtin_amdgcn_readfirstlane(tid2>>6);
    float*wsf2=(float*)(shm+LDS_WS)+wid2*64;
    if(hib==0)wsf2[32+r32b]=l_reg;asm volatile("s_waitcnt lgkmcnt(0)":::"memory");
    float rli[16];
    #pragma unroll
    for(int r=0;r<16;++r)rli[r]=__builtin_amdgcn_rcpf(wsf2[32+crow(r,hib)]);
    bf16*Ow=O+((long)b*SEQ+qb*QB+wid2*QBLK)*DMO+h*D;
    bf16*stg=(bf16*)(shm+LDS_OST)+wid2*2048;
    #pragma unroll
    for(int r=0;r<16;++r){const int orow=crow(r,hib);
      #pragma unroll
      for(int d0=0;d0<2;++d0)stg[orow*64+d0*32+r32b]=__float2bfloat16(o[d0][r]*rli[r]);}
    asm volatile("s_waitcnt lgkmcnt(0)":::"memory");
    #pragma unroll
    for(int i=0;i<4;++i){const int row=i*8+(lane2>>3),ch=lane2&7; const u32x4 v=*(const u32x4*)(stg+row*64+ch*8); ATTN_STORE16(Ow+(long)row*DMO+ch*8,v);} }
  asm volatile("s_waitcnt lgkmcnt(0)\n\ts_barrier":::"memory");
  #undef DMA_K
  #undef DMA_V
  #undef CMASK
  #undef START
  #undef RESC
  #undef ROT
}
constexpr int ATTN_LDS_BYTES=LDS_BYTES;
struct AttnTensors { const bf16* Q; const bf16* K; const bf16* V; bf16* O; const float* Fneg; };
struct AttnUnit { int bh; int qb; };
struct StaticOrder {
  int vcu;
  __device__ __forceinline__ explicit StaticOrder(int grid,int block):vcu((block%8)*(grid/8)+block/8){}
  __device__ __forceinline__ bool next(int i,AttnUnit&u)const{ if(i>=2||vcu>=256)return false; const int s=vcu&3; u.bh=vcu>>2; u.qb=(i==0)?s:7-s; return true; }
  __device__ __forceinline__ void a_ready(const AttnUnit&)const{}
  __device__ __forceinline__ void done(const AttnUnit&)const{}
};
template<class Sched,int THRL=8> __device__ __forceinline__ void attn_phase(char*lds,const AttnTensors&T,const Sched&S){
  AttnUnit u;
  for(int i=0;S.next(i,u);++i){ S.a_ready(u); attn_unit<THRL>(u.bh/NHEAD,u.bh%NHEAD,u.qb,T.Q,T.K,T.V,T.O,T.Fneg+(long)u.bh*SEQ,lds); S.done(u); }
}
#undef SBAR
#undef WAIT_BAR
}
#define GAS __attribute__((address_space(1)))
#define LAS __attribute__((address_space(3)))
typedef unsigned short bf16;
typedef unsigned v4u __attribute__((ext_vector_type(4)));
typedef float f32x4 __attribute__((ext_vector_type(4)));
typedef short bf16x8 __attribute__((ext_vector_type(8)));
typedef GAS unsigned gu32;
typedef GAS unsigned long long gu64;
#define RLX_AGENT __ATOMIC_RELAXED, __HIP_MEMORY_SCOPE_AGENT
#define LDS_WAIT() asm volatile("s_waitcnt lgkmcnt(0)" ::: "memory")
#define VM_WAIT() asm volatile("s_waitcnt vmcnt(0)" ::: "memory")
__device__ __forceinline__ unsigned long long rt() { return __builtin_amdgcn_s_memrealtime(); }
__device__ __forceinline__ unsigned f2bf(float f) { unsigned u = __builtin_bit_cast(unsigned, f); return (u + 0x7fffu + ((u >> 16) & 1u)) >> 16; }
__device__ __forceinline__ unsigned pk2(float lo, float hi) { return f2bf(lo) | (f2bf(hi) << 16); }

#define XB_TMO      128
#define XB_XCNT(j)  (256  + 64 * (j))
#define XB_XSUB(j)  (1280 + 64 * (j))
#define XB_XGEN(j)  (2304 + 64 * (j))
#define XB_TOP      3328
#define XB_TOPGEN   3392
#define XCD_BAR_WORDS 3456
#define XB_SPIN_CAP (1u << 18)

__device__ __forceinline__ unsigned xb_ld(unsigned* p)              { return __hip_atomic_load(p, __ATOMIC_RELAXED, __HIP_MEMORY_SCOPE_AGENT); }
__device__ __forceinline__ unsigned xb_add(unsigned* p, unsigned v) { return __hip_atomic_fetch_add(p, v, __ATOMIC_RELAXED, __HIP_MEMORY_SCOPE_AGENT); }
__device__ __forceinline__ unsigned xb_xcc_id() { return (unsigned)__builtin_amdgcn_s_getreg((3 << 11) | 20) & 0xFu; }
#define XB_SPIN(cond, bar) do { unsigned _sp = 0; while (cond) { __builtin_amdgcn_s_sleep(1); \
    if ((++_sp & 255u) == 0u) { if (xb_ld(&(bar)[XB_TMO])) break; if (_sp > XB_SPIN_CAP) { atomicAdd(&(bar)[XB_TMO], 1u); break; } } } } while (0)

struct XcdBarrier {
    unsigned* bar; unsigned x;
    volatile LAS unsigned* st;
};

__device__ __forceinline__ XcdBarrier xcd_barrier_post(unsigned* bar, volatile LAS unsigned* st) {
    XcdBarrier b; b.bar = bar; b.x = xb_xcc_id(); b.st = st;
    if (threadIdx.x == 0) (void)xb_add(&bar[XB_XCNT(b.x)], 1u);
    return b;
}
__device__ __forceinline__ void xcd_barrier_complete(unsigned* bar, unsigned x, unsigned& nloc, unsigned& nx) {
    const unsigned G = gridDim.x * gridDim.y * gridDim.z;
    unsigned sum, cnt, mine, sp = 0u;
    for (;;) {
        sum = 0u; cnt = 0u; mine = 0u;
#pragma unroll
        for (unsigned j = 0; j < 16; ++j) { const unsigned c = xb_ld(&bar[XB_XCNT(j)]); sum += c; cnt += (c > 0u) ? 1u : 0u; mine = (j == x) ? c : mine; }
        if (sum == G) break;
        __builtin_amdgcn_s_sleep(1);
        if ((++sp & 255u) == 0u) { if (xb_ld(&bar[XB_TMO])) break; if (sp > XB_SPIN_CAP) { atomicAdd(&bar[XB_TMO], 1u); break; } }
    }
    nloc = mine > 0u ? mine : 1u; nx = cnt > 0u ? cnt : 1u;
}

__device__ __forceinline__ void xcd_barrier(const XcdBarrier& b) {
    asm volatile("s_waitcnt vmcnt(0)" ::: "memory");
    __syncthreads();
    if (threadIdx.x == 0) {
        unsigned* bar = b.bar;
        __builtin_amdgcn_s_waitcnt(0);
        unsigned nloc = b.st[0], nx = b.st[1];
        if (nloc == 0u) { xcd_barrier_complete(bar, b.x, nloc, nx); b.st[0] = nloc; b.st[1] = nx; }
        const unsigned old = xb_add(&bar[XB_XSUB(b.x)], 1u);
        const unsigned gen = old / nloc;
        if (old + 1u == (gen + 1u) * nloc) {
            __builtin_amdgcn_fence(__ATOMIC_RELEASE, "agent");
            asm volatile("s_waitcnt vmcnt(0)" ::: "memory");
            const unsigned og = xb_add(&bar[XB_TOP], 1u);
            const unsigned tg = og / nx;
            if (og + 1u == (tg + 1u) * nx) xb_add(&bar[XB_TOPGEN], 1u);
            else XB_SPIN(xb_ld(&bar[XB_TOPGEN]) == tg, bar);
            __builtin_amdgcn_fence(__ATOMIC_ACQUIRE, "agent");
            xb_add(&bar[XB_XGEN(b.x)], 1u);
            asm volatile("s_waitcnt vmcnt(0)" ::: "memory");
        } else {
            XB_SPIN(xb_ld(&bar[XB_XGEN(b.x)]) == gen, bar);
            __builtin_amdgcn_fence(__ATOMIC_ACQUIRE, "agent");
            asm volatile("s_waitcnt vmcnt(0)" ::: "memory");
        }
    }
    __syncthreads();
}

constexpr int NWAVES = 8;
constexpr int NB = 8, SEQ = 2048, M = NB * SEQ, D = 1024, NH = 8, DH = 64, FW = 512, PW = 512, INW = 2056, DFF = 2816, NE = 8;
constexpr int SG = 64, SGH = 16, SP = 64;
constexpr int CL = 32, NCH = SEQ / CL, NBC = NB * NCH, KA = 2 * SP + CL * SGH;
constexpr float EPS = 1e-6f, LOG2E = 1.4426950408889634f;
static_assert(KA == 640 && NBC == 512, "ssm chunk geometry");

constexpr size_t MiB = 1u << 20, KiB = 1024;
constexpr size_t WS_CTL = 0, CTL_ZERO_BYTES = 1 * MiB;
constexpr size_t WS_LOGF = 1 * MiB;
constexpr size_t WS_FNEG = WS_LOGF + 512 * KiB;
constexpr size_t WS_SSQ1 = 2 * MiB;
constexpr size_t WS_SSQ2 = WS_SSQ1 + 256 * KiB;
constexpr size_t WS_AL   = WS_SSQ2 + 256 * KiB;
constexpr size_t WS_TOKE = WS_AL + 64 * KiB;
constexpr size_t WS_GATE = WS_TOKE + 64 * KiB;
constexpr size_t WS_POS  = WS_GATE + 128 * KiB;
constexpr size_t WS_CNT  = WS_POS + 128 * KiB;
constexpr size_t WS_TAB  = WS_CNT + 16 * KiB;
constexpr size_t WS_TOKS = WS_TAB + 16 * KiB;
constexpr size_t WS_RS0  = 3 * MiB + 256 * KiB;
static_assert(WS_TOKS + (2 * M + 256) * 4 <= 4 * MiB, "small tables");
constexpr size_t WS_WIN0 = 4 * MiB;
constexpr size_t WS_WOT  = 8 * MiB;
constexpr size_t WS_W13  = 10 * MiB;
constexpr size_t WS_W2T  = 21 * MiB;
constexpr size_t WS_WIN1 = 27 * MiB;
constexpr size_t WS_WGLU = 29 * MiB;
constexpr size_t WS_W13E = 34 * MiB;
constexpr size_t WS_BT2  = 34 * MiB;
constexpr size_t WS_MG   = 74 * MiB;
constexpr size_t WS_YS   = 34 * MiB;
constexpr size_t WS_YP   = 70 * MiB;
constexpr size_t WS_W2E  = 122 * MiB;
constexpr size_t WS_R    = 166 * MiB;
constexpr size_t WS_H0   = WS_R;
constexpr size_t WS_QKVP = WS_R + 32 * MiB;
constexpr size_t WS_ACT0 = WS_R + 96 * MiB;
constexpr size_t WS_MIX  = WS_ACT0;
constexpr size_t WS_ACTS = WS_R + 32 * MiB;
constexpr size_t WS_H3   = 344 * MiB;
constexpr size_t WS_END  = 376 * MiB;
static_assert(WS_ACTS + (size_t)(2 * M + 256) * DFF <= WS_H3 && WS_ACT0 + (size_t)M * DFF * 2 <= WS_END && WS_W13E + (size_t)NE * 2 * DFF * D * 2 <= WS_W2E && WS_W2E + (size_t)NE * D * DFF * 2 <= WS_R, "d_ws map");
static_assert(WS_MG + (size_t)SG * 128 * 512 * 2 <= WS_W2E && WS_BT2 + (size_t)SG * 512 * KA * 2 <= WS_MG && WS_YS + (size_t)(2 * M + 256) * D * 2 <= WS_W2E, "d_ws map 2");
constexpr int CW_BAR = 4096;
constexpr int CW_W2E = 192;
constexpr int CW_RDY = 64;

constexpr int RING_OFF = 0, RING_BYTES = 131072;
constexpr int LDSCTL_OFF = RING_BYTES, MISC_OFF = LDSCTL_OFF + 320;
constexpr int LDS_BYTES = 147456;
static_assert(MISC_OFF + 128 <= LDS_BYTES && attn_body::ATTN_LDS_BYTES <= RING_BYTES, "LDS map");

struct Args { const float* in[30]; float* out; unsigned char* ws; int ph_lo, ph_hi; };
enum { I_X = 0, I_N0, I_WIN0, I_BF, I_WPOOL, I_PSCALE, I_WOUT, I_N1, I_W1, I_W3, I_W2, I_N2, I_WIN1, I_ARE, I_AIM, I_LOGDT, I_BRE, I_BIM, I_CRE, I_CIM, I_SD, I_GA, I_GB, I_N3, I_RW, I_RB, I_EW1, I_EW3, I_EW2, I_NF };

__device__ __forceinline__ float wave_sum(float v) {
#pragma unroll
    for (int o = 1; o < 64; o <<= 1) v += __shfl_xor(v, o);
    return v;
}
__device__ __forceinline__ void transpose_item(const float* W, int ldw, int k0, int c0, const float* gain, bf16* WT, int ldt, int drow0, LAS unsigned char* scr, int lane) {
    const int lr = lane >> 4, lc = lane & 15; f32x4 v[16];
    const GAS f32x4* src = (const GAS f32x4*)(W + (size_t)(k0 + lr) * ldw + c0) + lc;
#pragma unroll
    for (int i = 0; i < 16; ++i) v[i] = __builtin_nontemporal_load(src + (size_t)i * ldw);
    if (gain) {
#pragma unroll
        for (int i = 0; i < 16; ++i) v[i] = v[i] * gain[k0 + 4 * i + lr];
    }
#pragma unroll
    for (int i = 0; i < 16; ++i) { typedef unsigned u32x2v __attribute__((ext_vector_type(2))); u32x2v w; w.x = pk2(v[i].x, v[i].y); w.y = pk2(v[i].z, v[i].w);
        *(LAS u32x2v*)(scr + (4 * i + lr) * 136 + 8 * lc) = w; }
    LDS_WAIT(); asm volatile("" ::: "memory");
    const int c = lane & 7;
#pragma unroll
    for (int it = 0; it < 4; ++it) { const int np = (lane >> 3) + 8 * it; unsigned w[8];
#pragma unroll
        for (int j = 0; j < 8; ++j) w[j] = *(const LAS unsigned*)(scr + (8 * c + j) * 136 + 4 * np);
        v4u lo, hi;
        lo.x = (w[0] & 0xffffu) | (w[1] << 16); lo.y = (w[2] & 0xffffu) | (w[3] << 16); lo.z = (w[4] & 0xffffu) | (w[5] << 16); lo.w = (w[6] & 0xffffu) | (w[7] << 16);
        hi.x = (w[0] >> 16) | (w[1] & 0xffff0000u); hi.y = (w[2] >> 16) | (w[3] & 0xffff0000u); hi.z = (w[4] >> 16) | (w[5] & 0xffff0000u); hi.w = (w[6] >> 16) | (w[7] & 0xffff0000u);
        bf16* o = WT + (size_t)(drow0 + 2 * np) * ldt + k0 + 8 * c;
        *(GAS v4u*)o = lo; *(GAS v4u*)(o + ldt) = hi; }
    LDS_WAIT(); asm volatile("" ::: "memory");
}

__device__ __forceinline__ unsigned pk4_fp8(float a, float b, float c, float d) { int w = 0; w = __builtin_amdgcn_cvt_pk_fp8_f32(a, b, w, false); w = __builtin_amdgcn_cvt_pk_fp8_f32(c, d, w, true); return (unsigned)w; }
constexpr float W8_SCALE = 64.0f, W8_INV = 1.0f / 64.0f;
__device__ __forceinline__ void transpose_item_f8(const float* W, int ldw, int k0, int c0, float scale, unsigned char* WT, int ldt, int drow0, LAS unsigned char* scr, int lane) {
    const int lr = lane >> 4, lc = lane & 15; f32x4 v[32];
    const GAS f32x4* src = (const GAS f32x4*)(W + (size_t)(k0 + lr) * ldw + c0) + lc;
#pragma unroll
    for (int i = 0; i < 32; ++i) v[i] = __builtin_nontemporal_load(src + (size_t)i * ldw);
#pragma unroll
    for (int i = 0; i < 32; ++i) *(LAS unsigned*)(scr + (4 * i + lr) * 68 + 4 * lc) = pk4_fp8(v[i].x * scale, v[i].y * scale, v[i].z * scale, v[i].w * scale);
    LDS_WAIT(); asm volatile("" ::: "memory");
#pragma unroll
    for (int it = 0; it < 2; ++it) { const int nq = lane & 15, c = (lane >> 4) + 4 * it; unsigned d[16];
#pragma unroll
        for (int j = 0; j < 16; ++j) d[j] = *(const LAS unsigned*)(scr + (16 * c + j) * 68 + 4 * nq);
        v4u y[4];
#pragma unroll
        for (int q = 0; q < 4; ++q) { const unsigned x0 = d[4 * q], x1 = d[4 * q + 1], x2 = d[4 * q + 2], x3 = d[4 * q + 3];
            const unsigned t01l = __builtin_amdgcn_perm(x1, x0, 0x05010400u), t01h = __builtin_amdgcn_perm(x1, x0, 0x07030602u), t23l = __builtin_amdgcn_perm(x3, x2, 0x05010400u), t23h = __builtin_amdgcn_perm(x3, x2, 0x07030602u);
            y[0][q] = __builtin_amdgcn_perm(t23l, t01l, 0x05040100u); y[1][q] = __builtin_amdgcn_perm(t23l, t01l, 0x07060302u); y[2][q] = __builtin_amdgcn_perm(t23h, t01h, 0x05040100u); y[3][q] = __builtin_amdgcn_perm(t23h, t01h, 0x07060302u); }
        unsigned char* o = WT + (size_t)(drow0 + 4 * nq) * ldt + k0 + 16 * c;
#pragma unroll
        for (int b = 0; b < 4; ++b) *(GAS v4u*)(o + (size_t)b * ldt) = y[b]; }
    LDS_WAIT(); asm volatile("" ::: "memory");
}

struct PlainProb {
    static constexpr bool GATHER = false;
    const bf16* A; const bf16* Bt; int lda, ldb, ntk;
    __device__ __forceinline__ void ptrs(const pg8::Unit& u, const char*& a, const char*& b, int& nt) const { a = (const char*)A + (size_t)u.pm * 256 * lda; b = (const char*)Bt + (size_t)u.pn * 256 * ldb; nt = ntk; }
    __device__ __forceinline__ void gather(const pg8::Unit&, const int (&)[2], const int (&)[2], unsigned (&)[2][2]) const {}
};
struct SsmProb {
    static constexpr bool GATHER = false;
    const bf16* AG; const bf16* BT; int lda, ldb;
    __device__ __forceinline__ void ptrs(const pg8::Unit& u, const char*& a, const char*& b, int& nt) const {
        a = (const char*)(AG + ((size_t)u.x2 * NBC + (size_t)u.pm * 256) * KA); b = (const char*)(BT + ((size_t)u.x2 * 512 + (size_t)u.pn * 256) * KA); nt = 6 + 4 * u.pn; }
    __device__ __forceinline__ void gather(const pg8::Unit&, const int (&)[2], const int (&)[2], unsigned (&)[2][2]) const {}
};
struct SsmOrder {
    int vcu, G;
    __device__ __forceinline__ bool next(int i, pg8::Unit& u) const { const int L = i * G + vcu; if (L >= 256) return false; u.x2 = L >> 2; u.pm = (L >> 1) & 1; u.pn = L & 1; u.x0 = 0; u.x1 = 0; u.kq = -1; return true; }
};
struct MoeOrder : pg8::GridOrder {
    const unsigned* tab;
    __device__ __forceinline__ bool next(int i, pg8::Unit& u) const {
        if (!tile(i, u.pm, u.pn)) return false;
        u.kq = -1; int e = 0;
#pragma unroll
        for (int k = 1; k < NE; ++k) e += ((int)tab[16 + k] <= u.pm) ? 1 : 0;
        u.x2 = e; u.x0 = (int)tab[e] + 256 * (u.pm - (int)tab[16 + e]); u.x1 = (int)tab[e + 1]; return true;
    }
};
constexpr int YP_ROWS = 8 * 256 + 256, MAIN_TILES = 128;
struct MoeDownOrder {
    pg8::GridOrder G4; const unsigned* tab; int nM, G, c, nmain_c;
    __device__ __forceinline__ void init(const unsigned* tab_, int G_, int c_) { tab = tab_; nM = (int)tab[24]; G = G_; c = c_; const int nmt = nM < MAIN_TILES ? nM : MAIN_TILES; G4.init(nmt, D / 256, G_, c_); nmain_c = (G4.nwg - c_ + G_ - 1) / G_; if (nmain_c < 0) nmain_c = 0; }
    __device__ __forceinline__ bool next(int i, pg8::Unit& u) const {
        if (i < nmain_c) { if (!G4.tile(i, u.pm, u.pn)) return false; u.kq = -1; }
        else if (i == nmain_c) { const int nl = nM - MAIN_TILES; if (nl <= 0 || c >= 16 * nl) return false; u.pm = MAIN_TILES + c / 16; u.pn = (c >> 2) & 3; u.kq = c & 3; }
        else return false;
        int e = 0;
#pragma unroll
        for (int k = 1; k < NE; ++k) e += ((int)tab[16 + k] <= u.pm) ? 1 : 0;
        u.x2 = e; u.x0 = (int)tab[e] + 256 * (u.pm - (int)tab[16 + e]); u.x1 = (int)tab[e + 1]; return true;
    }
};
struct MoeUpProb {
    static constexpr bool GATHER = true;
    const unsigned char* H3; const unsigned char* W; const unsigned* toks; int lda, ldb;
    __device__ __forceinline__ void ptrs(const pg8::Unit& u, const char*& a, const char*& b, int& nt) const { a = (const char*)H3; b = (const char*)(W + ((size_t)u.x2 * (2 * DFF) + (size_t)u.pn * 256) * D); nt = D / 128; }
    __device__ __forceinline__ void gather(const pg8::Unit& u, const int (&pR)[2], const int (&pC)[2], unsigned (&V)[2][2]) const {
#pragma unroll
        for (int h = 0; h < 2; ++h)
#pragma unroll
            for (int i = 0; i < 2; ++i) V[h][i] = toks[u.x0 + 128 * h + pR[i]] * (unsigned)D + (unsigned)(pC[i] * 2);
    }
};
struct MoeDownProb {
    static constexpr bool GATHER = false;
    const unsigned char* ACTS; const unsigned char* W; int lda, ldb;
    __device__ __forceinline__ void ptrs(const pg8::Unit& u, const char*& a, const char*& b, int& nt) const { const int k0 = u.kq < 0 ? 0 : 6 * u.kq;
        a = (const char*)(ACTS + (size_t)u.x0 * DFF) + 128 * k0; b = (const char*)(W + ((size_t)u.x2 * D + (size_t)u.pn * 256) * DFF) + 128 * k0; nt = u.kq < 0 ? DFF / 128 : (u.kq == 3 ? 4 : 6); }
    __device__ __forceinline__ void gather(const pg8::Unit&, const int (&)[2], const int (&)[2], unsigned (&)[2][2]) const {}
};

using pg8::u32x4; using pg8::Unit; using pg8::cvt_pk_bf16;
#define ACC_T const pg8::f32x4 (&acc)[2][2][4][2]

struct EpiSplitBf16 {
    static constexpr bool PERM = true, AFTER_DRAIN = false;
    bf16* O; float scale0; const LAS float* RSL;
    __device__ __forceinline__ void operator()(ACC_T, const Unit& u, int wr, int wc, int fr, int fq) const {
        const int t = u.pn >> 1; bf16* base = O + (size_t)t * M * 512; const float sc0 = (t == 0) ? scale0 : 1.f;
        const int row0 = u.pm * 256 + wr * 64 + fr, col0 = (u.pn & 1) * 256 + wc * 32 + 8 * fq;
#pragma unroll
        for (int ai = 0; ai < 2; ++ai)
#pragma unroll
            for (int m = 0; m < 4; ++m) { bf16* rowp = base + (size_t)(row0 + ai * 128 + m * 16) * 512 + col0; const float sc = sc0 * RSL[u.x1 * 256 + ai * 128 + wr * 64 + m * 16 + fr];
#pragma unroll
                for (int bj = 0; bj < 2; ++bj) { const f32x4 v0 = acc[ai][bj][m][0] * sc, v1 = acc[ai][bj][m][1] * sc;
                    u32x4 w; w.x = cvt_pk_bf16(v0[0], v0[1]); w.y = cvt_pk_bf16(v0[2], v0[3]); w.z = cvt_pk_bf16(v1[0], v1[1]); w.w = cvt_pk_bf16(v1[2], v1[3]);
                    *(u32x4*)(rowp + bj * 128) = w; } }
    }
};
__device__ __forceinline__ f32x4 bf16x4_lo(u32x4 w) { return (f32x4){__uint_as_float(w.x << 16), __uint_as_float(w.x & 0xffff0000u), __uint_as_float(w.y << 16), __uint_as_float(w.y & 0xffff0000u)}; }
__device__ __forceinline__ f32x4 bf16x4_hi(u32x4 w) { return (f32x4){__uint_as_float(w.z << 16), __uint_as_float(w.z & 0xffff0000u), __uint_as_float(w.w << 16), __uint_as_float(w.w & 0xffff0000u)}; }
template <bool BASE_F32> struct EpiResid {
    static constexpr bool PERM = true, AFTER_DRAIN = true;
    const void* base; bf16* outb; float* ssq;
    __device__ __forceinline__ void fused(pg8::f32x4 (&acc)[2][2][4][2], const Unit& u, int wr, int wc, int fr, int fq, LAS unsigned char* lds, int wid, int lane) const {
        LAS float* Pq = (LAS float*)lds;
        const int col0 = u.pn * 256 + wc * 32 + 8 * fq;
#pragma unroll
        for (int ai = 0; ai < 2; ++ai)
#pragma unroll
            for (int m = 0; m < 4; ++m) { const int rl = ai * 128 + wr * 64 + m * 16 + fr; const size_t off = (size_t)(u.pm * 256 + rl) * D + col0; float s = 0.f;
#pragma unroll
                for (int bj = 0; bj < 2; ++bj) { f32x4 b0, b1;
                    if constexpr (BASE_F32) { const float* bp = (const float*)base + off + bj * 128; b0 = __builtin_nontemporal_load((const f32x4*)bp); b1 = __builtin_nontemporal_load((const f32x4*)(bp + 4)); }
                    else { const u32x4 bw = *(const u32x4*)((const bf16*)base + off + bj * 128); b0 = bf16x4_lo(bw); b1 = bf16x4_hi(bw); }
                    const f32x4 o0 = b0 + acc[ai][bj][m][0], o1 = b1 + acc[ai][bj][m][1];
                    u32x4 w; w.x = cvt_pk_bf16(o0[0], o0[1]); w.y = cvt_pk_bf16(o0[2], o0[3]); w.z = cvt_pk_bf16(o1[0], o1[1]); w.w = cvt_pk_bf16(o1[2], o1[3]);
                    *(u32x4*)(outb + off + bj * 128) = w;
                    s += ((o0[0] * o0[0] + o0[1] * o0[1]) + (o0[2] * o0[2] + o0[3] * o0[3])) + ((o1[0] * o1[0] + o1[1] * o1[1]) + (o1[2] * o1[2] + o1[3] * o1[3])); }
                s += __shfl_xor(s, 16); s += __shfl_xor(s, 32);
                if (fq == 0) Pq[rl * 4 + wc] = s;
                if (BASE_F32 && m == 3) asm volatile("" ::: "memory"); }
        asm volatile("s_waitcnt lgkmcnt(0)" ::: "memory"); __builtin_amdgcn_s_barrier(); asm volatile("" ::: "memory");
        const int tid = wid * 64 + lane;
        if (tid < 256) { const f32x4 p = *(const LAS f32x4*)(Pq + tid * 4); ssq[(size_t)(u.pm * 256 + tid) * 4 + u.pn] = (p[0] + p[1]) + (p[2] + p[3]); }
    }
};
constexpr int RS_OFF = RING_BYTES + 512, RS_SLOTS = 6;
static_assert(RS_OFF + RS_SLOTS * 256 * 4 <= LDS_BYTES, "rs table");
template <class Sched> __device__ __forceinline__ void fill_rs(LAS float* RSL, const float* ssq, const Sched& S, int tid) {
    for (int i0 = 0; i0 < RS_SLOTS; i0 += 2) { const int i = i0 + (tid >> 8); int pm, pn;
        if (S.tile(i, pm, pn)) { const f32x4 q = *(const f32x4*)(ssq + (size_t)(pm * 256 + (tid & 255)) * 4); RSL[i * 256 + (tid & 255)] = __builtin_amdgcn_rsqf(((q[0] + q[1]) + (q[2] + q[3])) * (1.0f / D) + EPS); } }
    __syncthreads();
}
template <class Sched> __device__ __forceinline__ void fill_rs_direct(LAS float* RSL, const float* rs, const Sched& S, int tid) {
    for (int i0 = 0; i0 < RS_SLOTS; i0 += 2) { const int i = i0 + (tid >> 8); int pm, pn; if (S.tile(i, pm, pn)) RSL[i * 256 + (tid & 255)] = rs[pm * 256 + (tid & 255)]; }
    __syncthreads();
}
constexpr int UT_OFF = RS_OFF + RS_SLOTS * 256 * 4, UT_MAX = 16;
static_assert(UT_OFF + UT_MAX * 32 <= LDS_BYTES, "unit table");
struct TableOrder {
    const LAS int* T;
    __device__ __forceinline__ bool next(int i, pg8::Unit& u) const {
        if (i >= UT_MAX) return false; const LAS int* t = T + i * 8;
        if (__builtin_amdgcn_readfirstlane(t[5]) == 0) return false;
        u.pm = __builtin_amdgcn_readfirstlane(t[0]); u.pn = __builtin_amdgcn_readfirstlane(t[1]); u.x0 = __builtin_amdgcn_readfirstlane(t[2]); u.x1 = __builtin_amdgcn_readfirstlane(t[3]); u.x2 = __builtin_amdgcn_readfirstlane(t[4]); u.kq = __builtin_amdgcn_readfirstlane(t[6]); return true;
    }
};
template <class Sched> __device__ __forceinline__ TableOrder build_units(LAS unsigned char* lds, const Sched& S, int tid) {
    LAS int* T = (LAS int*)(lds + UT_OFF);
    if (tid < UT_MAX) { pg8::Unit u; const bool ok = S.next(tid, u); T[tid * 8 + 0] = u.pm; T[tid * 8 + 1] = u.pn; T[tid * 8 + 2] = u.x0; T[tid * 8 + 3] = u.x1; T[tid * 8 + 4] = u.x2; T[tid * 8 + 5] = ok ? 1 : 0; T[tid * 8 + 6] = u.kq; }
    __syncthreads();
    return TableOrder{T};
}
__device__ __forceinline__ pg8::f32x2 swiglu_pk(pg8::f32x2 a, pg8::f32x2 b, float c1, float c2) {
    pg8::f32x2 t = a * c1; t.x = __builtin_amdgcn_exp2f(t.x); t.y = __builtin_amdgcn_exp2f(t.y);
    const pg8::f32x2 d = t + 1.0f; pg8::f32x2 r; r.x = __builtin_amdgcn_rcpf(d.x); r.y = __builtin_amdgcn_rcpf(d.y);
    return (a * b) * (r * c2);
}
struct EpiSwiglu {
    static constexpr bool PERM = true, AFTER_DRAIN = false;
    bf16* O; const LAS float* RSL;
    __device__ __forceinline__ void operator()(ACC_T, const Unit& u, int wr, int wc, int fr, int fq) const {
        const int col0 = u.pn * 128 + wc * 32 + 8 * fq;
#pragma unroll
        for (int ai = 0; ai < 2; ++ai)
#pragma unroll
            for (int m = 0; m < 4; ++m) { const int rl = ai * 128 + wr * 64 + m * 16 + fr, row = u.pm * 256 + rl; const float rs = RSL[u.x1 * 256 + rl];
                const f32x4 a0 = acc[ai][0][m][0], a1 = acc[ai][0][m][1], b0 = acc[ai][1][m][0], b1 = acc[ai][1][m][1]; const float c1 = -LOG2E * rs, c2 = rs * rs;
                const pg8::f32x2 v0 = swiglu_pk((pg8::f32x2){a0[0], a0[1]}, (pg8::f32x2){b0[0], b0[1]}, c1, c2), v1 = swiglu_pk((pg8::f32x2){a0[2], a0[3]}, (pg8::f32x2){b0[2], b0[3]}, c1, c2);
                const pg8::f32x2 v2 = swiglu_pk((pg8::f32x2){a1[0], a1[1]}, (pg8::f32x2){b1[0], b1[1]}, c1, c2), v3 = swiglu_pk((pg8::f32x2){a1[2], a1[3]}, (pg8::f32x2){b1[2], b1[3]}, c1, c2);
                u32x4 w; w.x = cvt_pk_bf16(v0.x, v0.y); w.y = cvt_pk_bf16(v1.x, v1.y); w.z = cvt_pk_bf16(v2.x, v2.y); w.w = cvt_pk_bf16(v3.x, v3.y);
                *(u32x4*)(O + (size_t)row * DFF + col0) = w; }
    }
};
struct EpiSsmU {
    static constexpr bool PERM = true, AFTER_DRAIN = false;
    bf16* AG; const LAS float* RSL;
    __device__ __forceinline__ void operator()(ACC_T, const Unit& u, int wr, int wc, int fr, int fq) const {
#pragma unroll
        for (int ai = 0; ai < 2; ++ai)
#pragma unroll
            for (int m = 0; m < 4; ++m) { const int rl = ai * 128 + wr * 64 + m * 16 + fr, row = u.pm * 256 + rl; const float rs = RSL[u.x1 * 256 + rl]; const int bc = row >> 5, l = row & 31;
#pragma unroll
                for (int bj = 0; bj < 2; ++bj) { const int c0 = u.pn * 256 + bj * 128 + wc * 32 + 8 * fq, g = c0 >> 4, h0 = c0 & 15; const f32x4 v0 = acc[ai][bj][m][0] * rs, v1 = acc[ai][bj][m][1] * rs;
                    u32x4 w; w.x = cvt_pk_bf16(v0[0], v0[1]); w.y = cvt_pk_bf16(v0[2], v0[3]); w.z = cvt_pk_bf16(v1[0], v1[1]); w.w = cvt_pk_bf16(v1[2], v1[3]);
                    *(u32x4*)(AG + ((size_t)g * NBC + bc) * KA + 2 * SP + l * SGH + h0) = w; } }
    }
};
struct EpiGelu {
    static constexpr bool PERM = true, AFTER_DRAIN = false;
    bf16* GB;
    __device__ __forceinline__ void operator()(ACC_T, const Unit& u, int wr, int wc, int fr, int fq) const {
#pragma unroll
        for (int ai = 0; ai < 2; ++ai)
#pragma unroll
            for (int m = 0; m < 4; ++m) { const int bc = u.pm * 256 + ai * 128 + wr * 64 + m * 16 + fr;
#pragma unroll
                for (int bj = 0; bj < 2; ++bj) { const int n0 = u.pn * 256 + bj * 128 + wc * 32 + 8 * fq, l = n0 >> 4, h0 = n0 & 15; const f32x4 v0 = acc[ai][bj][m][0], v1 = acc[ai][bj][m][1];
                    u32x4 w; w.x = cvt_pk_bf16(pg8::gelu_tanh(v0[0]), pg8::gelu_tanh(v0[1])); w.y = cvt_pk_bf16(pg8::gelu_tanh(v0[2]), pg8::gelu_tanh(v0[3]));
                    w.z = cvt_pk_bf16(pg8::gelu_tanh(v1[0]), pg8::gelu_tanh(v1[1])); w.w = cvt_pk_bf16(pg8::gelu_tanh(v1[2]), pg8::gelu_tanh(v1[3]));
                    *(u32x4*)(GB + ((size_t)bc * CL + l) * D + u.x2 * SGH + h0) = w; } }
    }
};
struct EpiGlu {
    static constexpr bool PERM = true, AFTER_DRAIN = false;
    bf16* X;
    __device__ __forceinline__ void operator()(ACC_T, const Unit& u, int wr, int wc, int fr, int fq) const {
        const int col0 = u.pn * 128 + wc * 32 + 8 * fq;
#pragma unroll
        for (int ai = 0; ai < 2; ++ai)
#pragma unroll
            for (int m = 0; m < 4; ++m) { bf16* pp = X + (size_t)(u.pm * 256 + ai * 128 + wr * 64 + m * 16 + fr) * D + col0; const u32x4 xw = *(const u32x4*)pp;
                f32x4 o0 = bf16x4_lo(xw), o1 = bf16x4_hi(xw); const f32x4 a0 = acc[ai][0][m][0], a1 = acc[ai][0][m][1], b0 = acc[ai][1][m][0], b1 = acc[ai][1][m][1];
#pragma unroll
                for (int i = 0; i < 4; ++i) { o0[i] += a0[i] * pg8::fast_sigmoid(b0[i]); o1[i] += a1[i] * pg8::fast_sigmoid(b1[i]); }
                u32x4 w; w.x = cvt_pk_bf16(o0[0], o0[1]); w.y = cvt_pk_bf16(o0[2], o0[3]); w.z = cvt_pk_bf16(o1[0], o1[1]); w.w = cvt_pk_bf16(o1[2], o1[3]);
                *(u32x4*)pp = w; }
    }
};
struct EpiSwigluF8 {
    static constexpr bool PERM = true, AFTER_DRAIN = false;
    unsigned char* O;
    __device__ __forceinline__ void operator()(ACC_T, const Unit& u, int wr, int wc, int fr, int fq) const {
        const int col0 = u.pn * 128 + wc * 32 + 8 * fq;
#pragma unroll
        for (int ai = 0; ai < 2; ++ai)
#pragma unroll
            for (int m = 0; m < 4; ++m) { const int row = u.x0 + ai * 128 + wr * 64 + m * 16 + fr;
                const f32x4 a0 = acc[ai][0][m][0], a1 = acc[ai][0][m][1], b0 = acc[ai][1][m][0], b1 = acc[ai][1][m][1]; constexpr float c1 = -LOG2E * W8_INV, c2 = W8_INV * W8_INV;
                const pg8::f32x2 v0 = swiglu_pk((pg8::f32x2){a0[0], a0[1]}, (pg8::f32x2){b0[0], b0[1]}, c1, c2), v1 = swiglu_pk((pg8::f32x2){a0[2], a0[3]}, (pg8::f32x2){b0[2], b0[3]}, c1, c2);
                const pg8::f32x2 v2 = swiglu_pk((pg8::f32x2){a1[0], a1[1]}, (pg8::f32x2){b1[0], b1[1]}, c1, c2), v3 = swiglu_pk((pg8::f32x2){a1[2], a1[3]}, (pg8::f32x2){b1[2], b1[3]}, c1, c2);
                pg8::u32x2 w; w.x = pk4_fp8(v0.x, v0.y, v1.x, v1.y); w.y = pk4_fp8(v2.x, v2.y, v3.x, v3.y);
                if (row < u.x1) *(pg8::u32x2*)(O + (size_t)row * DFF + col0) = w; }
    }
};
struct EpiMaskF8 {
    static constexpr bool PERM = true, AFTER_DRAIN = false;
    unsigned char* Y; unsigned char* YP; int rowL;
    __device__ __forceinline__ void operator()(ACC_T, const Unit& u, int wr, int wc, int fr, int fq) const {
#pragma unroll
        for (int ai = 0; ai < 2; ++ai)
#pragma unroll
            for (int m = 0; m < 4; ++m) { const int row = u.x0 + ai * 128 + wr * 64 + m * 16 + fr;
                unsigned char* dst = (u.kq <= 0) ? Y + (size_t)row * D : YP + ((size_t)(u.kq - 1) * YP_ROWS + (size_t)(row - rowL)) * D;
#pragma unroll
                for (int bj = 0; bj < 2; ++bj) { const f32x4 v0 = acc[ai][bj][m][0] * W8_INV, v1 = acc[ai][bj][m][1] * W8_INV;
                    pg8::u32x2 w; w.x = pk4_fp8(v0[0], v0[1], v0[2], v0[3]); w.y = pk4_fp8(v1[0], v1[1], v1[2], v1[3]);
                    if (row < u.x1) *(pg8::u32x2*)(dst + u.pn * 256 + bj * 128 + wc * 32 + 8 * fq) = w; } }
    }
};

struct Frame {
    LAS unsigned char* lds; volatile LAS unsigned* MISC; gu32* ctl;
    int tid, lane, wave, vcu, G;
    const float* const __attribute__((address_space(4)))* in;
    float* out; unsigned char* ws;
};
#define WSP(T, off) ((T*)(F.ws + (off)))

__device__ __forceinline__ void tr_job(const float* W, int ldw, int ncb, int cbase, const float* gain, bf16* WT, int ldt, int mode, int rowoff, int item, LAS unsigned char* scr, int lane) {
    const int kb = item / ncb, nb = item % ncb, n0 = 64 * nb;
    const int drow0 = (mode == 0) ? rowoff + n0 : (n0 >> 7) * 256 + (n0 & 127) + rowoff;
    transpose_item(W, ldw, 64 * kb, cbase + n0, gain, WT, ldt, drow0, scr, lane);
}

__device__ __forceinline__ void tr_job_f8(const float* W, int ldw, int ncb, unsigned char* WT, int ldt, int mode, int rowoff, int item, LAS unsigned char* scr, int lane) {
    const int kb = item / ncb, nb = item % ncb, n0 = 64 * nb;
    const int drow0 = (mode == 0) ? rowoff + n0 : (n0 >> 7) * 256 + (n0 & 127) + rowoff;
    transpose_item_f8(W, ldw, 128 * kb, n0, W8_SCALE, WT, ldt, drow0, scr, lane);
}

__device__ __forceinline__ void ssm_prep_job(Frame& F, int g, int q, bool fresh = true) {
    LAS float* PWR = (LAS float*)(F.lds + RING_OFF);
    LAS float* PWI = PWR + 33 * 64;
    LAS float* BBR = PWI + 33 * 64;
    LAS float* BBI = BBR + 1024;
    LAS float* CR = BBI + 1024;
    LAS float* CI = CR + 1024;
    LAS float* KT = CI + 1024;
    LAS float* COEF = KT + 2048;
    const int tid = F.tid;
    const float* are = F.in[I_ARE]; const float* aim = F.in[I_AIM]; const float* logdt = F.in[I_LOGDT];
    if (fresh) {
    float pbr[2], pbi[2], pcr[2], pci[2];
#pragma unroll
    for (int it = 0; it < 2; ++it) { const int i = tid + 512 * it; pbr[it] = F.in[I_BRE][g * 1024 + i]; pbi[it] = F.in[I_BIM][g * 1024 + i]; pcr[it] = F.in[I_CRE][g * 1024 + i]; pci[it] = F.in[I_CIM][g * 1024 + i]; }
    if (tid < 64) {
        const int p = tid; const float dt = expf(logdt[g]); const float ar = are[g * SP + p], ai = aim[g * SP + p];
        const float mag = expf(ar * dt), th = ai * dt; const float abr = mag * cosf(th), abi = mag * sinf(th);
        const float sh = sinf(0.5f * th); const float nr = expm1f(ar * dt) - 2.0f * mag * sh * sh, ni = abi;
        const float den = ar * ar + ai * ai;
        COEF[2 * p] = (nr * ar + ni * ai) / den; COEF[2 * p + 1] = (ni * ar - nr * ai) / den;
        float pr = 1.0f, pi = 0.0f;
        for (int t = 0; t <= CL; ++t) { PWR[t * 64 + p] = pr; PWI[t * 64 + p] = pi; const float nr2 = pr * abr - pi * abi, ni2 = pr * abi + pi * abr; pr = nr2; pi = ni2; }
        if (q == 0) { float* AL = WSP(float, WS_AL); AL[(g * SP + p) * 2] = PWR[CL * 64 + p]; AL[(g * SP + p) * 2 + 1] = PWI[CL * 64 + p]; }
    }
    __syncthreads();
#pragma unroll
    for (int it = 0; it < 2; ++it) { const int i = tid + 512 * it, p = i >> 4; const float cr = COEF[2 * p], ci = COEF[2 * p + 1];
        BBR[i] = cr * pbr[it] - ci * pbi[it]; BBI[i] = cr * pbi[it] + ci * pbr[it]; CR[i] = pcr[it]; CI[i] = pci[it]; }
    __syncthreads();
    }
    { const int tl = tid >> 6, h = (tid >> 2) & 15, pq = tid & 3, tau = 8 * q + tl; float a[16];
#pragma unroll
        for (int i = 0; i < 16; ++i) a[i] = 0.f;
#pragma unroll 4
        for (int pp = 0; pp < 16; ++pp) { const int p = 16 * pq + pp; const float cr = CR[h * 64 + p], ci = CI[h * 64 + p], pr = PWR[tau * 64 + p], pi = PWI[tau * 64 + p];
            const float zr = cr * pr - ci * pi, zi = cr * pi + ci * pr;
#pragma unroll
            for (int i4 = 0; i4 < 4; ++i4) { const f32x4 br = *(const LAS f32x4*)(BBR + p * 16 + 4 * i4), bi = *(const LAS f32x4*)(BBI + p * 16 + 4 * i4);
                a[4 * i4] += zr * br.x - zi * bi.x; a[4 * i4 + 1] += zr * br.y - zi * bi.y; a[4 * i4 + 2] += zr * br.z - zi * bi.z; a[4 * i4 + 3] += zr * br.w - zi * bi.w; } }
#pragma unroll
        for (int i = 0; i < 16; ++i) { a[i] += __shfl_xor(a[i], 1); a[i] += __shfl_xor(a[i], 2); }
        f32x4 o;
        o.x = pq == 0 ? a[0] : pq == 1 ? a[4] : pq == 2 ? a[8] : a[12]; o.y = pq == 0 ? a[1] : pq == 1 ? a[5] : pq == 2 ? a[9] : a[13];
        o.z = pq == 0 ? a[2] : pq == 1 ? a[6] : pq == 2 ? a[10] : a[14]; o.w = pq == 0 ? a[3] : pq == 1 ? a[7] : pq == 2 ? a[11] : a[15];
        if (tau == 0 && (h >> 2) == pq) { const float dv = F.in[I_SD][g * SGH + h]; if ((h & 3) == 0) o.x += dv; else if ((h & 3) == 1) o.y += dv; else if ((h & 3) == 2) o.z += dv; else o.w += dv; }
        *(LAS f32x4*)(KT + tl * 256 + h * 16 + 4 * pq) = o; }
    __syncthreads();
    bf16* BT = WSP(bf16, WS_BT2) + (size_t)g * 512 * KA; bf16* MG = WSP(bf16, WS_MG) + (size_t)g * 128 * 512;
    for (int it = tid; it < 8192; it += 512) { const int half = it & 1, h = (it >> 1) & 15, tl = (it >> 5) & 7, l = it >> 8, l2 = l - (8 * q + tl);
        if (l2 >= 0) { const LAS float* s = KT + tl * 256 + h * 16 + 8 * half; v4u o; o.x = pk2(s[0], s[1]); o.y = pk2(s[2], s[3]); o.z = pk2(s[4], s[5]); o.w = pk2(s[6], s[7]);
            *(GAS v4u*)(BT + (size_t)(16 * l + h) * KA + 128 + 16 * l2 + 8 * half) = o; } }
    for (int it = tid; it < 16384; it += 512) { const int half = it & 1, h = (it >> 1) & 15, dl = (it >> 5) & 15, l = it >> 9, l2 = l + dl;
        if (dl >= 1 && (dl & 3) == q && l2 <= 16 * (l >> 4) + 15) *(GAS v4u*)(BT + (size_t)(16 * l + h) * KA + 128 + 16 * l2 + 8 * half) = (v4u){0u, 0u, 0u, 0u}; }
    for (int it = tid; it < 2048; it += 512) { const int pc = it & 7, part = (it >> 3) & 1, h = (it >> 4) & 15, l = 8 * q + (it >> 8); float v[8];
#pragma unroll
        for (int j = 0; j < 8; ++j) { const int p = 8 * pc + j; const float cr = CR[h * 64 + p], ci = CI[h * 64 + p], pr = PWR[(l + 1) * 64 + p], pi = PWI[(l + 1) * 64 + p];
            v[j] = part == 0 ? (cr * pr - ci * pi) : -(cr * pi + ci * pr); }
        v4u o; o.x = pk2(v[0], v[1]); o.y = pk2(v[2], v[3]); o.z = pk2(v[4], v[5]); o.w = pk2(v[6], v[7]);
        *(GAS v4u*)(BT + (size_t)(16 * l + h) * KA + 64 * part + 8 * pc) = o; }
    for (int it = tid; it < 2048; it += 512) { const int half = it & 1, ll = (it >> 1) & 7, p = (it >> 4) & 63, part = it >> 10, l2 = 8 * q + ll; float v[8];
        const float pr = PWR[(CL - 1 - l2) * 64 + p], pi = PWI[(CL - 1 - l2) * 64 + p];
#pragma unroll
        for (int j = 0; j < 8; ++j) { const float br = BBR[p * 16 + 8 * half + j], bi = BBI[p * 16 + 8 * half + j]; v[j] = part == 0 ? (pr * br - pi * bi) : (pr * bi + pi * br); }
        v4u o; o.x = pk2(v[0], v[1]); o.y = pk2(v[2], v[3]); o.z = pk2(v[4], v[5]); o.w = pk2(v[6], v[7]);
        *(GAS v4u*)(MG + (size_t)(part * 64 + p) * 512 + 16 * l2 + 8 * half) = o; }
    __syncthreads();
}


__device__ __forceinline__ float reduce8(const float (&d)[8], int lane) {
    const bool b5 = lane & 32, b4 = lane & 16, b3 = lane & 8; float a[4], b[2];
#pragma unroll
    for (int i = 0; i < 4; ++i) { const float keep = b5 ? d[4 + i] : d[i], send = b5 ? d[i] : d[4 + i]; a[i] = keep + __shfl_xor(send, 32); }
#pragma unroll
    for (int i = 0; i < 2; ++i) { const float keep = b4 ? a[2 + i] : a[i], send = b4 ? a[i] : a[2 + i]; b[i] = keep + __shfl_xor(send, 16); }
    float c = (b3 ? b[1] : b[0]) + __shfl_xor(b3 ? b[0] : b[1], 8);
    c += __shfl_xor(c, 4); c += __shfl_xor(c, 2); c += __shfl_xor(c, 1);
    return c;
}
__device__ __forceinline__ void fill_w8(LAS float* WL, const float* W, int ldw, const float* gain, int tid) {
#pragma unroll
    for (int it = 0; it < 16; ++it) { const int idx = tid + 512 * it, k = idx >> 3, e = idx & 7; const float v = W[(size_t)k * ldw + e] * gain[k];
        WL[((((k >> 8) * 4 + (k & 3)) * 64 + ((k >> 2) & 63)) << 3) + e] = v; }
}
__device__ __forceinline__ void row_dots(const f32x4 (&v)[4], const LAS float* WL, int lane, float& rs, float& red) {
    float s = 0.f, dot[8];
#pragma unroll
    for (int e = 0; e < 8; ++e) dot[e] = 0.f;
#pragma unroll
    for (int j = 0; j < 4; ++j) { s += (v[j].x * v[j].x + v[j].y * v[j].y) + (v[j].z * v[j].z + v[j].w * v[j].w);
#pragma unroll
        for (int i = 0; i < 4; ++i) { const LAS f32x4* wp = (const LAS f32x4*)(WL + (((j * 4 + i) * 64 + lane) << 3)); const f32x4 w0 = wp[0], w1 = wp[1]; const float xv = v[j][i];
            dot[0] += xv * w0.x; dot[1] += xv * w0.y; dot[2] += xv * w0.z; dot[3] += xv * w0.w; dot[4] += xv * w1.x; dot[5] += xv * w1.y; dot[6] += xv * w1.z; dot[7] += xv * w1.w; } }
    rs = 1.0f / sqrtf(wave_sum(s) * (1.0f / D) + EPS);
    red = reduce8(dot, lane) * rs;
}

__device__ __forceinline__ void p0_prologue(Frame& F) {
    const int gw = F.vcu * NWAVES + F.wave, NGW = F.G * NWAVES;
#ifndef P0_REP_SSM
#define P0_REP_SSM 1
#define P0_REP_TR 1
#define P0_REP_FOLD 1
#define P0_REP_ROWS 1
#endif
#ifndef SSM_IN_P4
#define SSM_IN_P4 1
#endif
    if (!SSM_IN_P4 && (F.vcu & 1) == 0) {
    for (int rep = 0; rep < P0_REP_SSM; ++rep)
    for (int job = F.vcu; job < 4 * SG; job += F.G) ssm_prep_job(F, job >> 2, job & 3);
    }
    {
    LAS float* WFG = (LAS float*)(F.lds + RING_OFF + 98304);
    fill_w8(WFG, F.in[I_WIN0] + 3 * FW, INW, F.in[I_N0], F.tid);
    __syncthreads();
    LAS unsigned char* scr = F.lds + RING_OFF + F.wave * 8704;
    {
        constexpr int J1 = 16 * 24, J2 = 16 * 8, J3 = 8 * 16, J4 = 16 * 44, J5 = J4, J6 = 44 * 16, J7 = 16 * 16, J8 = J7, J9 = J7, NJ = J1 + J2 + J3 + J4 + J5 + J6 + J7 + J8 + J9;
        for (int rep = 0; rep < P0_REP_TR; ++rep)
        for (int it = gw; it < NJ; it += NGW) {
            int r = it;
            if (r < J1) { tr_job(F.in[I_WIN0], INW, 24, 0, F.in[I_N0], WSP(bf16, WS_WIN0), D, 0, 0, r, scr, F.lane); continue; } r -= J1;
            if (r < J2) { tr_job(F.in[I_WIN0], INW, 8, 3 * FW + NH, F.in[I_N0], WSP(bf16, WS_WIN0), D, 0, 3 * FW, r, scr, F.lane); continue; } r -= J2;
            if (r < J3) { tr_job(F.in[I_WOUT], D, 16, 0, nullptr, WSP(bf16, WS_WOT), D, 0, 0, r, scr, F.lane); continue; } r -= J3;
            if (r < J4) { tr_job(F.in[I_W1], DFF, 44, 0, F.in[I_N1], WSP(bf16, WS_W13), D, 1, 0, r, scr, F.lane); continue; } r -= J4;
            if (r < J5) { tr_job(F.in[I_W3], DFF, 44, 0, F.in[I_N1], WSP(bf16, WS_W13), D, 1, 128, r, scr, F.lane); continue; } r -= J5;
            if (r < J6) { tr_job(F.in[I_W2], D, 16, 0, nullptr, WSP(bf16, WS_W2T), DFF, 0, 0, r, scr, F.lane); continue; } r -= J6;
            if (r < J7) { tr_job(F.in[I_WIN1], D, 16, 0, F.in[I_N2], WSP(bf16, WS_WIN1), D, 0, 0, r, scr, F.lane); continue; } r -= J7;
            if (r < J8) { tr_job(F.in[I_GA], D, 16, 0, nullptr, WSP(bf16, WS_WGLU), D, 1, 0, r, scr, F.lane); continue; } r -= J8;
            tr_job(F.in[I_GB], D, 16, 0, nullptr, WSP(bf16, WS_WGLU), D, 1, 128, r, scr, F.lane);
        }
    }
    for (int rep = 0; rep < P0_REP_FOLD; ++rep)
    for (int it = gw; it < 16 * 64; it += NGW) {
        const int n = 64 * (it & 15) + F.lane, kk0 = 8 * (it >> 4), g = kk0 >> 7, kl0 = kk0 & 127;
        const float* wp = F.in[I_WPOOL] + ((size_t)g * 128 + kl0) * 128; const float* ps = F.in[I_PSCALE] + g * 128; const float* wo = F.in[I_WOUT] + (size_t)(FW + g * 128) * D + n;
        float a[8];
#pragma unroll
        for (int i = 0; i < 8; ++i) a[i] = 0.f;
#pragma unroll 16
        for (int j = 0; j < 128; ++j) { const float w = wo[(size_t)j * D] * ps[j];
#pragma unroll
            for (int i = 0; i < 8; ++i) a[i] += wp[i * 128 + j] * w; }
        v4u o; o.x = pk2(a[0], a[1]); o.y = pk2(a[2], a[3]); o.z = pk2(a[4], a[5]); o.w = pk2(a[6], a[7]);
        *(GAS v4u*)(WSP(bf16, WS_WOT) + (size_t)n * D + FW + kk0) = o;
    }
    for (int rep = 0; rep < P0_REP_ROWS; ++rep)
    {
        f32x4 nx[4];
        if (gw < M) { const GAS f32x4* xr = (const GAS f32x4*)(F.in[I_X] + (size_t)gw * D) + F.lane;
#pragma unroll
            for (int j = 0; j < 4; ++j) nx[j] = __builtin_nontemporal_load(xr + 64 * j); }
        for (int m = gw; m < M; m += NGW) {
            f32x4 v[4];
#pragma unroll
            for (int j = 0; j < 4; ++j) v[j] = nx[j];
            if (m + NGW < M) { const GAS f32x4* xr = (const GAS f32x4*)(F.in[I_X] + (size_t)(m + NGW) * D) + F.lane;
#pragma unroll
                for (int j = 0; j < 4; ++j) nx[j] = __builtin_nontemporal_load(xr + 64 * j); }
            float rs, red; row_dots(v, WFG, F.lane, rs, red);
            GAS unsigned long long* o8 = (GAS unsigned long long*)(WSP(bf16, WS_H0) + (size_t)m * D) + F.lane;
#pragma unroll
            for (int j = 0; j < 4; ++j) o8[64 * j] = (unsigned long long)pk2(v[j].x, v[j].y) | ((unsigned long long)pk2(v[j].z, v[j].w) << 32);
            if (F.lane == 0) WSP(float, WS_RS0)[m] = rs;
            if ((F.lane & 7) == 0) { const int e = F.lane >> 3; const float a = red + F.in[I_BF][e]; WSP(float, WS_LOGF)[(size_t)m * 8 + e] = fminf(a, 0.f) - log1pf(expf(-fabsf(a))); }
        }
    }
    __syncthreads();
    }
    if (!SSM_IN_P4 && (F.vcu & 1) != 0) { for (int job = F.vcu; job < 4 * SG; job += F.G) ssm_prep_job(F, job >> 2, job & 3); }
}

__device__ __forceinline__ void forget_cumsum(Frame& F, int b, int h) {
    const float* lf = WSP(float, WS_LOGF) + ((size_t)b * SEQ + 4 * F.tid) * 8 + h; float v[4]; float s = 0.f;
#pragma unroll
    for (int i = 0; i < 4; ++i) v[i] = lf[i * 8];
#pragma unroll
    for (int i = 0; i < 4; ++i) { s += v[i]; v[i] = s; }
    float incl = s;
#pragma unroll
    for (int o = 1; o < 64; o <<= 1) { const float t = __shfl_up(incl, o); if (F.lane >= o) incl += t; }
    LAS float* WT = (LAS float*)(F.lds + RING_OFF);
    if (F.lane == 63) WT[F.wave] = incl;
    __syncthreads();
    float off = incl - s;
#pragma unroll
    for (int w = 0; w < NWAVES; ++w) off += (w < F.wave) ? WT[w] : 0.f;
    *(f32x4*)(WSP(float, WS_FNEG) + ((size_t)b * NH + h) * SEQ + 4 * F.tid) = (f32x4){-(off + v[0]) * LOG2E, -(off + v[1]) * LOG2E, -(off + v[2]) * LOG2E, -(off + v[3]) * LOG2E};
    __syncthreads();
}

__device__ __forceinline__ void pool_rows(Frame& F, int row0) {
    const unsigned* Pp = (const unsigned*)(WSP(bf16, WS_QKVP) + (size_t)3 * M * 512); unsigned* mix = (unsigned*)WSP(bf16, WS_MIX);
    const int cp = F.tid & 255, half = F.tid >> 8, w = 2 << (cp >> 6), t0 = row0 + 32 * half, bs = t0 & ~(SEQ - 1);
    unsigned u[48];
#pragma unroll
    for (int i = 0; i < 48; ++i) { const int t = t0 - 16 + i; u[i] = (t >= bs) ? Pp[(size_t)t * 256 + cp] : 0u; }
    float s0 = 0.f, s1 = 0.f;
#pragma unroll
    for (int i = 0; i < 16; ++i) { if (16 - i <= w) { s0 += __uint_as_float(u[i] << 16); s1 += __uint_as_float(u[i] & 0xffff0000u); } }
#pragma unroll
    for (int i = 0; i < 32; ++i) { const int t = t0 + i; const float p0 = __uint_as_float(u[16 + i] << 16), p1 = __uint_as_float(u[16 + i] & 0xffff0000u);
        const unsigned uo = (w == 2) ? u[14 + i] : (w == 4) ? u[12 + i] : (w == 8) ? u[8 + i] : u[i];
        s0 += p0 - __uint_as_float(uo << 16); s1 += p1 - __uint_as_float(uo & 0xffff0000u);
        const int cnt = (t - bs + 1) < w ? (t - bs + 1) : w; const float ic = 1.0f / (float)cnt;
        mix[(size_t)t * 512 + 256 + cp] = pk2(s0 * ic - p0, s1 * ic - p1); }
}

__device__ __forceinline__ void ssm_state_unit(Frame& F, int g, int bp) {
    typedef short bf16x8v __attribute__((ext_vector_type(8)));
    LAS unsigned char* BL = F.lds + RING_OFF;
    LAS float* SL = (LAS float*)(F.lds + RING_OFF);
    LAS float* TL = SL + 128 * 132;
    bf16* AGg = WSP(bf16, WS_QKVP) + ((size_t)g * NBC + 128 * bp) * KA; const bf16* MGg = WSP(bf16, WS_MG) + (size_t)g * 128 * 512;
    const int r16 = F.lane & 15, quad = F.lane >> 4;
#pragma unroll
    for (int i = 0; i < 16; ++i) { const int n = 16 * F.wave + i, cs = (F.lane & ~7) | ((F.lane ^ n) & 7);
        __builtin_amdgcn_global_load_lds((const unsigned*)(MGg + (size_t)n * 512 + 8 * cs), (LAS unsigned*)(BL + n * 1024), 16, 0, 0); }
    f32x4 acc[8];
#pragma unroll
    for (int nb = 0; nb < 8; ++nb) acc[nb] = (f32x4){0.f, 0.f, 0.f, 0.f};
    const bf16* ap = AGg + (size_t)(16 * F.wave + r16) * KA + 128 + 8 * quad;
    bf16x8v a[8];
#pragma unroll
    for (int ks = 0; ks < 8; ++ks) a[ks] = *(const bf16x8v*)(ap + 32 * ks);
    asm volatile("s_waitcnt vmcnt(0)" ::: "memory"); __syncthreads();
    const int n7 = r16 & 7; const LAS unsigned char* be = BL + r16 * 1024 + 16 * (quad ^ n7); const LAS unsigned char* bo = BL + r16 * 1024 + 16 * ((4 + quad) ^ n7);
#pragma unroll 1
    for (int kh = 0; kh < 2; ++kh) {
#pragma unroll
        for (int ks = 0; ks < 8; ++ks) { const LAS unsigned char* bb = ((ks & 1) ? bo : be) + kh * 512 + (ks >> 1) * 128;
#pragma unroll
            for (int nb = 0; nb < 8; ++nb) { const bf16x8v b = *(const LAS bf16x8v*)(bb + nb * 16384); acc[nb] = __builtin_amdgcn_mfma_f32_16x16x32_bf16(a[ks], b, acc[nb], 0, 0, 0); } }
        if (kh == 0) {
#pragma unroll
            for (int ks = 0; ks < 8; ++ks) a[ks] = *(const bf16x8v*)(ap + 256 + 32 * ks); }
    }
    __syncthreads();
#pragma unroll
    for (int nb = 0; nb < 8; ++nb)
#pragma unroll
        for (int r = 0; r < 4; ++r) SL[(16 * F.wave + 4 * quad + r) * 132 + 16 * nb + r16] = acc[nb][r];
    __syncthreads();
    { const int seg = F.tid >> 7, b2 = (F.tid >> 6) & 1, p = F.tid & 63; const float alr = WSP(float, WS_AL)[(g * SP + p) * 2], ali = WSP(float, WS_AL)[(g * SP + p) * 2 + 1];
      float lr[16], li[16], xr = 0.f, xi = 0.f, pr = 1.f, pi = 0.f;
#pragma unroll
      for (int j = 0; j < 16; ++j) { const int row = b2 * NCH + 16 * seg + j; lr[j] = xr; li[j] = xi;
          const float sr = SL[row * 132 + p], si = SL[row * 132 + SP + p]; const float nr = alr * xr - ali * xi + sr, ni = alr * xi + ali * xr + si; xr = nr; xi = ni;
          const float qr = pr * alr - pi * ali, qi = pr * ali + pi * alr; pr = qr; pi = qi; }
      TL[(seg * 128 + b2 * 64 + p) * 2] = xr; TL[(seg * 128 + b2 * 64 + p) * 2 + 1] = xi;
      __syncthreads();
      float cr = 0.f, ci = 0.f;
      for (int s2 = 0; s2 < seg; ++s2) { const float tr = TL[(s2 * 128 + b2 * 64 + p) * 2], ti = TL[(s2 * 128 + b2 * 64 + p) * 2 + 1]; const float nr = pr * cr - pi * ci + tr, ni = pr * ci + pi * cr + ti; cr = nr; ci = ni; }
      float wr_ = 1.f, wi_ = 0.f;
#pragma unroll
      for (int j = 0; j < 16; ++j) { const int row = b2 * NCH + 16 * seg + j; bf16* o = AGg + (size_t)row * KA + p;
          o[0] = (bf16)f2bf(lr[j] + wr_ * cr - wi_ * ci); o[SP] = (bf16)f2bf(li[j] + wr_ * ci + wi_ * cr);
          const float qr = wr_ * alr - wi_ * ali, qi = wr_ * ali + wi_ * alr; wr_ = qr; wi_ = qi; } }
    __syncthreads();
}

__device__ __forceinline__ void router_rows(Frame& F, const LAS float* WR, LAS unsigned* CN) {
    const int m0 = 64 * F.vcu + 16 * F.wave;
    unsigned long long nxb[4];
    { const GAS unsigned long long* xr = (const GAS unsigned long long*)(WSP(bf16, WS_H0) + (size_t)m0 * D) + F.lane;
#pragma unroll
        for (int j = 0; j < 4; ++j) nxb[j] = xr[64 * j]; }
    for (int r = 0; r < 16; ++r) { const int m = m0 + r;
        f32x4 v[4];
#pragma unroll
        for (int j = 0; j < 4; ++j) { const unsigned lo = (unsigned)nxb[j], hi = (unsigned)(nxb[j] >> 32); v[j] = (f32x4){__uint_as_float(lo << 16), __uint_as_float(lo & 0xffff0000u), __uint_as_float(hi << 16), __uint_as_float(hi & 0xffff0000u)}; }
        if (r + 1 < 16) { const GAS unsigned long long* xr = (const GAS unsigned long long*)(WSP(bf16, WS_H0) + (size_t)(m + 1) * D) + F.lane;
#pragma unroll
            for (int j = 0; j < 4; ++j) nxb[j] = xr[64 * j]; }
        float rs, red; row_dots(v, WR, F.lane, rs, red);
        GAS unsigned* o4 = (GAS unsigned*)(WSP(unsigned char, WS_H3) + (size_t)m * D) + F.lane;
#pragma unroll
        for (int j = 0; j < 4; ++j) { const f32x4 g = *(const GAS f32x4*)(F.in[I_N3] + 4 * F.lane + 256 * j);
            o4[64 * j] = pk4_fp8(v[j].x * rs * g.x, v[j].y * rs * g.y, v[j].z * rs * g.z, v[j].w * rs * g.w); }
        float lg[8];
#pragma unroll
        for (int e = 0; e < 8; ++e) lg[e] = __builtin_bit_cast(float, __builtin_amdgcn_readlane(__builtin_bit_cast(int, red), 8 * e)) + F.in[I_RB][e];
        int e1 = 0; float l1 = lg[0];
#pragma unroll
        for (int e = 1; e < 8; ++e) if (lg[e] > l1) { l1 = lg[e]; e1 = e; }
        int e2 = -1; float l2 = -INFINITY;
#pragma unroll
        for (int e = 0; e < 8; ++e) if (e != e1 && lg[e] > l2) { l2 = lg[e]; e2 = e; }
        if (F.lane == 0) { const float g2 = 1.0f / (1.0f + expf(l1 - l2)); WSP(unsigned, WS_TOKE)[m] = (unsigned)e1 | ((unsigned)e2 << 8);
            WSP(float, WS_GATE)[2 * m] = 1.0f - g2; WSP(float, WS_GATE)[2 * m + 1] = g2; atomicAdd((unsigned*)&CN[e1], 1u); atomicAdd((unsigned*)&CN[e2], 1u); }
    }
}

__device__ __forceinline__ void moe_sort(Frame& F) {
    LAS unsigned* TOT = (LAS unsigned*)(F.lds + RING_OFF);
    LAS unsigned* BASE = TOT + 2048;
    for (int i = F.tid; i < F.G * 8; i += 512) TOT[i] = WSP(unsigned, WS_CNT)[i];
    __syncthreads();
    if (F.tid < 8) { unsigned tot = 0, pre = 0; for (int b = 0; b < F.G; ++b) { if (b == F.vcu) pre = tot; tot += TOT[b * 8 + F.tid]; } BASE[F.tid] = pre; BASE[8 + F.tid] = tot; }
    __syncthreads();
    if (F.tid == 0) { unsigned s = 0, tl = 0; for (int e = 0; e < 8; ++e) { BASE[16 + e] = s; if (F.vcu == 0) { WSP(unsigned, WS_TAB)[e] = s; WSP(unsigned, WS_TAB)[16 + e] = tl; } s += BASE[8 + e]; tl += (BASE[8 + e] + 255u) >> 8; }
        BASE[24] = s; if (F.vcu == 0) { WSP(unsigned, WS_TAB)[8] = s; WSP(unsigned, WS_TAB)[24] = tl;
            unsigned rowL = 2u * M, t0 = 0, r0 = 0; for (int e = 0; e < 8; ++e) { const unsigned nt_ = (BASE[8 + e] + 255u) >> 8; if (t0 <= (unsigned)MAIN_TILES && (unsigned)MAIN_TILES < t0 + nt_) rowL = r0 + 256u * ((unsigned)MAIN_TILES - t0); t0 += nt_; r0 += BASE[8 + e]; }
            WSP(unsigned, WS_TAB)[25] = rowL; } }
    __syncthreads();
    if (F.vcu == 1 && F.tid < 256) WSP(unsigned, WS_TOKS)[2 * M + F.tid] = 0u;
    if (F.wave == 0) { const int t = 64 * F.vcu + F.lane; const unsigned te = WSP(unsigned, WS_TOKE)[t]; const int e1 = te & 255, e2 = (te >> 8) & 255;
        unsigned p1 = 0, p2 = 0; const unsigned long long lt = (1ull << F.lane) - 1ull;
#pragma unroll
        for (int e = 0; e < 8; ++e) { const unsigned long long b1 = __ballot(e1 == e), b2 = __ballot(e2 == e);
            if (e1 == e) p1 = BASE[16 + e] + BASE[e] + (unsigned)__popcll(b1 & lt);
            if (e2 == e) p2 = BASE[16 + e] + BASE[e] + (unsigned)__popcll(b1) + (unsigned)__popcll(b2 & lt); }
        WSP(unsigned, WS_POS)[2 * t] = p1; WSP(unsigned, WS_POS)[2 * t + 1] = p2; WSP(unsigned, WS_TOKS)[p1] = (unsigned)t; WSP(unsigned, WS_TOKS)[p2] = (unsigned)t; }
}

__device__ __forceinline__ void final_rows(Frame& F) {
    const int gw = F.vcu * NWAVES + F.wave, NGW = F.G * NWAVES; int lane_ = F.lane; asm volatile("" : "+v"(lane_));
    unsigned pp1 = 0, pp2 = 0; float gg1 = 0.f, gg2 = 0.f; const unsigned rowL = WSP(unsigned, WS_TAB)[25];
    { const int mi = gw + (lane_ & 7) * NGW; if (mi < M) { pp1 = WSP(unsigned, WS_POS)[2 * mi]; pp2 = WSP(unsigned, WS_POS)[2 * mi + 1]; gg1 = WSP(float, WS_GATE)[2 * mi]; gg2 = WSP(float, WS_GATE)[2 * mi + 1]; } }
#define FR_LOAD(i, X, A, B) do { const int m_ = gw + (i) * NGW; const unsigned q1_ = (unsigned)__builtin_amdgcn_readlane((int)pp1, (i) & 7), q2_ = (unsigned)__builtin_amdgcn_readlane((int)pp2, (i) & 7); \
        const GAS unsigned long long* xr_ = (const GAS unsigned long long*)(WSP(bf16, WS_H0) + (size_t)m_ * D) + lane_; const GAS unsigned* y1_ = (const GAS unsigned*)(WSP(unsigned char, WS_YS) + (size_t)q1_ * D) + lane_; \
        const GAS unsigned* y2_ = (const GAS unsigned*)(WSP(unsigned char, WS_YS) + (size_t)q2_ * D) + lane_; \
        _Pragma("unroll") for (int j = 0; j < 4; ++j) { X[j] = __builtin_nontemporal_load(xr_ + 64 * j); A[j] = __builtin_nontemporal_load(y1_ + 64 * j); B[j] = __builtin_nontemporal_load(y2_ + 64 * j); } } while (0)
    unsigned long long nx[4]; unsigned na[4], nb[4];
    if (gw < M) FR_LOAD(0, nx, na, nb);
    for (int i = 0; gw + i * NGW < M; ++i) { const int m = gw + i * NGW;
        f32x4 v[4]; unsigned ya[4], yb[4];
#pragma unroll
        for (int j = 0; j < 4; ++j) { const unsigned lo = (unsigned)nx[j], hi = (unsigned)(nx[j] >> 32); v[j] = (f32x4){__uint_as_float(lo << 16), __uint_as_float(lo & 0xffff0000u), __uint_as_float(hi << 16), __uint_as_float(hi & 0xffff0000u)}; ya[j] = na[j]; yb[j] = nb[j]; }
        const float g1 = __builtin_bit_cast(float, __builtin_amdgcn_readlane(__builtin_bit_cast(int, gg1), i & 7)), g2 = __builtin_bit_cast(float, __builtin_amdgcn_readlane(__builtin_bit_cast(int, gg2), i & 7));
        if (gw + (i + 1) * NGW < M) FR_LOAD(i + 1, nx, na, nb);
        float s = 0.f;
        typedef float f32x2v __attribute__((ext_vector_type(2)));
#pragma unroll
        for (int j = 0; j < 4; ++j) {
            const f32x2v a0 = __builtin_amdgcn_cvt_pk_f32_fp8((int)ya[j], false), a1 = __builtin_amdgcn_cvt_pk_f32_fp8((int)ya[j], true), b0 = __builtin_amdgcn_cvt_pk_f32_fp8((int)yb[j], false), b1 = __builtin_amdgcn_cvt_pk_f32_fp8((int)yb[j], true);
            v[j].x += g1 * a0.x + g2 * b0.x; v[j].y += g1 * a0.y + g2 * b0.y; v[j].z += g1 * a1.x + g2 * b1.x; v[j].w += g1 * a1.y + g2 * b1.y; }
        { const unsigned q1 = (unsigned)__builtin_amdgcn_readlane((int)pp1, i & 7), q2 = (unsigned)__builtin_amdgcn_readlane((int)pp2, i & 7);
#pragma unroll
          for (int sl = 0; sl < 2; ++sl) { const unsigned q = sl ? q2 : q1; const float gg = sl ? g2 : g1;
            if (q >= rowL) { const GAS unsigned* yp = (const GAS unsigned*)(WSP(unsigned char, WS_YP) + (size_t)(q - rowL) * D) + lane_;
#pragma unroll
                for (int part = 0; part < 3; ++part)
#pragma unroll
                    for (int j = 0; j < 4; ++j) { const unsigned w = yp[(size_t)part * (YP_ROWS * D / 4) + 64 * j]; const f32x2v c0 = __builtin_amdgcn_cvt_pk_f32_fp8((int)w, false), c1 = __builtin_amdgcn_cvt_pk_f32_fp8((int)w, true);
                        v[j].x += gg * c0.x; v[j].y += gg * c0.y; v[j].z += gg * c1.x; v[j].w += gg * c1.y; } } } }
#pragma unroll
        for (int j = 0; j < 4; ++j) {
            s += (v[j].x * v[j].x + v[j].y * v[j].y) + (v[j].z * v[j].z + v[j].w * v[j].w); }
        const float rs = 1.0f / sqrtf(wave_sum(s) * (1.0f / D) + EPS);
        GAS f32x4* xw = (GAS f32x4*)(F.out + (size_t)m * D) + lane_;
#pragma unroll
        for (int j = 0; j < 4; ++j) { const f32x4 g = *(const GAS f32x4*)(F.in[I_NF] + 4 * lane_ + 256 * j); __builtin_nontemporal_store((f32x4){v[j].x * rs * g.x, v[j].y * rs * g.y, v[j].z * rs * g.z, v[j].w * rs * g.w}, xw + 64 * j); }
    }
#undef FR_LOAD
}

constexpr int N_PHASES = 15;
#ifndef REP_P4
#define REP_P4 1
#endif
#ifndef REP_P12
#define REP_P12 1
#endif
#ifndef REP_P13
#define REP_P13 1
#endif
__global__ void __launch_bounds__(NWAVES * 64, 2) trunk_fwd(Args args) {
    extern __shared__ __attribute__((aligned(16))) unsigned char lds[];
    Frame F;
    F.lds = (LAS unsigned char*)lds;
    F.MISC = (volatile LAS unsigned*)(F.lds + MISC_OFF);
    F.tid = threadIdx.x; F.lane = F.tid & 63; F.wave = __builtin_amdgcn_readfirstlane(F.tid >> 6);
    F.G = gridDim.x; { const int bx = blockIdx.x; F.vcu = (F.G % 8 == 0) ? (bx % 8) * (F.G / 8) + bx / 8 : bx; }
    F.in = (const float* const __attribute__((address_space(4)))*)__builtin_amdgcn_kernarg_segment_ptr();
    F.out = args.out; F.ws = args.ws; F.ctl = (gu32*)(args.ws + WS_CTL);
    for (int u = F.tid; u < (LDS_BYTES - LDSCTL_OFF) / 4; u += NWAVES * 64) ((LAS unsigned*)(F.lds + LDSCTL_OFF))[u] = 0u;
    __syncthreads();
    const int lo = args.ph_lo, hi = args.ph_hi;
    const bool use_bar = (hi - lo) > 1;
    XcdBarrier bar; bar.bar = (unsigned*)(F.ctl + CW_BAR); bar.x = 0; bar.st = nullptr;
    if (use_bar) bar = xcd_barrier_post((unsigned*)(F.ctl + CW_BAR), F.MISC + 8);
#ifndef PHMASK
#define PHMASK 0x7fff
#endif
#define IN(k) ((((PHMASK) >> (k)) & 1) && lo <= (k) && (k) < hi)
#define SEAM(k) do { if (lo <= (k) && (k) + 1 < hi) xcd_barrier(bar); } while (0)
#ifndef DBLMASK
#define DBLMASK 0
#endif
#define RETID() do { int t_ = threadIdx.x; asm volatile("" : "+v"(t_)); F.tid = t_; F.lane = t_ & 63; } while (0)
#define PH(k, ...) if (IN(k)) { RETID(); { __VA_ARGS__ } if (((DBLMASK) >> (k)) & 1) { xcd_barrier(bar); { __VA_ARGS__ } } } SEAM(k);
    LAS unsigned char* ring = F.lds + RING_OFF;

    PH(0, p0_prologue(F); )

    PH(1,
        if (blockIdx.x < NB * NH) forget_cumsum(F, blockIdx.x >> 3, blockIdx.x & 7);
        PlainProb P{WSP(bf16, WS_H0), WSP(bf16, WS_WIN0), 2 * D, 2 * D, D / 64}; pg8::GridOrder S; S.init(M / 256, 2048 / 256, F.G, (int)blockIdx.x);
        LAS float* RSL = (LAS float*)(F.lds + RS_OFF); fill_rs_direct(RSL, WSP(float, WS_RS0), S, F.tid);
        EpiSplitBf16 E{WSP(bf16, WS_QKVP), attn_body::C2, RSL};
        const TableOrder TS = build_units(F.lds, S, F.tid);
        pg8::gemm_phase<EpiSplitBf16, TableOrder, PlainProb, true>(ring, P, TS, E);
    )

    PH(2,
        for (int r = F.vcu; r < M / 64; r += F.G) pool_rows(F, 64 * r);
        const attn_body::bf16* qkv = (const attn_body::bf16*)WSP(bf16, WS_QKVP);
        const attn_body::AttnTensors AT{qkv, qkv + (size_t)M * 512, qkv + (size_t)2 * M * 512, (attn_body::bf16*)WSP(bf16, WS_MIX), WSP(float, WS_FNEG)};
        const attn_body::StaticOrder S((int)F.G, (int)blockIdx.x);
        attn_body::attn_phase<attn_body::StaticOrder>((char*)lds + RING_OFF, AT, S);
    )

    PH(3,
        PlainProb P{WSP(bf16, WS_MIX), WSP(bf16, WS_WOT), 2 * D, 2 * D, D / 64}; pg8::GridOrder S; S.init(M / 256, D / 256, F.G, (int)blockIdx.x);
        EpiResid<false> E{WSP(bf16, WS_H0), WSP(bf16, WS_QKVP), WSP(float, WS_SSQ1)};
        pg8::gemm_phase<EpiResid<false>, pg8::GridOrder, PlainProb, false>(ring, P, S, E);
    )

    PH(4,
        PlainProb P{WSP(bf16, WS_QKVP), WSP(bf16, WS_W13), 2 * D, 2 * D, D / 64}; pg8::GridOrder S; S.init(M / 256, 2 * DFF / 256, F.G, (int)blockIdx.x);
        LAS float* RSL = (LAS float*)(F.lds + RS_OFF); fill_rs(RSL, WSP(float, WS_SSQ1), S, F.tid);
        EpiSwiglu E{WSP(bf16, WS_ACT0), RSL};
        const TableOrder TS = build_units(F.lds, S, F.tid);
        pg8::gemm_phase<EpiSwiglu, TableOrder, PlainProb, true, false, REP_P4>(ring, P, TS, E);
        if (SSM_IN_P4) { int pm_, pn_; if (!S.tile(5, pm_, pn_)) { const int k_ = (int)blockIdx.x - 128; if (k_ >= 0) { ssm_prep_job(F, k_ >> 1, k_ & 1, true); ssm_prep_job(F, k_ >> 1, (k_ & 1) + 2, false); } } }
    )

    PH(5,
        PlainProb P{WSP(bf16, WS_ACT0), WSP(bf16, WS_W2T), 2 * DFF, 2 * DFF, DFF / 64}; pg8::GridOrder S; S.init(M / 256, D / 256, F.G, (int)blockIdx.x);
        EpiResid<false> E{WSP(bf16, WS_QKVP), WSP(bf16, WS_H0), WSP(float, WS_SSQ2)};
        pg8::gemm_phase<EpiResid<false>, pg8::GridOrder, PlainProb, false>(ring, P, S, E);
    )

    PH(6,
        PlainProb P{WSP(bf16, WS_H0), WSP(bf16, WS_WIN1), 2 * D, 2 * D, D / 64}; pg8::GridOrder S; S.init(M / 256, D / 256, F.G, (int)blockIdx.x);
        LAS float* RSL = (LAS float*)(F.lds + RS_OFF); fill_rs(RSL, WSP(float, WS_SSQ2), S, F.tid);
        EpiSsmU E{WSP(bf16, WS_QKVP), RSL};
        pg8::gemm_phase<EpiSsmU, pg8::GridOrder, PlainProb, false>(ring, P, S, E);
    )

    PH(7, for (int j = F.vcu; j < 4 * SG; j += F.G) ssm_state_unit(F, j >> 2, j & 3); )

    PH(8,
        SsmProb P{WSP(bf16, WS_QKVP), WSP(bf16, WS_BT2), 2 * KA, 2 * KA}; SsmOrder S{F.vcu, F.G};
        EpiGelu E{WSP(bf16, WS_ACT0)};
        pg8::gemm_phase<EpiGelu, SsmOrder, SsmProb, false>(ring, P, S, E);
    )

    PH(9,
        PlainProb P{WSP(bf16, WS_ACT0), WSP(bf16, WS_WGLU), 2 * D, 2 * D, D / 64}; pg8::GridOrder S; S.init(M / 256, 2 * D / 256, F.G, (int)blockIdx.x);
        EpiGlu E{WSP(bf16, WS_H0)};
        const TableOrder TS = build_units(F.lds, S, F.tid);
        pg8::gemm_phase<EpiGlu, TableOrder, PlainProb, true>(ring, P, TS, E);
    )

    PH(10,
        LAS float* WR = (LAS float*)(F.lds + RING_OFF + 69632);
        LAS unsigned* CN = (LAS unsigned*)(F.lds + RING_OFF + 69632 + 32768);
        fill_w8(WR, F.in[I_RW], NE, F.in[I_N3], F.tid);
        if (F.tid < 16) CN[F.tid] = 0u;
        __syncthreads();
        if (F.wave < 4) router_rows(F, WR, CN);
        { LAS unsigned char* scr = F.lds + RING_OFF + F.wave * 8704;
          constexpr int JE = 8 * 44; constexpr int NIT = NE * 2 * JE;
          for (;;) { unsigned k = 0; if (F.lane == 0) k = atomicAdd((unsigned*)&CN[8], 1u); k = (unsigned)__builtin_amdgcn_readfirstlane((int)k);
              const int it = F.vcu + (int)k * F.G; if (it >= NIT) break; const int e = it / (2 * JE), r = it % (2 * JE);
              if (r < JE) tr_job_f8(F.in[I_EW1] + (size_t)e * D * DFF, DFF, 44, WSP(unsigned char, WS_W13E) + (size_t)e * 2 * DFF * D, D, 1, 0, r, scr, F.lane);
              else tr_job_f8(F.in[I_EW3] + (size_t)e * D * DFF, DFF, 44, WSP(unsigned char, WS_W13E) + (size_t)e * 2 * DFF * D, D, 1, 128, r - JE, scr, F.lane); } }
        __syncthreads();
        if (F.tid < 8) WSP(unsigned, WS_CNT)[F.vcu * 8 + F.tid] = CN[F.tid];
    )

    PH(11, moe_sort(F); )

    PH(12,
        const int nM_ = (int)WSP(unsigned, WS_TAB)[24], nwg_ = nM_ * (2 * DFF / 256), rounds_ = (nwg_ + F.G - 1) / F.G; int Gp_ = rounds_ > 0 ? (nwg_ + rounds_ - 1) / rounds_ : F.G; if (Gp_ > F.G) Gp_ = F.G;
        if ((int)blockIdx.x < Gp_) {
            MoeOrder S; S.tab = WSP(unsigned, WS_TAB); S.init(nM_, 2 * DFF / 256, Gp_, (int)blockIdx.x);
            MoeUpProb P{WSP(unsigned char, WS_H3), WSP(unsigned char, WS_W13E), WSP(unsigned, WS_TOKS), D, D};
            EpiSwigluF8 E{WSP(unsigned char, WS_ACTS)};
            const TableOrder TS = build_units(F.lds, S, F.tid);
            pg8::gemm_phase<EpiSwigluF8, TableOrder, MoeUpProb, true, true, REP_P12>(ring, P, TS, E);
        }
        { LAS unsigned char* scr = F.lds + RING_OFF + F.wave * 8704; constexpr int JE = 8 * 44; constexpr int NIT2 = NE * JE;
          for (;;) { __syncthreads(); if (F.tid == 0) F.MISC[16] = __hip_atomic_fetch_add((unsigned*)(F.ctl + CW_W2E), 8u, RLX_AGENT); __syncthreads();
              const int base = (int)F.MISC[16]; if (base >= NIT2) break; const int it = base + F.wave;
              if (it < NIT2) { const int e = it / JE, r = it % JE; tr_job_f8(F.in[I_EW2] + (size_t)e * DFF * D, D, 16, WSP(unsigned char, WS_W2E) + (size_t)e * D * DFF, DFF, 0, 0, r, scr, F.lane); } } }
    )

    PH(13,
        MoeDownOrder S; S.init(WSP(unsigned, WS_TAB), F.G, (int)blockIdx.x);
        MoeDownProb P{WSP(unsigned char, WS_ACTS), WSP(unsigned char, WS_W2E), DFF, DFF};
        EpiMaskF8 E{WSP(unsigned char, WS_YS), WSP(unsigned char, WS_YP), (int)WSP(unsigned, WS_TAB)[25]};
        const TableOrder TS = build_units(F.lds, S, F.tid);
        pg8::gemm_phase<EpiMaskF8, TableOrder, MoeDownProb, true, true, REP_P13>(ring, P, TS, E);
    )

    PH(14, final_rows(F); )
#undef IN
#undef SEAM
}

extern "C" void kernel_launch(void* const* d_in, const int* in_sizes, int n_in, void* d_out, int out_size, void* d_ws, size_t ws_size, hipStream_t stream) {
    static int grid = 0;
    if (grid == 0) {
        if (n_in != 30 || in_sizes[0] != M * D || out_size != M * D || ws_size < WS_END) { fprintf(stderr, "kernel_launch: shape/workspace mismatch (n_in %d, ws %zu, need %zu); nothing launched\n", n_in, ws_size, (size_t)WS_END); grid = -1; return; }
        int dev = 0, cus = 0, per_cu = 0;
        if (hipGetDevice(&dev) != hipSuccess || hipDeviceGetAttribute(&cus, hipDeviceAttributeMultiprocessorCount, dev) != hipSuccess) { grid = -1; return; }
        if (hipFuncSetAttribute((const void*)trunk_fwd, hipFuncAttributeMaxDynamicSharedMemorySize, LDS_BYTES) != hipSuccess) { fprintf(stderr, "kernel_launch: hipFuncSetAttribute failed\n"); grid = -1; return; }
        if (hipOccupancyMaxActiveBlocksPerMultiprocessor(&per_cu, (const void*)trunk_fwd, NWAVES * 64, LDS_BYTES) != hipSuccess || per_cu < 1) fprintf(stderr, "kernel_launch: occupancy query reports %d\n", per_cu);
        (void)hipGetLastError();
        if (cus < 256) { fprintf(stderr, "kernel_launch: needs 256 CUs, device has %d\n", cus); grid = -1; return; }
        grid = 256;
    }
    if (grid < 0) return;
    if (hipMemsetAsync((char*)d_ws + WS_CTL, 0, 32 * 1024, stream) != hipSuccess) return;
    Args a{};
    for (int i = 0; i < 30; ++i) a.in[i] = (const float*)d_in[i];
    a.out = (float*)d_out; a.ws = (unsigned char*)d_ws;
#ifndef MK_SPLIT
    a.ph_lo = 0; a.ph_hi = N_PHASES;
    hipLaunchKernelGGL(trunk_fwd, dim3(grid), dim3(NWAVES * 64), LDS_BYTES, stream, a);
#else
    for (int p = 0; p < N_PHASES; ++p) { a.ph_lo = p; a.ph_hi = p + 1; hipLaunchKernelGGL(trunk_fwd, dim3(grid), dim3(NWAVES * 64), LDS_BYTES, stream, a); }
#endif
}
```
